# Optimizing an MI355X kernel written in HIP

```python
import math
import jax
import jax.numpy as jnp
from jax import lax
import numpy as np

D_MODEL = 2048
BATCH = 32
SEQ = 256
DEPTH = 2
DEC_BATCH = 2
DEC_SEQ = 1024
PAST_LEN = 512

GRID_W = 64
RMS_EPS = 1e-6
N_MOD = 9
D_FF = 5632
GLA_HEADS = 4
GLA_DK = 128
GLA_DV = 256
GLA_RANK = 16
GLA_GATE_NORM = 16.0
GLA_CHUNK = 16
SSM_HEADS = 16
SSM_HEADDIM = 64
SSM_GROUPS = 4
SSM_HPG = SSM_HEADS // SSM_GROUPS
SSM_STATE = 128
SSM_CONV = 5
SSM_CHUNK = 64
SSM_INNER = SSM_HEADS * SSM_HEADDIM
SSM_BC = SSM_GROUPS * SSM_STATE
CONV_CH = SSM_INNER + 2 * SSM_BC
ATTN_HEADS = 8
KV_HEADS = 2
Q_PER_KV = ATTN_HEADS // KV_HEADS
HEAD_DIM = 128
WINDOW = 128
ATTN_BLOCK = 128
ROPE_THETA = 10000.0
GLA_QK = GLA_HEADS * GLA_DK
GLA_VAL = GLA_HEADS * GLA_DV
ATTN_Q = ATTN_HEADS * HEAD_DIM
ATTN_KV = KV_HEADS * HEAD_DIM
N_BRANCH = 3
IN_SPLITS = (GLA_QK, GLA_QK, GLA_VAL, GLA_VAL, 2 * GLA_RANK,
             SSM_INNER, CONV_CH, 2 * SSM_HEADS,
             ATTN_Q, ATTN_KV, ATTN_KV,
             N_BRANCH * D_MODEL)
D_IN = sum(IN_SPLITS)

kernel_name = 'hybrid_diffusion_trunk_step'


def _rmsnorm(x, w):
    xf = x.astype(jnp.float32)
    y = xf * lax.rsqrt(jnp.mean(xf * xf, axis=-1, keepdims=True) + RMS_EPS)
    return (y * w.astype(jnp.float32)).astype(x.dtype)


def _modulate(h, shift, scale):
    return h * (1.0 + scale[:, None]) + shift[:, None]


def _swiglu(h, w_gate, w_up, w_down):
    return (jax.nn.silu(h @ w_gate) * (h @ w_up)) @ w_down


def _flip(t):
    return jnp.flip(t, axis=1)


def _rope_1d(x, pos):
    half = x.shape[-1] // 2
    freqs = ROPE_THETA ** (-jnp.arange(half, dtype=jnp.float32) / half)
    ang = pos.astype(jnp.float32)[:, None] * freqs[None, :]
    cos = jnp.cos(ang)[:, None, :]
    sin = jnp.sin(ang)[:, None, :]
    x1 = x[..., :half].astype(jnp.float32)
    x2 = x[..., half:].astype(jnp.float32)
    return jnp.concatenate([x1 * cos - x2 * sin, x2 * cos + x1 * sin], axis=-1).astype(x.dtype)


def _rope_2d(x):
    t = jnp.arange(x.shape[1])
    half = x.shape[-1] // 2
    return jnp.concatenate([_rope_1d(x[..., :half], t // GRID_W), _rope_1d(x[..., half:], t % GRID_W)], axis=-1)


def _depthwise_conv(x, w, b):
    y = lax.conv_general_dilated(x, w[:, None, :], window_strides=(1,),
                                 padding=[(SSM_CONV // 2, SSM_CONV // 2)],
                                 dimension_numbers=('NWC', 'WIO', 'NWC'),
                                 feature_group_count=x.shape[-1])
    return y + b


def _gla_chunked(q, k, v, log_a, h0):
    B, L, H, K = q.shape
    V = v.shape[-1]
    n = L // GLA_CHUNK
    f32 = jnp.float32
    qc = q.astype(f32).reshape(B, n, GLA_CHUNK, H, K)
    kc = k.astype(f32).reshape(B, n, GLA_CHUNK, H, K)
    vc = v.astype(f32).reshape(B, n, GLA_CHUNK, H, V)
    cum = jnp.cumsum(log_a.astype(f32).reshape(B, n, GLA_CHUNK, H, K), axis=2)
    causal = jnp.tril(jnp.ones((GLA_CHUNK, GLA_CHUNK), bool))[:, :, None, None]
    decay = jnp.exp(jnp.where(causal, cum[:, :, :, None] - cum[:, :, None, :], -jnp.inf))
    scores = jnp.einsum('bcthk,bcshk,bctshk->bchts', qc, kc, decay)
    o_intra = jnp.einsum('bchts,bcshv->bcthv', scores, vc)
    cum_end = cum[:, :, -1]
    s_chunk = jnp.einsum('bcshk,bcshv->bchkv', kc * jnp.exp(cum_end[:, :, None] - cum), vc)

    def step(s, inp):
        sc, ae = inp
        return jnp.exp(ae)[..., None] * s + sc, s

    s_final, s_prev = lax.scan(step, h0.astype(f32), (jnp.moveaxis(s_chunk, 1, 0), jnp.moveaxis(cum_end, 1, 0)))
    s_prev = jnp.moveaxis(s_prev, 0, 1)
    o_inter = jnp.einsum('bcthk,bchkv->bcthv', qc * jnp.exp(cum), s_prev)
    return (o_intra + o_inter).reshape(B, L, H, V).astype(v.dtype), s_final


def _ssd_chunked(x, dt, A, bm, cm, h0):
    B, L, G, Hg, P = x.shape
    n = L // SSM_CHUNK
    f32 = jnp.float32
    xc = x.astype(f32).reshape(B, n, SSM_CHUNK, G, Hg, P)
    dtc = dt.astype(f32).reshape(B, n, SSM_CHUNK, G, Hg)
    bc = bm.astype(f32).reshape(B, n, SSM_CHUNK, G, SSM_STATE)
    cc = cm.astype(f32).reshape(B, n, SSM_CHUNK, G, SSM_STATE)
    cum = jnp.cumsum(dtc * A.astype(f32), axis=2)
    cum_t = jnp.moveaxis(cum, 2, -1)
    causal = jnp.tril(jnp.ones((SSM_CHUNK, SSM_CHUNK), bool))
    seg = jnp.exp(jnp.where(causal, cum_t[..., :, None] - cum_t[..., None, :], -jnp.inf))
    cb = jnp.einsum('bctgn,bcsgn->bcgts', cc, bc)
    w = cb[:, :, :, None] * seg * jnp.moveaxis(dtc, 2, -1)[..., None, :]
    y_intra = jnp.einsum('bcghts,bcsghp->bctghp', w, xc)
    cum_end = cum[:, :, -1]
    s_chunk = jnp.einsum('bcsgn,bcsgh,bcsghp->bcghpn', bc, dtc * jnp.exp(cum_end[:, :, None] - cum), xc)

    def step(s, inp):
        sc, ae = inp
        return jnp.exp(ae)[..., None, None] * s + sc, s

    s_final, s_prev = lax.scan(step, h0.astype(f32), (jnp.moveaxis(s_chunk, 1, 0), jnp.moveaxis(cum_end, 1, 0)))
    s_prev = jnp.moveaxis(s_prev, 0, 1)
    y_inter = jnp.einsum('bctgn,bctgh,bcghpn->bctghp', cc, jnp.exp(cum), s_prev)
    return (y_intra + y_inter).reshape(B, L, G, Hg, P).astype(x.dtype), s_final


def _sink_attention(q, k, v, mask, sink):
    s = jnp.einsum('bqkgd,bskd->bkgqs', q, k).astype(jnp.float32) * (HEAD_DIM ** -0.5)
    if mask is not None:
        s = jnp.where(mask, s, -jnp.inf)
    sink_col = jnp.broadcast_to(sink.astype(jnp.float32)[None, :, :, None, None], s.shape[:-1] + (1,))
    p = jax.nn.softmax(jnp.concatenate([sink_col, s], axis=-1), axis=-1)[..., 1:]
    return jnp.einsum('bkgqs,bskd->bqkgd', p.astype(v.dtype), v)


def _context_attention(q, k, v, sink):
    B, L = q.shape[:2]
    nb = L // ATTN_BLOCK
    q_blocks = jnp.moveaxis(q.reshape(B, nb, ATTN_BLOCK, KV_HEADS, Q_PER_KV, HEAD_DIM), 1, 0)
    out = lax.map(lambda qi: _sink_attention(qi, k, v, None, sink), q_blocks)
    return jnp.moveaxis(out, 0, 1).reshape(B, L, ATTN_Q)


def _latent_attention(q, k, v, k_ctx, v_ctx, sink):
    B, L = q.shape[:2]
    nb = L // ATTN_BLOCK
    span = ATTN_BLOCK + 2 * WINDOW
    pad = ((0, 0), (WINDOW, WINDOW), (0, 0), (0, 0))
    kp = jnp.pad(k, pad)
    vp = jnp.pad(v, pad)
    q_blocks = jnp.moveaxis(q.reshape(B, nb, ATTN_BLOCK, KV_HEADS, Q_PER_KV, HEAD_DIM), 1, 0)
    ctx_mask = jnp.ones((ATTN_BLOCK, k_ctx.shape[1]), bool)

    def block(args):
        i, qi = args
        start = i * ATTN_BLOCK
        kw = lax.dynamic_slice_in_dim(kp, start, span, axis=1)
        vw = lax.dynamic_slice_in_dim(vp, start, span, axis=1)
        qpos = start + jnp.arange(ATTN_BLOCK)
        kpos = start - WINDOW + jnp.arange(span)
        win = (jnp.abs(qpos[:, None] - kpos[None, :]) <= WINDOW) & (kpos[None, :] >= 0) & (kpos[None, :] < L)
        mask = jnp.concatenate([ctx_mask, win], axis=1)
        return _sink_attention(qi, jnp.concatenate([k_ctx, kw], axis=1),
                               jnp.concatenate([v_ctx, vw], axis=1), mask, sink)

    out = lax.map(block, (jnp.arange(nb), q_blocks))
    return jnp.moveaxis(out, 0, 1).reshape(B, L, ATTN_Q)


def _token_mix(h, lp, ctx):
    B, L, _ = h.shape
    f32 = jnp.float32
    split_at = [int(s) for s in np.cumsum(IN_SPLITS)[:-1]]
    (g_q, g_k, g_v, g_r, g_down, s_z, s_xbc, s_dt, a_q, a_k, a_v, br) = jnp.split(h @ lp['w_in'], split_at, axis=-1)
    if ctx is None:
        gla_h0 = jnp.zeros((2, B, GLA_HEADS, GLA_DK, GLA_DV), f32)
        ssm_h0 = jnp.zeros((2, B, SSM_GROUPS, SSM_HPG, SSM_HEADDIM, SSM_STATE), f32)
    else:
        gla_h0 = jnp.moveaxis(ctx['gla'], 1, 0)
        ssm_h0 = jnp.moveaxis(ctx['ssm'], 1, 0).reshape(2, B, SSM_GROUPS, SSM_HPG, SSM_HEADDIM, SSM_STATE)

    q = g_q.reshape(B, L, GLA_HEADS, GLA_DK) * (GLA_DK ** -0.5)
    k = g_k.reshape(B, L, GLA_HEADS, GLA_DK)
    v = g_v.reshape(B, L, GLA_HEADS, GLA_DV)
    gz = jnp.einsum('bldr,drk->bldk', g_down.reshape(B, L, 2, GLA_RANK), lp['gla_w_up']) + lp['gla_b_up']
    log_a = (jax.nn.log_sigmoid(gz.astype(f32)) / GLA_GATE_NORM).reshape(B, L, 2, GLA_HEADS, GLA_DK)
    o_f, sg_f = _gla_chunked(q, k, v, log_a[:, :, 0], gla_h0[0])
    o_b, sg_b = _gla_chunked(_flip(q), _flip(k), _flip(v), _flip(log_a[:, :, 1]), gla_h0[1])
    o_gla = _rmsnorm(o_f + _flip(o_b), lp['gla_norm']).reshape(B, L, GLA_VAL) * jax.nn.silu(g_r)

    xbc = jax.nn.silu(_depthwise_conv(s_xbc, lp['ssm_conv_w'], lp['ssm_conv_b']))
    xs, bm, cm = jnp.split(xbc, [SSM_INNER, SSM_INNER + SSM_BC], axis=-1)
    xs = xs.reshape(B, L, SSM_GROUPS, SSM_HPG, SSM_HEADDIM)
    bm = bm.reshape(B, L, SSM_GROUPS, SSM_STATE)
    cm = cm.reshape(B, L, SSM_GROUPS, SSM_STATE)
    dt = jax.nn.softplus(s_dt.astype(f32).reshape(B, L, 2, SSM_HEADS) + lp['ssm_dt_bias'].astype(f32))
    dt = dt.reshape(B, L, 2, SSM_GROUPS, SSM_HPG)
    A = -jnp.exp(lp['ssm_a_log'].astype(f32)).reshape(2, SSM_GROUPS, SSM_HPG)
    y_f, ss_f = _ssd_chunked(xs, dt[:, :, 0], A[0], bm, cm, ssm_h0[0])
    y_b, ss_b = _ssd_chunked(_flip(xs), _flip(dt[:, :, 1]), A[1], _flip(bm), _flip(cm), ssm_h0[1])
    y = y_f + _flip(y_b) + lp['ssm_d'].reshape(SSM_GROUPS, SSM_HPG)[:, :, None] * xs
    o_ssm = _rmsnorm(y.reshape(B, L, SSM_INNER) * jax.nn.silu(s_z), lp['ssm_norm'])

    qa = a_q.reshape(B, L, ATTN_HEADS, HEAD_DIM)
    ka = a_k.reshape(B, L, KV_HEADS, HEAD_DIM)
    va = a_v.reshape(B, L, KV_HEADS, HEAD_DIM)
    sink = lp['attn_sink'].reshape(KV_HEADS, Q_PER_KV)
    if ctx is None:
        o_att = _context_attention(qa.reshape(B, L, KV_HEADS, Q_PER_KV, HEAD_DIM), ka, va, sink)
    else:
        qa = _rope_2d(qa)
        ka = _rope_2d(ka)
        o_att = _latent_attention(qa.reshape(B, L, KV_HEADS, Q_PER_KV, HEAD_DIM), ka, va, ctx['k'], ctx['v'], sink)

    gates = jax.nn.sigmoid(br).reshape(B, L, N_BRANCH, D_MODEL)
    m = (gates[:, :, 0] * (o_gla @ lp['w_br_gla'])
         + gates[:, :, 1] * (o_ssm @ lp['w_br_ssm'])
         + gates[:, :, 2] * (o_att @ lp['w_br_attn']))
    out = m @ lp['w_out']
    gla_state = jnp.stack([sg_f, sg_b], axis=1)
    ssm_state = jnp.stack([ss_f, ss_b], axis=1).reshape(B, 2, SSM_HEADS, SSM_HEADDIM, SSM_STATE)
    return out, (ka, va, gla_state, ssm_state)


def _trunk_layer(x, mod, lp, ctx):
    sh1, sc1, g1, sh2, sc2, g2, sh3, sc3, g3 = jnp.split(mod, N_MOD, axis=-1)
    h = _modulate(_rmsnorm(x, lp['ffn1_norm']), sh1, sc1)
    x = x + 0.5 * g1[:, None] * _swiglu(h, lp['ffn1_w_gate'], lp['ffn1_w_up'], lp['ffn1_w_down'])
    h = _modulate(_rmsnorm(x, lp['mix_norm']), sh2, sc2)
    mix, ctx_tensors = _token_mix(h, lp, ctx)
    x = x + g2[:, None] * mix
    h = _modulate(_rmsnorm(x, lp['ffn2_norm']), sh3, sc3)
    x = x + 0.5 * g3[:, None] * _swiglu(h, lp['ffn2_w_gate'], lp['ffn2_w_up'], lp['ffn2_w_down'])
    return x, ctx_tensors


def setup_inputs(seed: int = 0) -> dict:
    key = jax.random.key(seed)
    ks = iter(jax.random.split(key, 48))
    D = D_MODEL

    def nrm(shape, scale=1.0):
        return jax.random.normal(next(ks), shape, jnp.float32) * scale

    def gain(shape):
        return 1.0 + nrm(shape, 0.05)

    dt0 = jnp.exp(jax.random.uniform(next(ks), (DEPTH, 2, SSM_HEADS), jnp.float32, math.log(1e-3), math.log(1e-1)))
    a0 = jax.random.uniform(next(ks), (DEPTH, 2, SSM_HEADS), jnp.float32, 1.0, 16.0)
    return {
        'x_prompt': nrm((BATCH, SEQ, D)),
        'x_sample': nrm((DEC_BATCH, DEC_SEQ, D)),
        'c': nrm((DEC_BATCH, D)),
        'cache_k': nrm((DEC_BATCH, DEPTH, PAST_LEN, KV_HEADS, HEAD_DIM)),
        'cache_v': nrm((DEC_BATCH, DEPTH, PAST_LEN, KV_HEADS, HEAD_DIM)),
        'state_gla': nrm((DEC_BATCH, DEPTH, 2, GLA_HEADS, GLA_DK, GLA_DV)),
        'state_ssm': nrm((DEC_BATCH, DEPTH, 2, SSM_HEADS, SSM_HEADDIM, SSM_STATE)),
        'c_ctx': nrm((D,)),
        'w_mod': nrm((DEPTH, D, N_MOD * D), D ** -0.5),
        'b_mod': nrm((DEPTH, N_MOD * D), 0.01),
        'ffn1_norm': gain((DEPTH, D)),
        'ffn1_w_gate': nrm((DEPTH, D, D_FF), D ** -0.5),
        'ffn1_w_up': nrm((DEPTH, D, D_FF), D ** -0.5),
        'ffn1_w_down': nrm((DEPTH, D_FF, D), D_FF ** -0.5),
        'mix_norm': gain((DEPTH, D)),
        'w_in': nrm((DEPTH, D, D_IN), D ** -0.5),
        'gla_w_up': nrm((DEPTH, 2, GLA_RANK, GLA_QK), GLA_RANK ** -0.5),
        'gla_b_up': nrm((DEPTH, 2, GLA_QK), 0.1),
        'gla_norm': gain((DEPTH, GLA_DV)),
        'ssm_conv_w': nrm((DEPTH, SSM_CONV, CONV_CH), SSM_CONV ** -0.5),
        'ssm_conv_b': nrm((DEPTH, CONV_CH), 0.01),
        'ssm_dt_bias': dt0 + jnp.log(-jnp.expm1(-dt0)),
        'ssm_a_log': jnp.log(a0),
        'ssm_d': 1.0 + nrm((DEPTH, SSM_HEADS), 0.1),
        'ssm_norm': gain((DEPTH, SSM_INNER)),
        'attn_sink': nrm((DEPTH, ATTN_HEADS), 0.5),
        'w_br_gla': nrm((DEPTH, GLA_VAL, D), GLA_VAL ** -0.5),
        'w_br_ssm': nrm((DEPTH, SSM_INNER, D), SSM_INNER ** -0.5),
        'w_br_attn': nrm((DEPTH, ATTN_Q, D), ATTN_Q ** -0.5),
        'w_out': nrm((DEPTH, D, D), D ** -0.5),
        'ffn2_norm': gain((DEPTH, D)),
        'ffn2_w_gate': nrm((DEPTH, D, D_FF), D ** -0.5),
        'ffn2_w_up': nrm((DEPTH, D, D_FF), D ** -0.5),
        'ffn2_w_down': nrm((DEPTH, D_FF, D), D_FF ** -0.5),
        'final_norm': gain((D,)),
    }


def reference(x_prompt, x_sample, c, cache_k, cache_v, state_gla, state_ssm, c_ctx,
              w_mod, b_mod, ffn1_norm, ffn1_w_gate, ffn1_w_up, ffn1_w_down,
              mix_norm, w_in, gla_w_up, gla_b_up, gla_norm,
              ssm_conv_w, ssm_conv_b, ssm_dt_bias, ssm_a_log, ssm_d, ssm_norm,
              attn_sink, w_br_gla, w_br_ssm, w_br_attn, w_out,
              ffn2_norm, ffn2_w_gate, ffn2_w_up, ffn2_w_down, final_norm):
    silu_ctx = jax.nn.silu(c_ctx)[None]
    silu_lat = jax.nn.silu(c)
    xp, xs = x_prompt, x_sample
    new_k, new_v, new_gla, new_ssm = [], [], [], []
    for l in range(DEPTH):
        lp = {
            'ffn1_norm': ffn1_norm[l], 'ffn1_w_gate': ffn1_w_gate[l], 'ffn1_w_up': ffn1_w_up[l],
            'ffn1_w_down': ffn1_w_down[l], 'mix_norm': mix_norm[l], 'w_in': w_in[l],
            'gla_w_up': gla_w_up[l], 'gla_b_up': gla_b_up[l], 'gla_norm': gla_norm[l],
            'ssm_conv_w': ssm_conv_w[l], 'ssm_conv_b': ssm_conv_b[l], 'ssm_dt_bias': ssm_dt_bias[l],
            'ssm_a_log': ssm_a_log[l], 'ssm_d': ssm_d[l], 'ssm_norm': ssm_norm[l],
            'attn_sink': attn_sink[l], 'w_br_gla': w_br_gla[l], 'w_br_ssm': w_br_ssm[l],
            'w_br_attn': w_br_attn[l], 'w_out': w_out[l], 'ffn2_norm': ffn2_norm[l],
            'ffn2_w_gate': ffn2_w_gate[l], 'ffn2_w_up': ffn2_w_up[l], 'ffn2_w_down': ffn2_w_down[l],
        }
        mod_ctx = silu_ctx @ w_mod[l] + b_mod[l]
        mod_lat = silu_lat @ w_mod[l] + b_mod[l]
        xp, (k_c, v_c, g_st, s_st) = _trunk_layer(xp, mod_ctx, lp, None)
        new_k.append(k_c)
        new_v.append(v_c)
        new_gla.append(g_st)
        new_ssm.append(s_st)
        ctx = {'k': cache_k[:, l], 'v': cache_v[:, l], 'gla': state_gla[:, l], 'ssm': state_ssm[:, l]}
        xs, _ = _trunk_layer(xs, mod_lat, lp, ctx)
    y_prompt = _rmsnorm(xp, final_norm)
    y_sample = _rmsnorm(xs, final_norm)
    return (y_prompt, y_sample, jnp.stack(new_k, axis=1), jnp.stack(new_v, axis=1),
            jnp.stack(new_gla, axis=1), jnp.stack(new_ssm, axis=1))
```

```cpp
#include <hip/hip_runtime.h>
#include <cstdio>
#include <cstdint>

#ifndef MIX_MASK
#define MIX_MASK 7
#endif
#ifndef PG8_ALIGN
#define PG8_ALIGN 1
#endif
#ifndef XCD_CONTIG
#define XCD_CONTIG 0
#endif
#ifdef PROBE_DUP_OVERRIDE
#define PROBE_DUP PROBE_DUP_OVERRIDE
#endif
#ifndef PROBE_DUP
#define PROBE_DUP 0
#endif
#define NREP(bit) ((PROBE_DUP & (bit)) ? 2 : 1)
#define GAS __attribute__((address_space(1)))
#define LAS __attribute__((address_space(3)))
#define DI __device__ __forceinline__
typedef unsigned short bf16_t;
typedef short bf16x8 __attribute__((ext_vector_type(8)));
typedef short s16x4 __attribute__((ext_vector_type(4)));
typedef float f32x4 __attribute__((ext_vector_type(4)));
typedef float f32x2 __attribute__((ext_vector_type(2)));
typedef float f32x8 __attribute__((ext_vector_type(8)));
typedef float f32x16 __attribute__((ext_vector_type(16)));
typedef unsigned u32x4 __attribute__((ext_vector_type(4)));
typedef unsigned u32x2 __attribute__((ext_vector_type(2)));
typedef __bf16 bf16x2_t __attribute__((ext_vector_type(2)));
typedef GAS unsigned gu32;

constexpr int DM = 2048, FF = 5632, NMOD = 9 * DM;
constexpr int M_CTX = 8192, M_LAT = 2048, MT = 10240;
constexpr int NGU = 2 * FF;
constexpr int D_IN = 13888, NY = 14080;
constexpr int YC_GQ = 0, YC_GK = 512, YC_GV = 1024, YC_GR = 2048, YC_SZ = 3072, YC_XBC = 4096, YC_AQ = 6144, YC_AK = 7168, YC_AV = 7424, YC_BR = 7680, YC_GD = 13824, YC_DT = 13856;
constexpr float RMS_EPS = 1e-6f;

constexpr size_t OUT_YP = 0, OUT_YS = 16777216, OUT_CK = 20971520, OUT_CV = 25165824, OUT_GLA = 29360128, OUT_SSM = 46137344, OUT_TOTAL = 62914560;

constexpr size_t MiB = 1u << 20;
constexpr size_t WS_CTL = 0, CTL_ZERO_BYTES = 2 * MiB;
constexpr size_t WS_MOD = 2 * MiB;
constexpr size_t WS_DT = 3 * MiB;
constexpr size_t WS_DTA = WS_DT + (size_t)MT * 32 * 4;
constexpr size_t WS_YS = 6 * MiB;
constexpr size_t WS_CKB = 9 * MiB;
constexpr size_t WS_CVB = 10 * MiB;
constexpr size_t WS_KR = 11 * MiB;
constexpr size_t WS_WGU = 12 * MiB;
constexpr size_t SZ_WGU = (size_t)NGU * DM * 2;
constexpr size_t WS_WD = WS_WGU + 4 * SZ_WGU;
constexpr size_t SZ_WD = (size_t)DM * FF * 2;
constexpr size_t WS_WIN = WS_WD + 4 * SZ_WD;
constexpr size_t SZ_WIN = (size_t)NY * DM * 2;
constexpr size_t WS_WBR = WS_WIN + 2 * SZ_WIN;
constexpr size_t SZ_WBR = (size_t)DM * 1024 * 2;
constexpr size_t WS_WOUT = WS_WBR + 6 * SZ_WBR;
constexpr size_t SZ_WOUT = (size_t)DM * DM * 2;
constexpr size_t WS_XN = WS_WOUT + 2 * SZ_WOUT;
constexpr size_t WS_BIG = WS_XN + (size_t)MT * DM * 2;
constexpr size_t WS_XBC = WS_BIG + (size_t)MT * NY * 2;
constexpr size_t WS_LA = WS_XBC + (size_t)MT * 2048 * 2;
constexpr size_t WS_ODG = WS_LA + (size_t)MT * 1024 * 4;
constexpr size_t WS_ODS = WS_ODG + (size_t)2 * MT * 1024 * 4;
constexpr size_t WS_XB = WS_ODS + (size_t)2 * MT * 1024 * 2;
constexpr size_t WS_OCAT = WS_ODS + (size_t)2 * MT * 1024 * 4;
constexpr size_t WS_QR = WS_OCAT + (size_t)MT * 3072 * 2;
constexpr size_t WS_SLAB = WS_QR + (size_t)M_LAT * 1024 * 2;
constexpr size_t WS_END = WS_SLAB + (size_t)256 * 65536 * 4;
static_assert(WS_WGU % 256 == 0 && WS_XN % 256 == 0 && WS_BIG % 256 == 0 && WS_OCAT % 256 == 0, "ws alignment");
constexpr int CW_BAR = 4096;
constexpr int CW_Q = 16384;
constexpr int CW_SK = 32768;

constexpr int RING_BYTES = 131072;
constexpr int MISC_OFF = RING_BYTES + 320;
constexpr int LDS_BYTES = 147456;
constexpr int NWAVES = 8;

DI unsigned pk2(float lo, float hi) { f32x2 v = {lo, hi}; bf16x2_t b = __builtin_convertvector(v, bf16x2_t); return __builtin_bit_cast(unsigned, b); }
DI float bflo(unsigned u) { return __uint_as_float(u << 16); }
DI float bfhi(unsigned u) { return __uint_as_float(u & 0xffff0000u); }
DI float bf2f(unsigned short s) { return __uint_as_float(((unsigned)s) << 16); }
DI float bf2f_s(short s) { return __uint_as_float(((unsigned)(unsigned short)s) << 16); }
DI unsigned short f2bf(float f) { return (unsigned short)(pk2(f, 0.f) & 0xffffu); }
DI float wave_sum(float v) {
#pragma unroll
    for (int o = 1; o < 64; o <<= 1) v += __shfl_xor(v, o);
    return v;
}
DI float fast_exp(float x) { return __builtin_amdgcn_exp2f(x * 1.4426950408889634f); }
DI float fast_sigmoid(float x) { return __builtin_amdgcn_rcpf(1.0f + fast_exp(-x)); }
DI float fast_silu(float x) { return x * fast_sigmoid(x); }
DI float softplusf(float x) { return fmaxf(x, 0.f) + __logf(1.0f + __expf(-fabsf(x))); }
DI size_t kb64(int rows, int row, int k) { return ((size_t)(k >> 6) * rows + row) * 64 + (k & 63); }
constexpr int YLD = 256;
DI size_t yaddr(int row, int col) { return ((size_t)(col >> 8) * MT + row) * YLD + (col & 255); }
DI int opaque_s(int x) { asm volatile("" : "+s"(x)); return x; }
DI int crow(int r, int hi) { return (r & 3) + 8 * (r >> 2) + 4 * hi; }
#define LDS_WAIT() asm volatile("s_waitcnt lgkmcnt(0)" ::: "memory")
#define VM_WAIT() asm volatile("s_waitcnt vmcnt(0)" ::: "memory")
#define RLX_AGENT __ATOMIC_RELAXED, __HIP_MEMORY_SCOPE_AGENT

namespace pg8 {
constexpr int BM = 256, BK = 64, HALF = 128, HTB = HALF * BK * 2, STAGE_BYTES = 8 * HTB, NXCD = 8, WGM = 8;
__host__ __device__ __forceinline__ int lds_byte(int r, int c) { const int st = (r >> 4) * 2 + (c >> 5), rr = r & 15, cc = c & 31, ob = rr * 64 + cc * 2; return st * 1024 + (ob ^ (((ob >> 9) & 1) << 5)); }
__host__ __device__ __forceinline__ void stage_rc(int b, int& R, int& C) { const int st = b / 1024, sb = b % 1024, swz = sb ^ (((sb >> 9) & 1) << 5); R = (st >> 1) * 16 + swz / 64; C = (st & 1) * 32 + (swz % 64) / 2; }
__host__ __device__ __forceinline__ int perm32(int rho) { const int n = rho >> 4, i = rho & 15; return 8 * (i >> 2) + 4 * n + (i & 3); }

struct Unit { int pm, pn, seg, k0, nt, role; };
struct Prob {
    const char* A; const char* Bt; int lda, ldb;
    size_t kstepA, kstepB;
    int nM, nN, ntk, nseg; size_t a_seg, b_seg;
    int G, c;
    DI bool next(int i, Unit& u) const {
        const int nwg = nM * nN; long L = (long)i * G + c; if (L >= (long)nwg * nseg) return false;
        u.seg = (int)(L / nwg); L -= (long)u.seg * nwg; u.k0 = 0; u.nt = ntk; u.role = 0;
        int wgid = (int)L; { const int q = nwg / NXCD, r = nwg % NXCD, xcd = wgid % NXCD, off = wgid / NXCD; wgid = (xcd < r ? xcd * (q + 1) : r * (q + 1) + (xcd - r) * q) + off; }
        const int nig = WGM * nN, gid = wgid / nig, fm = gid * WGM, gsz = (nM - fm) < WGM ? (nM - fm) : WGM;
        u.pm = fm + ((wgid % nig) % gsz); u.pn = (wgid % nig) / gsz; return true;
    }
    DI const char* aptr(const Unit& u) const { return A + (size_t)u.pm * BM * lda * 2 + (size_t)u.seg * a_seg; }
    DI const char* bptr(const Unit& u) const { return Bt + (size_t)u.pn * BM * ldb * 2 + (size_t)u.seg * b_seg; }
    DI void acc_init(const Unit&, f32x4 (&acc)[2][2][4][2], int) const {
#pragma unroll
        for (int a = 0; a < 2; ++a)
#pragma unroll
            for (int b = 0; b < 2; ++b)
#pragma unroll
                for (int m = 0; m < 4; ++m)
#pragma unroll
                    for (int n = 0; n < 2; ++n) acc[a][b][m][n] = (f32x4){0.f, 0.f, 0.f, 0.f};
    }
};
struct ProbSK {
    const char* A; const char* Bt; int lda, ldb, q4, vc, G;
    size_t kstepA, kstepB;
    DI bool next(int i, Unit& u) const {
        const int v = (i >> 1) * G + vc; if (v >= 256) return false;
        const int r = v & 3, gq = v >> 2; const bool quarter = (r < 3) == ((i & 1) == 0); int t;
        if (quarter) { t = 256 + gq; u.k0 = r * q4; u.nt = q4; u.role = r < 3 ? 1 : 2; }
        else { t = r == 3 ? gq : 64 + gq * 3 + r; u.k0 = 0; u.nt = 4 * q4; u.role = 0; }
        u.pm = t >> 3; u.pn = t & 7; u.seg = v; return true;
    }
    DI const char* aptr(const Unit& u) const { return A + (size_t)u.pm * BM * lda * 2 + (size_t)u.k0 * kstepA; }
    DI const char* bptr(const Unit& u) const { return Bt + (size_t)u.pn * BM * ldb * 2 + (size_t)u.k0 * kstepB; }
    const float* slab; unsigned* flags;
    DI void acc_init(const Unit& u, f32x4 (&acc)[2][2][4][2], int tid) const {
        if (u.role == 2) {
            if (tid < 64) {
                unsigned sp = 0;
                for (int j = 1; j <= 3; ++j)
                    while ((unsigned)__builtin_amdgcn_readfirstlane(__hip_atomic_load(flags + (u.seg - j) * 64, RLX_AGENT)) < 8u) { __builtin_amdgcn_s_sleep(2); if (++sp > (1u << 22)) break; }
                __builtin_amdgcn_fence(__ATOMIC_ACQUIRE, "agent");
                asm volatile("s_waitcnt vmcnt(0)" ::: "memory");
            }
            asm volatile("" ::: "memory"); __builtin_amdgcn_s_barrier(); asm volatile("" ::: "memory");
            const char* base = (const char*)(slab + (size_t)(u.seg - 3) * 65536); unsigned voff = (unsigned)tid * 16u; asm volatile("" : "+v"(voff));
#pragma unroll
            for (int a = 0; a < 2; ++a)
#pragma unroll
                for (int b = 0; b < 2; ++b)
#pragma unroll
                    for (int m = 0; m < 4; ++m) { const char* p = base + (size_t)(((a * 2 + b) * 4 + m) * 8192) + voff;
                        const u32x4 x = *(const u32x4*)p, y = *(const u32x4*)(p + 262144), z = *(const u32x4*)(p + 524288);
                        acc[a][b][m][0] = (f32x4){bflo(x.x) + bflo(y.x) + bflo(z.x), bfhi(x.x) + bfhi(y.x) + bfhi(z.x), bflo(x.y) + bflo(y.y) + bflo(z.y), bfhi(x.y) + bfhi(y.y) + bfhi(z.y)};
                        acc[a][b][m][1] = (f32x4){bflo(x.z) + bflo(y.z) + bflo(z.z), bfhi(x.z) + bfhi(y.z) + bfhi(z.z), bflo(x.w) + bflo(y.w) + bflo(z.w), bfhi(x.w) + bfhi(y.w) + bfhi(z.w)}; }
            asm volatile("s_waitcnt vmcnt(0)" ::: "memory");
        } else {
#pragma unroll
            for (int a = 0; a < 2; ++a)
#pragma unroll
                for (int b = 0; b < 2; ++b)
#pragma unroll
                    for (int m = 0; m < 4; ++m)
#pragma unroll
                        for (int n = 0; n < 2; ++n) acc[a][b][m][n] = (f32x4){0.f, 0.f, 0.f, 0.f};
        }
    }
};

template <class Epi, class PB>
DI void gemm_phase(LAS unsigned char* lds, const PB& S, const Epi& E) {
    int tid_ = threadIdx.x; asm volatile("" : "+v"(tid_));
    const int tid = tid_, wid = __builtin_amdgcn_readfirstlane(tid >> 6), lane = tid & 63, wr = wid >> 2, wc = wid & 3, fr = lane & 15, fq = lane >> 4;
    unsigned voffA[2], voffB[2];
#pragma unroll
    for (int i = 0; i < 2; ++i) { int R, C; stage_rc(tid * 16 + i * 8192, R, C); const int Rb = Epi::PERM ? ((R & ~31) + perm32(R & 31)) : R;
        voffA[i] = (unsigned)(R * S.lda + C) * 2u; voffB[i] = (unsigned)(Rb * S.ldb + C) * 2u; }
    const size_t kstepA = S.kstepA, kstepB = S.kstepB;
    const size_t hstepA = (size_t)HALF * S.lda * 2, hstepB = (size_t)HALF * S.ldb * 2;
    const unsigned ldsw = (unsigned)wid * 1024u;
    const int aoff = lds_byte(wr * 64 + fr, fq * 8), boff = lds_byte(wc * 32 + fr, fq * 8);
#define PG8_SA(b, h) (((b) * 2 + (h)) * HTB)
#define PG8_SB(b, h) ((4 + (b) * 2 + (h)) * HTB)
#define PG8_STAGE(bufoff, gbase, voff) do { _Pragma("unroll") for (int _i = 0; _i < 2; ++_i) \
        __builtin_amdgcn_global_load_lds((const unsigned*)((const char*)(gbase) + (voff)[_i]), (LAS unsigned*)(lds + (bufoff) + ldsw + _i * 8192), 16, 0, 0); } while (0)
#define PG8_LDA(dst, b, h) do { _Pragma("unroll") for (int m = 0; m < 4; ++m) _Pragma("unroll") for (int k = 0; k < 2; ++k) dst[m][k] = *(const LAS bf16x8*)(lds + PG8_SA(b, h) + aoff + m * 2048 + k * 1024); } while (0)
#define PG8_LDB(dst, b, h) do { _Pragma("unroll") for (int n = 0; n < 2; ++n) _Pragma("unroll") for (int k = 0; k < 2; ++k) dst[n][k] = *(const LAS bf16x8*)(lds + PG8_SB(b, h) + boff + n * 2048 + k * 1024); } while (0)
#define PG8_MMA(ai, bj, At, Bt) do { __builtin_amdgcn_s_setprio(1); _Pragma("unroll") for (int m = 0; m < 4; ++m) _Pragma("unroll") for (int n = 0; n < 2; ++n) _Pragma("unroll") for (int k = 0; k < 2; ++k) \
        acc[ai][bj][m][n] = __builtin_amdgcn_mfma_f32_16x16x32_bf16(Bt[n][k], At[m][k], acc[ai][bj][m][n], 0, 0, 0); __builtin_amdgcn_s_setprio(0); } while (0)
#define PG8_WAIT_V(n) asm volatile("s_waitcnt vmcnt(" #n ")" ::: "memory")
#define PG8_WAIT_L(n) asm volatile("s_waitcnt lgkmcnt(" #n ")" ::: "memory")
#define PG8_BAR __builtin_amdgcn_s_barrier()
#define PG8_SCHED __builtin_amdgcn_sched_barrier(0)
    Unit cur, nxt; int ui = 0;
    if (!S.next(0, cur)) return;
    f32x4 acc[2][2][4][2];
#pragma unroll
    for (int a = 0; a < 2; ++a)
#pragma unroll
        for (int b = 0; b < 2; ++b)
#pragma unroll
            for (int m = 0; m < 4; ++m)
#pragma unroll
                for (int n = 0; n < 2; ++n) acc[a][b][m][n] = (f32x4){0.f, 0.f, 0.f, 0.f};
    bf16x8 At[4][2], B0[2][2], B1[2][2];
    const char* cA = S.aptr(cur); const char* cB = S.bptr(cur);
    PG8_STAGE(PG8_SB(0, 0), cB, voffB); PG8_STAGE(PG8_SB(0, 1), cB + hstepB, voffB); PG8_STAGE(PG8_SA(0, 0), cA, voffA); PG8_STAGE(PG8_SA(0, 1), cA + hstepA, voffA);
    if (wr == 1) PG8_BAR;
    PG8_WAIT_V(2); PG8_BAR;
    PG8_STAGE(PG8_SB(1, 0), cB + kstepB, voffB); PG8_STAGE(PG8_SA(1, 0), cA + kstepA, voffA); PG8_STAGE(PG8_SB(1, 1), cB + hstepB + kstepB, voffB);
    PG8_WAIT_V(6); PG8_BAR;
    for (;;) {
        const bool has_next = S.next(ui + 1, nxt);
        const char* nA = has_next ? S.aptr(nxt) : cA; const char* nB = has_next ? S.bptr(nxt) : cB;
        const int nt = cur.nt;
        for (int t = 0; t < nt; t += 2) {
            const bool last = (t == nt - 2);
            const char* a1 = cA + (size_t)(t + 1) * kstepA;
            const char* a2 = last ? nA : cA + (size_t)(t + 2) * kstepA; const char* b2 = last ? nB : cB + (size_t)(t + 2) * kstepB;
            const char* a3 = a2 + kstepA; const char* b3 = b2 + kstepB;
            PG8_LDB(B0, 0, 0); PG8_LDB(B1, 0, 1); PG8_SCHED; PG8_LDA(At, 0, 0); PG8_STAGE(PG8_SA(1, 1), a1 + hstepA, voffA);
            PG8_WAIT_V(8); PG8_WAIT_L(0); PG8_BAR; PG8_MMA(0, 0, At, B0); PG8_MMA(0, 1, At, B1); PG8_BAR; PG8_SCHED;
            PG8_LDA(At, 0, 1); PG8_STAGE(PG8_SB(0, 0), b2, voffB); PG8_STAGE(PG8_SB(0, 1), b2 + hstepB, voffB); PG8_STAGE(PG8_SA(0, 0), a2, voffA);
            PG8_WAIT_V(8); PG8_WAIT_L(0); PG8_BAR; PG8_MMA(1, 0, At, B0); PG8_MMA(1, 1, At, B1); PG8_BAR; PG8_SCHED;
            PG8_LDB(B0, 1, 0); PG8_LDB(B1, 1, 1); PG8_SCHED; PG8_LDA(At, 1, 0); PG8_STAGE(PG8_SA(0, 1), a2 + hstepA, voffA);
            PG8_WAIT_V(8); PG8_WAIT_L(0); PG8_BAR; PG8_MMA(0, 0, At, B0); PG8_MMA(0, 1, At, B1); PG8_BAR; PG8_SCHED;
            PG8_LDA(At, 1, 1); PG8_STAGE(PG8_SB(1, 0), b3, voffB); PG8_STAGE(PG8_SB(1, 1), b3 + hstepB, voffB); PG8_STAGE(PG8_SA(1, 0), a3, voffA);
            PG8_WAIT_V(8); PG8_WAIT_L(0); PG8_BAR; PG8_MMA(1, 0, At, B0); PG8_MMA(1, 1, At, B1); PG8_BAR; PG8_SCHED;
        }
#if PG8_ALIGN
        if (wr == 0) PG8_BAR;
#endif
        E(acc, cur, wr, wc, fr, fq);
        if (!has_next) break;
        S.acc_init(nxt, acc, tid);
        cur = nxt; cA = nA; cB = nB; ++ui;
#if PG8_ALIGN
        if (wr == 1) PG8_BAR;
#endif
    }
    PG8_WAIT_V(0);
#if !PG8_ALIGN
    if (wr == 0) PG8_BAR;
#endif
    PG8_BAR;
#undef PG8_SA
#undef PG8_SB
#undef PG8_STAGE
#undef PG8_LDA
#undef PG8_LDB
#undef PG8_MMA
#undef PG8_WAIT_V
#undef PG8_WAIT_L
#undef PG8_BAR
#undef PG8_SCHED
}
}

DI int mod_index(int pm) { return pm < 32 ? 0 : 1 + ((pm - 32) >> 2); }
struct EpiSwiGLU {
    static constexpr bool PERM = true;
    bf16_t* H;
    DI void operator()(f32x4 (&acc)[2][2][4][2], const pg8::Unit& u, int wr, int wc, int fr, int fq) const {
        const int row0 = u.pm * 256 + wr * 64 + fr, col0 = u.pn * 128 + wc * 32 + 8 * fq;
#pragma unroll
        for (int ai = 0; ai < 2; ++ai)
#pragma unroll
            for (int m = 0; m < 4; ++m) {
                bf16_t* rowp = H + kb64(MT, row0 + ai * 128 + m * 16, col0);
                const f32x4 g0 = acc[ai][0][m][0], g1 = acc[ai][0][m][1], u0 = acc[ai][1][m][0], u1 = acc[ai][1][m][1];
                u32x4 w;
                w.x = pk2(fast_silu(g0[0]) * u0[0], fast_silu(g0[1]) * u0[1]); w.y = pk2(fast_silu(g0[2]) * u0[2], fast_silu(g0[3]) * u0[3]);
                w.z = pk2(fast_silu(g1[0]) * u1[0], fast_silu(g1[1]) * u1[1]); w.w = pk2(fast_silu(g1[2]) * u1[2], fast_silu(g1[3]) * u1[3]);
                *(u32x4*)rowp = w;
            }
    }
};
template <bool F32IN> struct EpiResid {
    static constexpr bool PERM = true; static constexpr int MB = F32IN ? 2 : 4;
    bf16_t* X; const float* gvec; float coef;
    const float* Xa; const float* Xb;
    DI void operator()(f32x4 (&acc)[2][2][4][2], const pg8::Unit& u, int wr, int wc, int fr, int fq) const {
        const int row0 = u.pm * 256 + wr * 64 + fr, col0 = u.pn * 256 + wc * 32 + 8 * fq;
        const float* Xi = u.pm < 32 ? Xa : Xb;
        const float* gv = gvec + (size_t)mod_index(u.pm) * NMOD + col0;
        f32x4 g[2][2];
#pragma unroll
        for (int bj = 0; bj < 2; ++bj)
#pragma unroll
            for (int n = 0; n < 2; ++n) g[bj][n] = *(const f32x4*)(gv + bj * 128 + n * 4) * coef;
        if (F32IN) {
#pragma unroll
            for (int ai = 0; ai < 2; ++ai)
#pragma unroll
                for (int mb = 0; mb < 4; mb += 2) {
                    f32x4 tv[2][2][2];
#pragma unroll
                    for (int mm = 0; mm < 2; ++mm) { const size_t ro = (size_t)(row0 + ai * 128 + (mb + mm) * 16) * DM + col0;
#pragma unroll
                        for (int bj = 0; bj < 2; ++bj) { tv[mm][bj][0] = *(const f32x4*)(Xi + ro + bj * 128); tv[mm][bj][1] = *(const f32x4*)(Xi + ro + bj * 128 + 4); } }
#pragma unroll
                    for (int mm = 0; mm < 2; ++mm) { const int m = mb + mm; bf16_t* rowp = X + ((size_t)u.pn * MT + row0 + ai * 128 + m * 16) * YLD + wc * 32 + 8 * fq;
#pragma unroll
                        for (int bj = 0; bj < 2; ++bj) { const f32x4 r0 = tv[mm][bj][0] + g[bj][0] * acc[ai][bj][m][0], r1 = tv[mm][bj][1] + g[bj][1] * acc[ai][bj][m][1];
                            u32x4 w; w.x = pk2(r0[0], r0[1]); w.y = pk2(r0[2], r0[3]); w.z = pk2(r1[0], r1[1]); w.w = pk2(r1[2], r1[3]); *(u32x4*)(rowp + bj * 128) = w; } }
                }
        } else {
            u32x4 tv[2][4][2];
            bf16_t* Xw = X + ((size_t)u.pn * MT + u.pm * 256 + wr * 64) * YLD + wc * 32;
            const unsigned lo = (unsigned)(fr * YLD + 8 * fq);
#define ER_LOAD(i) tv[(i) >> 3][((i) >> 1) & 3][(i) & 1] = *(const u32x4*)(Xw + (size_t)((((i) >> 3) * 128 + (((i) >> 1) & 3) * 16) * YLD + ((i) & 1) * 128) + lo)
#define ER_DONE(i) do { const int ai = (i) >> 3, m = ((i) >> 1) & 3, bj = (i) & 1; const u32x4 t = tv[ai][m][bj]; \
                const f32x4 r0 = (f32x4){bflo(t.x), bfhi(t.x), bflo(t.y), bfhi(t.y)} + g[bj][0] * acc[ai][bj][m][0], r1 = (f32x4){bflo(t.z), bfhi(t.z), bflo(t.w), bfhi(t.w)} + g[bj][1] * acc[ai][bj][m][1]; \
                u32x4 w; w.x = pk2(r0[0], r0[1]); w.y = pk2(r0[2], r0[3]); w.z = pk2(r1[0], r1[1]); w.w = pk2(r1[2], r1[3]); \
                *(u32x4*)(Xw + (size_t)((ai * 128 + m * 16) * YLD + bj * 128) + lo) = w; } while (0)
#pragma unroll
            for (int i = 0; i < 12; ++i) ER_LOAD(i);
            asm volatile("" ::: "memory");
#pragma unroll
            for (int i = 0; i < 4; ++i) ER_DONE(i);
            asm volatile("" ::: "memory");
#pragma unroll
            for (int i = 12; i < 16; ++i) ER_LOAD(i);
            asm volatile("" ::: "memory");
#pragma unroll
            for (int i = 4; i < 16; ++i) ER_DONE(i);
#undef ER_LOAD
#undef ER_DONE
        }
    }
};
template <class Epi> struct EpiSK {
    static constexpr bool PERM = Epi::PERM;
    Epi E; float* slab; unsigned* flags;
    DI void operator()(f32x4 (&acc)[2][2][4][2], const pg8::Unit& u, int wr, int wc, int fr, int fq) const {
        const int tid = threadIdx.x;
        const unsigned voff = (unsigned)tid * 16u;
        if (u.role == 1) {
            const char* base = (const char*)(slab + (size_t)u.seg * 65536);
#pragma unroll
            for (int ai = 0; ai < 2; ++ai)
#pragma unroll
                for (int bj = 0; bj < 2; ++bj)
#pragma unroll
                    for (int m = 0; m < 4; ++m) { const f32x4 a0 = acc[ai][bj][m][0], a1 = acc[ai][bj][m][1];
                        u32x4 w; w.x = pk2(a0[0], a0[1]); w.y = pk2(a0[2], a0[3]); w.z = pk2(a1[0], a1[1]); w.w = pk2(a1[2], a1[3]);
                        asm volatile("global_store_dwordx4 %0, %1, %2 sc1" :: "v"(voff), "v"(w), "s"(base) : "memory"); base += 8192; asm volatile("" : "+s"(base)); }
            asm volatile("s_waitcnt vmcnt(0)" ::: "memory");
            if ((tid & 63) == 0) __hip_atomic_fetch_add(flags + u.seg * 64, 1u, RLX_AGENT);
            return;
        }
        if (PROBE_DUP != 0 && E.coef == 0.f) return;
        E(acc, u, wr, wc, fr, fq);
    }
};
struct EpiY {
    static constexpr bool PERM = true;
    bf16_t* Y; float* YS;
    DI void operator()(f32x4 (&acc)[2][2][4][2], const pg8::Unit& u, int wr, int wc, int fr, int fq) const {
        const int row0 = u.pm * 256 + wr * 64 + fr, col0 = u.pn * 256 + wc * 32 + 8 * fq;
#pragma unroll
        for (int ai = 0; ai < 2; ++ai)
#pragma unroll
            for (int m = 0; m < 4; ++m) {
                bf16_t* rowp = Y + ((size_t)u.pn * MT + row0 + ai * 128 + m * 16) * YLD + wc * 32 + 8 * fq;
#pragma unroll
                for (int bj = 0; bj < 2; ++bj) { const f32x4 v0 = acc[ai][bj][m][0], v1 = acc[ai][bj][m][1];
                    u32x4 w; w.x = pk2(v0[0], v0[1]); w.y = pk2(v0[2], v0[3]); w.z = pk2(v1[0], v1[1]); w.w = pk2(v1[2], v1[3]);
                    *(u32x4*)(rowp + bj * 128) = w; }
            }
        if (u.pn == 54 && wc < 2) {
#pragma unroll
            for (int ai = 0; ai < 2; ++ai)
#pragma unroll
                for (int m = 0; m < 4; ++m) { float* p = YS + (size_t)(row0 + ai * 128 + m * 16) * 64 + wc * 32 + 8 * fq;
                    *(f32x4*)p = acc[ai][0][m][0]; *(f32x4*)(p + 4) = acc[ai][0][m][1]; }
        }
    }
};
struct EpiBranch {
    static constexpr bool PERM = true;
    const bf16_t* Y; bf16_t* PB;
    DI void operator()(f32x4 (&acc)[2][2][4][2], const pg8::Unit& u, int wr, int wc, int fr, int fq) const {
        const int row0 = u.pm * 256 + wr * 64 + fr, col0 = u.pn * 256 + wc * 32 + 8 * fq;
        bf16_t* P = PB + (size_t)u.seg * MT * DM;
#pragma unroll
        for (int ai = 0; ai < 2; ++ai) {
            u32x4 gb[4][2];
#pragma unroll
            for (int m = 0; m < 4; ++m)
#pragma unroll
                for (int bj = 0; bj < 2; ++bj) gb[m][bj] = *(const u32x4*)(Y + ((size_t)(YC_BR / 256 + u.seg * 8 + u.pn) * MT + row0 + ai * 128 + m * 16) * YLD + wc * 32 + 8 * fq + bj * 128);
#pragma unroll
            for (int m = 0; m < 4; ++m) {
                const size_t row = (size_t)(row0 + ai * 128 + m * 16);
#pragma unroll
                for (int bj = 0; bj < 2; ++bj) {
                    const u32x4 g = gb[m][bj]; const f32x4 v0 = acc[ai][bj][m][0], v1 = acc[ai][bj][m][1];
                    u32x4 w;
                    w.x = pk2(fast_sigmoid(bflo(g.x)) * v0[0], fast_sigmoid(bfhi(g.x)) * v0[1]); w.y = pk2(fast_sigmoid(bflo(g.y)) * v0[2], fast_sigmoid(bfhi(g.y)) * v0[3]);
                    w.z = pk2(fast_sigmoid(bflo(g.z)) * v1[0], fast_sigmoid(bfhi(g.z)) * v1[1]); w.w = pk2(fast_sigmoid(bflo(g.w)) * v1[2], fast_sigmoid(bfhi(g.w)) * v1[3]);
                    *(u32x4*)(P + ((size_t)u.pn * MT + row) * YLD + wc * 32 + 8 * fq + bj * 128) = w;
                }
            }
        }
    }
};

#define XB_TMO      128
#define XB_XCNT(j)  (256  + 64 * (j))
#define XB_XSUB(j)  (1280 + 64 * (j))
#define XB_XGEN(j)  (2304 + 64 * (j))
#define XB_TOP      3328
#define XB_TOPGEN   3392
#define XCD_BAR_WORDS 3456
#define XB_SPIN_CAP (1u << 18)
DI unsigned xb_ld(GAS unsigned* p)              { return __hip_atomic_load(p, __ATOMIC_RELAXED, __HIP_MEMORY_SCOPE_AGENT); }
DI unsigned xb_add(GAS unsigned* p, unsigned v) { return __hip_atomic_fetch_add(p, v, __ATOMIC_RELAXED, __HIP_MEMORY_SCOPE_AGENT); }
DI unsigned xb_xcc_id() { return (unsigned)__builtin_amdgcn_s_getreg((3 << 11) | 20) & 0xFu; }
#define XB_SPIN(cond, bar) do { unsigned _sp = 0; while (cond) { __builtin_amdgcn_s_sleep(1); \
    if ((++_sp & 255u) == 0u) { if (xb_ld(&(bar)[XB_TMO])) break; if (_sp > XB_SPIN_CAP) { xb_add(&(bar)[XB_TMO], 1u); break; } } } } while (0)
struct XcdBarrier { unsigned* bar; unsigned x; volatile LAS unsigned* st; };
DI XcdBarrier xcd_barrier_post(unsigned* bar, volatile LAS unsigned* st) {
    XcdBarrier b; b.bar = bar; b.x = xb_xcc_id(); b.st = st;
    if (threadIdx.x == 0) (void)xb_add(&((GAS unsigned*)bar)[XB_XCNT(b.x)], 1u);
    return b;
}
DI void xcd_barrier_complete(GAS unsigned* bar, unsigned x, unsigned& nloc, unsigned& nx) {
    const unsigned G = gridDim.x * gridDim.y * gridDim.z;
    unsigned sum, cnt, mine, sp = 0u;
    for (;;) {
        sum = 0u; cnt = 0u; mine = 0u;
#pragma unroll
        for (unsigned j = 0; j < 16; ++j) { const unsigned c = xb_ld(&bar[XB_XCNT(j)]); sum += c; cnt += (c > 0u) ? 1u : 0u; mine = (j == x) ? c : mine; }
        if (sum == G) break;
        __builtin_amdgcn_s_sleep(1);
        if ((++sp & 255u) == 0u) { if (xb_ld(&bar[XB_TMO])) break; if (sp > XB_SPIN_CAP) { xb_add(&bar[XB_TMO], 1u); break; } }
    }
    nloc = mine > 0u ? mine : 1u; nx = cnt > 0u ? cnt : 1u;
}
DI void xcd_barrier(const XcdBarrier& b) {
    asm volatile("s_waitcnt vmcnt(0)" ::: "memory");
    __syncthreads();
    if (threadIdx.x == 0) {
        GAS unsigned* bar = (GAS unsigned*)b.bar; asm volatile("" : "+s"(bar));
        __builtin_amdgcn_s_waitcnt(0);
        unsigned nloc = b.st[0], nx = b.st[1];
        if (nloc == 0u) { xcd_barrier_complete(bar, b.x, nloc, nx); b.st[0] = nloc; b.st[1] = nx; }
        const unsigned old = xb_add(&bar[XB_XSUB(b.x)], 1u);
        const unsigned gen = old / nloc;
        if (old + 1u == (gen + 1u) * nloc) {
            __builtin_amdgcn_fence(__ATOMIC_RELEASE, "agent");
            asm volatile("s_waitcnt vmcnt(0)" ::: "memory");
            const unsigned og = xb_add(&bar[XB_TOP], 1u);
            const unsigned tg = og / nx;
            if (og + 1u == (tg + 1u) * nx) xb_add(&bar[XB_TOPGEN], 1u);
            else XB_SPIN(xb_ld(&bar[XB_TOPGEN]) == tg, bar);
            __builtin_amdgcn_fence(__ATOMIC_ACQUIRE, "agent");
            xb_add(&bar[XB_XGEN(b.x)], 1u);
            asm volatile("s_waitcnt vmcnt(0)" ::: "memory");
        } else {
            XB_SPIN(xb_ld(&bar[XB_XGEN(b.x)]) == gen, bar);
            __builtin_amdgcn_fence(__ATOMIC_ACQUIRE, "agent");
            asm volatile("s_waitcnt vmcnt(0)" ::: "memory");
        }
    }
    __syncthreads();
}

namespace att {
constexpr int D = 128, NW = 8, QBLK = 32, KVBLK = 64;
constexpr float SCALE = 0.088388347648318440f;
constexpr float THR = 8.f;
constexpr size_t SHM_V = KVBLK * D * 2, SHM_K = KVBLK * D * 2;
#define KSWZ(row, colB) ((row) * 256 + ((colB) ^ (((row) & 7) << 4)))
#define SBAR() __builtin_amdgcn_sched_barrier(0)
DI unsigned cvtpk(float lo, float hi) { return pk2(lo, hi); }
struct Tile { const bf16_t* k; const bf16_t* v; int ldk, ldv, dpos, masked; };

DI void partialSM(f32x16& p0, f32x16& p1, float& m_reg, float& mn, float& alpha) {
  constexpr float C = SCALE * 1.4426950408889634f;
  float pmax = p0[0];
#pragma unroll
  for (int r = 1; r < 16; ++r) pmax = fmaxf(pmax, p0[r]);
#pragma unroll
  for (int r = 0; r < 16; ++r) pmax = fmaxf(pmax, p1[r]);
  { auto rr = __builtin_amdgcn_permlane32_swap(__float_as_uint(pmax), __float_as_uint(pmax), false, false);
    pmax = fmaxf(__uint_as_float(rr[0]), __uint_as_float(rr[1])); }
  if (__builtin_expect(__all(pmax - m_reg <= THR / SCALE), 1)) { mn = m_reg; alpha = 1.f; }
  else { mn = fmaxf(m_reg, pmax); alpha = __builtin_amdgcn_exp2f((m_reg - mn) * C); m_reg = mn; }
  float mnC = -mn * C;
#pragma unroll
  for (int r = 0; r < 16; ++r) p0[r] = fmaf(p0[r], C, mnC);
#pragma unroll
  for (int r = 0; r < 16; ++r) p1[r] = fmaf(p1[r], C, mnC);
#pragma unroll
  for (int r = 0; r < 16; ++r) p0[r] = __builtin_amdgcn_exp2f(p0[r]);
}
DI void finishSM(f32x16& p0, f32x16& p1, float alpha, float& l_reg, bf16x8& pa0, bf16x8& pa1, bf16x8& pa2, bf16x8& pa3) {
#pragma unroll
  for (int r = 0; r < 16; ++r) p1[r] = __builtin_amdgcn_exp2f(p1[r]);
  float ps = 0;
#pragma unroll
  for (int r = 0; r < 16; ++r) ps += p0[r];
#pragma unroll
  for (int r = 0; r < 16; ++r) ps += p1[r];
  { auto rr = __builtin_amdgcn_permlane32_swap(__float_as_uint(ps), __float_as_uint(ps), false, false);
    ps = __uint_as_float(rr[0]) + __uint_as_float(rr[1]); }
  l_reg = l_reg * alpha + ps;
#define PK4(P, BASE, OUT) do { unsigned a0 = cvtpk(P[BASE + 0], P[BASE + 1]), a1 = cvtpk(P[BASE + 2], P[BASE + 3]);   \
    unsigned b0 = cvtpk(P[BASE + 4], P[BASE + 5]), b1 = cvtpk(P[BASE + 6], P[BASE + 7]);                              \
    auto r0 = __builtin_amdgcn_permlane32_swap(a0, b0, false, false); auto r1 = __builtin_amdgcn_permlane32_swap(a1, b1, false, false); \
    u32x4 w = {r0[0], r1[0], r0[1], r1[1]}; OUT = __builtin_bit_cast(bf16x8, w); } while (0)
  PK4(p0, 0, pa0); PK4(p0, 8, pa1); PK4(p1, 0, pa2); PK4(p1, 8, pa3);
#undef PK4
}
DI void qkt(f32x16& p0, f32x16& p1, const char* Ks, const bf16x8* qr, int r32, int hi) {
#pragma unroll
  for (int i = 0; i < 16; ++i) { p0[i] = 0.f; p1[i] = 0.f; }
#pragma unroll
  for (int d0 = 0; d0 < 8; ++d0) { int cb = (d0 * 16 + hi * 8) * 2;
    bf16x8 b0 = *reinterpret_cast<const bf16x8*>(Ks + KSWZ(r32, cb));
    bf16x8 b1 = *reinterpret_cast<const bf16x8*>(Ks + KSWZ(32 + r32, cb));
    p0 = __builtin_amdgcn_mfma_f32_32x32x16_bf16(b0, qr[d0], p0, 0, 0, 0);
    p1 = __builtin_amdgcn_mfma_f32_32x32x16_bf16(b1, qr[d0], p1, 0, 0, 0); }
}
DI void amask(f32x16& p0, f32x16& p1, int dl, int hi) {
#pragma unroll
  for (int r = 0; r < 16; ++r) { const int kk = crow(r, hi);
    if ((unsigned)(dl + kk + 128) > 256u) p0[r] = -1e30f;
    if ((unsigned)(dl + kk + 32 + 128) > 256u) p1[r] = -1e30f; }
}
DI int v_st(int k, int c) { const int kk = (k & ~0xC) | ((k & 4) << 1) | ((k & 8) >> 1); return ((kk >> 3) * 4 + (c >> 5)) * 512 + ((kk & 7) * 32 + (c & 31)) * 2; }
DI int v_rd_base(int lane) { return ((lane & 3) << 3) | (((lane >> 2) & 3) << 6) | (((lane >> 4) & 1) << 5) | (((lane >> 5) & 1) << 8); }
constexpr int v_rd_off(int d0, int ks, int half) { return d0 * 512 + ks * 4096 + half * 2048; }
template <int OFF> DI s16x4 tr_read(int vb) {
  s16x4 r; asm volatile("ds_read_b64_tr_b16 %0, %1 offset:%2" : "=&v"(r) : "v"(vb), "i"(OFF) : "memory"); return r;
}
template <int D0> DI void pv_one(f32x16& od, int vb, bf16x8 pa0, bf16x8 pa1, bf16x8 pa2, bf16x8 pa3) {
  const s16x4 l0 = tr_read<v_rd_off(D0, 0, 0)>(vb), h0 = tr_read<v_rd_off(D0, 0, 1)>(vb), l1 = tr_read<v_rd_off(D0, 1, 0)>(vb), h1 = tr_read<v_rd_off(D0, 1, 1)>(vb);
  const s16x4 l2 = tr_read<v_rd_off(D0, 2, 0)>(vb), h2 = tr_read<v_rd_off(D0, 2, 1)>(vb), l3 = tr_read<v_rd_off(D0, 3, 0)>(vb), h3 = tr_read<v_rd_off(D0, 3, 1)>(vb);
  asm volatile("s_waitcnt lgkmcnt(0)" ::: "memory"); SBAR();
#define PK(L, H) (bf16x8){L[0], L[1], L[2], L[3], H[0], H[1], H[2], H[3]}
  od = __builtin_amdgcn_mfma_f32_32x32x16_bf16(pa0, PK(l0, h0), od, 0, 0, 0);
  od = __builtin_amdgcn_mfma_f32_32x32x16_bf16(pa1, PK(l1, h1), od, 0, 0, 0);
  od = __builtin_amdgcn_mfma_f32_32x32x16_bf16(pa2, PK(l2, h2), od, 0, 0, 0);
  od = __builtin_amdgcn_mfma_f32_32x32x16_bf16(pa3, PK(l3, h3), od, 0, 0, 0);
#undef PK
}
DI void pv_d0(f32x16* o, int vb, bf16x8 pa0, bf16x8 pa1, bf16x8 pa2, bf16x8 pa3) {
  pv_one<0>(o[0], vb, pa0, pa1, pa2, pa3); pv_one<1>(o[1], vb, pa0, pa1, pa2, pa3); pv_one<2>(o[2], vb, pa0, pa1, pa2, pa3); pv_one<3>(o[3], vb, pa0, pa1, pa2, pa3);
}
DI bf16x8 ld8(const bf16_t* p) { return *reinterpret_cast<const bf16x8*>(p); }

template <class TS>
DI void attn_unit(const bf16_t* __restrict__ Qb, int ldq, const TS& ts, int NT, float sink, bf16_t* __restrict__ Ob, int ldo, char* lds) {
  int tid_ = threadIdx.x; asm volatile("" : "+v"(tid_));
  const int tid = tid_, wid = tid >> 6, lane = tid & 63, r32 = lane & 31, hi = lane >> 5;
  char* V_lds = lds; char* K_lds = lds + 2 * SHM_V;
  float* ws = (float*)(lds + 2 * SHM_V + 2 * SHM_K) + wid * 64; float* li_l = ws; float* al_l = ws + 32;
  float m_reg = sink * (1.0f / SCALE), l_reg = 1.0f; f32x16 o[4]; bf16x8 qr[8];
#pragma unroll
  for (int d = 0; d < 4; ++d)
#pragma unroll
    for (int r = 0; r < 16; ++r) o[d][r] = 0.f;
  const bf16_t* Qw = Qb + (long)(wid * QBLK + r32) * ldq + hi * 8;
#pragma unroll
  for (int d0 = 0; d0 < 8; ++d0) qr[d0] = ld8(Qw + d0 * 16);
  const int sr = tid >> 4, sc = (tid & 15) * 8, vst0 = v_st(sr, sc), vst1 = v_st(32 + sr, sc);
  const int vb0 = (int)(uintptr_t)V_lds + v_rd_base(lane);
  const int dlane = -(wid * QBLK + r32);
  struct { bf16x8 vs0, vs1, ks0, ks1; } sr_[2];
#define SLOAD(i, J) do { const Tile T_ = ts(J); sr_[i].vs0 = ld8(T_.v + (long)sr * T_.ldv + sc); sr_[i].vs1 = ld8(T_.v + (long)(32 + sr) * T_.ldv + sc); \
    sr_[i].ks0 = ld8(T_.k + (long)sr * T_.ldk + sc); sr_[i].ks1 = ld8(T_.k + (long)(32 + sr) * T_.ldk + sc); } while (0)
#define SWRITE(b, i) do { *(bf16x8*)(V_lds + (b) * SHM_V + vst0) = sr_[i].vs0;          \
    *(bf16x8*)(V_lds + (b) * SHM_V + vst1) = sr_[i].vs1; int kc = sc * 2;               \
    *(bf16x8*)(K_lds + (b) * SHM_K + KSWZ(sr, kc)) = sr_[i].ks0;                       \
    *(bf16x8*)(K_lds + (b) * SHM_K + KSWZ(32 + sr, kc)) = sr_[i].ks1; } while (0)
#define SWAIT() asm volatile("s_waitcnt vmcnt(4)" ::: "memory")
#define RESC(a) do { if (__any((a) < 1.f)) { if (hi == 0) al_l[r32] = (a); asm volatile("s_waitcnt lgkmcnt(0)" ::: "memory"); \
    _Pragma("unroll") for (int d = 0; d < 4; ++d) _Pragma("unroll") for (int r = 0; r < 16; ++r) o[d][r] *= al_l[crow(r, hi)]; } } while (0)
#define MASK(P0, P1, J) do { const Tile T_ = ts(J); if (T_.masked) amask(P0, P1, T_.dpos + dlane, hi); } while (0)
  f32x16 pA0, pA1, pB0, pB1; float mnA, mnB, alA, alB; bf16x8 pa0, pa1, pa2, pa3;
  constexpr int SE = 0, SO = 1;
  SLOAD(SE, 0); asm volatile("s_waitcnt vmcnt(0)" ::: "memory"); SWRITE(0, SE); __syncthreads();
  qkt(pA0, pA1, K_lds, qr, r32, hi); MASK(pA0, pA1, 0); partialSM(pA0, pA1, m_reg, mnA, alA);
  SLOAD(SO, 1); if (2 < NT) SLOAD(SE, 2);
  SWAIT(); SWRITE(1, SO); __syncthreads();
  for (int j = 1; j + 1 < NT; j += 2) {
    SBAR(); qkt(pB0, pB1, K_lds + SHM_K, qr, r32, hi); MASK(pB0, pB1, j);
    finishSM(pA0, pA1, alA, l_reg, pa0, pa1, pa2, pa3); SBAR();
    SLOAD(SO, j + 2); SBAR();
    pv_d0(o, vb0, pa0, pa1, pa2, pa3); partialSM(pB0, pB1, m_reg, mnB, alB);
    __syncthreads(); SWAIT(); SWRITE(0, SE);
    RESC(alB); __syncthreads();
    SBAR(); qkt(pA0, pA1, K_lds, qr, r32, hi); MASK(pA0, pA1, j + 1);
    finishSM(pB0, pB1, alB, l_reg, pa0, pa1, pa2, pa3); SBAR();
    if (j + 3 < NT) SLOAD(SE, j + 3); SBAR();
    pv_d0(o, vb0 + (int)SHM_V, pa0, pa1, pa2, pa3); partialSM(pA0, pA1, m_reg, mnA, alA);
    __syncthreads(); SWAIT(); SWRITE(1, SO);
    RESC(alA); __syncthreads();
  }
  SBAR(); qkt(pB0, pB1, K_lds + SHM_K, qr, r32, hi); MASK(pB0, pB1, NT - 1);
  finishSM(pA0, pA1, alA, l_reg, pa0, pa1, pa2, pa3); SBAR();
  pv_d0(o, vb0, pa0, pa1, pa2, pa3); partialSM(pB0, pB1, m_reg, mnB, alB);
  __syncthreads(); RESC(alB);
  finishSM(pB0, pB1, alB, l_reg, pa0, pa1, pa2, pa3); SBAR();
  pv_d0(o, vb0 + (int)SHM_V, pa0, pa1, pa2, pa3);
  if (hi == 0) li_l[r32] = l_reg; asm volatile("s_waitcnt lgkmcnt(0)" ::: "memory");
  float rli[16];
#pragma unroll
  for (int r = 0; r < 16; ++r) rli[r] = __builtin_amdgcn_rcpf(li_l[crow(r, hi)]);
  bf16_t* Ow = Ob + (long)(wid * QBLK) * ldo;
#pragma unroll
  for (int r = 0; r < 16; ++r) { int orow = crow(r, hi);
#pragma unroll
    for (int d0 = 0; d0 < 4; ++d0) Ow[(long)orow * ldo + (long)(d0 >> 1) * ((long)MT * 64) + (d0 & 1) * 32 + r32] = f2bf(o[d0][r] * rli[r]); }
  __syncthreads();
#undef SLOAD
#undef SWRITE
#undef SWAIT
#undef RESC
#undef MASK
}
}

struct Frame {
    unsigned char* ws; float* out; const float* const* in;
    int G, bid;
};
#define MFMA32(a, b, c) __builtin_amdgcn_mfma_f32_32x32x16_bf16((a), (b), (c), 0, 0, 0)
DI bf16x8 pack_step(const f32x16& x, int s) {
    u32x4 p; p.x = pk2(x[8 * s + 0], x[8 * s + 1]); p.y = pk2(x[8 * s + 2], x[8 * s + 3]); p.z = pk2(x[8 * s + 4], x[8 * s + 5]); p.w = pk2(x[8 * s + 6], x[8 * s + 7]);
    return __builtin_bit_cast(bf16x8, p);
}
DI bf16x8 cat4(s16x4 lo, s16x4 hi) { return (bf16x8){lo[0], lo[1], lo[2], lo[3], hi[0], hi[1], hi[2], hi[3]}; }

constexpr int GL_QS = 0, GL_KS = 17408, GL_KT = 34816, GL_VT = 53248, GL_AS = 90112, GL_DS = 99328, GL_PART = 99840;
DI void gla_chain(const Frame& F, LAS unsigned char* lds, int item, int layer) {
    unsigned char* const ws_ = F.ws;
    int tid_ = threadIdx.x; asm volatile("" : "+v"(tid_));
    const int tid = tid_, lane = tid & 63, w = __builtin_amdgcn_readfirstlane(tid >> 6), r = lane & 31, hh = lane >> 5;
    const int dir = item & 1, h = (item >> 1) & 3, sq = item >> 3;
    const bool lat = sq < 2; const int b = lat ? sq : sq - 2;
    const int L = lat ? 1024 : 256, row0 = lat ? M_CTX + b * 1024 : b * 256, NC = L / 64;
    const bf16_t* Y = (const bf16_t*)(ws_ + WS_BIG); const bf16_t* LA = (const bf16_t*)(ws_ + WS_LA);
    bf16_t* OD = (bf16_t*)(ws_ + WS_ODG) + (size_t)dir * MT * 1024;
    LAS bf16_t* Qs = (LAS bf16_t*)(lds + GL_QS); LAS bf16_t* Ks = (LAS bf16_t*)(lds + GL_KS); LAS bf16_t* KT = (LAS bf16_t*)(lds + GL_KT);
    LAS bf16_t* VT = (LAS bf16_t*)(lds + GL_VT); LAS bf16_t* As = (LAS bf16_t*)(lds + GL_AS); LAS float* dS = (LAS float*)(lds + GL_DS); LAS float* partS = (LAS float*)(lds + GL_PART);
    f32x16 S[4];
    if (lat) { const float* st = F.in[5] + ((((size_t)b * 2 + layer) * 2 + dir) * 4 + h) * 128 * 256;
#pragma unroll
        for (int kt = 0; kt < 4; ++kt)
#pragma unroll
            for (int i = 0; i < 16; ++i) S[kt][i] = st[(size_t)(32 * kt + crow(i, hh)) * 256 + 32 * w + r];
    } else {
#pragma unroll
        for (int kt = 0; kt < 4; ++kt)
#pragma unroll
            for (int i = 0; i < 16; ++i) S[kt][i] = 0.f;
    }
    const int kp = tid & 63, sg = tid >> 6, vcc = tid >> 4, vsb = tid & 15;
#define WG_BAR() do { asm volatile("s_waitcnt lgkmcnt(0)" ::: "memory"); __builtin_amdgcn_s_barrier(); asm volatile("" ::: "memory"); } while (0)
#define GLA_LOAD(PROW, LAr, QVr, KVr, VVr) do { \
        _Pragma("unroll") for (int i = 0; i < 8; ++i) LAr[i] = *(const unsigned*)(LA + ((size_t)(dir * 4 + h) * MT + (PROW) + 8 * sg + i) * 128 + 2 * kp); \
        _Pragma("unroll") for (int i = 0; i < 4; ++i) VVr[i] = *(const bf16x8*)(Y + yaddr((PROW) + 4 * vsb + i, YC_GV + h * 256 + 8 * vcc)); \
        _Pragma("unroll") for (int i = 0; i < 8; ++i) { const size_t ro = yaddr((PROW) + 8 * sg + i, h * 128 + 2 * kp); QVr[i] = *(const unsigned*)(Y + ro + yaddr(0, YC_GQ)); KVr[i] = *(const unsigned*)(Y + ro + yaddr(0, YC_GK)); } } while (0)
    unsigned la[8], qv[8], kv[8]; bf16x8 vv[4];
    GLA_LOAD(row0 + 64 * (dir ? NC - 1 : 0), la, qv, kv, vv);
    for (int c = 0; c < NC; ++c) {
        const int pb = dir ? NC - 1 - c : c, prow = row0 + 64 * pb;
        { f32x2 part = {0.f, 0.f};
#pragma unroll
          for (int i = 0; i < 8; ++i) part += (f32x2){bflo(la[i]), bfhi(la[i])};
          *(LAS f32x2*)(partS + sg * 128 + 2 * kp) = part; }
        WG_BAR();
        f32x2 run = {0.f, 0.f}, total = {0.f, 0.f};
#pragma unroll
        for (int j = 0; j < 8; ++j) { const f32x2 p = *(const LAS f32x2*)(partS + j * 128 + 2 * kp); total += p; if (dir == 0 ? (j < sg) : (j > sg)) run += p; }
        const float eta = __expf(total[0]), etb = __expf(total[1]);
        float kha[8], khb[8];
#pragma unroll
        for (int ii = 0; ii < 8; ++ii) { const int i = dir == 0 ? ii : 7 - ii; run += (f32x2){bflo(la[i]), bfhi(la[i])}; const int t = 8 * sg + i;
            const float xa = run[0] * 1.4426950408889634f, xb = run[1] * 1.4426950408889634f;
            const float ka = bflo(kv[i]) * __builtin_amdgcn_exp2f(-xa), kb = bfhi(kv[i]) * __builtin_amdgcn_exp2f(-xb);
            *(LAS unsigned*)(Qs + t * 136 + 2 * kp) = pk2(bflo(qv[i]) * 0.088388347648318440f * __builtin_amdgcn_exp2f(xa), bfhi(qv[i]) * 0.088388347648318440f * __builtin_amdgcn_exp2f(xb));
            *(LAS unsigned*)(Ks + t * 136 + 2 * kp) = pk2(ka, kb); kha[i] = ka * eta; khb[i] = kb * etb; }
        { u32x4 w0, w1; w0.x = pk2(kha[0], kha[1]); w0.y = pk2(kha[2], kha[3]); w0.z = pk2(kha[4], kha[5]); w0.w = pk2(kha[6], kha[7]);
          w1.x = pk2(khb[0], khb[1]); w1.y = pk2(khb[2], khb[3]); w1.z = pk2(khb[4], khb[5]); w1.w = pk2(khb[6], khb[7]);
          *(LAS u32x4*)(KT + (2 * kp) * 72 + 8 * sg) = w0; *(LAS u32x4*)(KT + (2 * kp + 1) * 72 + 8 * sg) = w1; }
        if (sg == 0) *(LAS f32x2*)(dS + 2 * kp) = (f32x2){eta, etb};
#pragma unroll
        for (int e = 0; e < 8; ++e) { s16x4 q4 = {vv[0][e], vv[1][e], vv[2][e], vv[3][e]}; *(LAS s16x4*)(VT + (8 * vcc + e) * 72 + 4 * vsb) = q4; }
        WG_BAR();
        if (c + 1 < NC) GLA_LOAD(row0 + 64 * (dir ? NC - 2 - c : c + 1), la, qv, kv, vv);
        if (w < 4) {
            const int ti = w >> 1, si = w & 1;
            const bool need = dir == 0 ? (si <= ti) : (si >= ti);
            f32x16 a;
#pragma unroll
            for (int i = 0; i < 16; ++i) a[i] = 0.f;
            if (need) {
#pragma unroll
                for (int kk = 0; kk < 8; ++kk) { const bf16x8 fa = *(const LAS bf16x8*)(Qs + (32 * ti + r) * 136 + 16 * kk + 8 * hh), fb = *(const LAS bf16x8*)(Ks + (32 * si + r) * 136 + 16 * kk + 8 * hh);
                    a = MFMA32(fa, fb, a); }
            }
            const int s = 32 * si + r;
#pragma unroll
            for (int i = 0; i < 16; ++i) { const int t = 32 * ti + crow(i, hh); const bool ok = dir == 0 ? (s <= t) : (s >= t); As[t * 72 + s] = f2bf(ok ? a[i] : 0.f); }
        }
        WG_BAR();
        bf16x8 bv[4];
#pragma unroll
        for (int kk = 0; kk < 4; ++kk) bv[kk] = *(const LAS bf16x8*)(VT + (32 * w + r) * 72 + 16 * kk + 8 * hh);
#pragma unroll
        for (int ti = 0; ti < 2; ++ti) {
            f32x16 o;
#pragma unroll
            for (int i = 0; i < 16; ++i) o[i] = 0.f;
#pragma unroll
            for (int kk = 0; kk < 4; ++kk) { const bf16x8 fa = *(const LAS bf16x8*)(As + (32 * ti + r) * 72 + 16 * kk + 8 * hh); o = MFMA32(fa, bv[kk], o); }
#pragma unroll
            for (int kt = 0; kt < 4; ++kt)
#pragma unroll
                for (int s2 = 0; s2 < 2; ++s2) { const bf16x8 fb = pack_step(S[kt], s2);
                    const LAS bf16_t* qp = Qs + (32 * ti + r) * 136 + 32 * kt + 16 * s2 + 4 * hh;
                    const bf16x8 fa = cat4(*(const LAS s16x4*)qp, *(const LAS s16x4*)(qp + 8)); o = MFMA32(fa, fb, o); }
#pragma unroll
            for (int i = 0; i < 16; ++i) (OD + ((size_t)h * MT + prow + 32 * ti + (i & 3) + 8 * (i >> 2)) * YLD + 32 * w)[(unsigned)(4 * hh * YLD + r)] = f2bf(o[i]);
        }
#pragma unroll
        for (int kt = 0; kt < 4; ++kt) {
#pragma unroll
            for (int g = 0; g < 4; ++g) { const f32x4 dv = *(const LAS f32x4*)(dS + 32 * kt + 8 * g + 4 * hh);
                S[kt][4 * g + 0] *= dv[0]; S[kt][4 * g + 1] *= dv[1]; S[kt][4 * g + 2] *= dv[2]; S[kt][4 * g + 3] *= dv[3]; }
#pragma unroll
            for (int kk = 0; kk < 4; ++kk) { const bf16x8 fa = *(const LAS bf16x8*)(KT + (32 * kt + r) * 72 + 16 * kk + 8 * hh); S[kt] = MFMA32(fa, bv[kk], S[kt]); }
        }
    }
    if (!lat) { float* so = F.out + OUT_GLA + ((((size_t)b * 2 + layer) * 2 + dir) * 4 + h) * 128 * 256;
#pragma unroll
        for (int kt = 0; kt < 4; ++kt)
#pragma unroll
            for (int i = 0; i < 16; ++i) so[(size_t)(32 * kt + crow(i, hh)) * 256 + 32 * w + r] = S[kt][i];
    }
    WG_BAR();
#undef GLA_LOAD
}

constexpr int SD_BS = 0, SD_CS = 17408, SD_BT = 34816, SD_XT = 53248, SD_GS = 90112, SD_CUM = 107520, SD_DT = 108544, SD_F = 109568, SD_E = 110592, SD_TOT = 111616;
DI void ssd_chain(const Frame& F, LAS unsigned char* lds, int item, int layer) {
    unsigned char* const ws_ = F.ws;
    int tid_ = threadIdx.x; asm volatile("" : "+v"(tid_));
    const int tid = tid_, lane = tid & 63, w = __builtin_amdgcn_readfirstlane(tid >> 6), r = lane & 31, hh = lane >> 5;
    const int dir = item & 1, g = (item >> 1) & 3, sq = item >> 3;
    const bool lat = sq < 2; const int b = lat ? sq : sq - 2;
    const int L = lat ? 1024 : 256, row0 = lat ? M_CTX + b * 1024 : b * 256, NC = L / 64;
    const int hg = w >> 1, ph = w & 1, head = g * 4 + hg;
    const bf16_t* XBC = (const bf16_t*)(ws_ + WS_XBC); const float* DT = (const float*)(ws_ + WS_DT); const float* DTA = (const float*)(ws_ + WS_DTA);
    bf16_t* YD = (bf16_t*)(ws_ + WS_ODS) + (size_t)dir * MT * 1024;
    LAS bf16_t* Bs = (LAS bf16_t*)(lds + SD_BS); LAS bf16_t* Cs = (LAS bf16_t*)(lds + SD_CS); LAS bf16_t* BT = (LAS bf16_t*)(lds + SD_BT); LAS bf16_t* XT = (LAS bf16_t*)(lds + SD_XT);
    LAS float* Gs = (LAS float*)(lds + SD_GS); LAS float* cumS = (LAS float*)(lds + SD_CUM); LAS float* dtS = (LAS float*)(lds + SD_DT); LAS float* fS = (LAS float*)(lds + SD_F);
    LAS float* eS = (LAS float*)(lds + SD_E); LAS float* totS = (LAS float*)(lds + SD_TOT);
    f32x16 ST[4];
    if (lat) { const float* st = F.in[6] + ((((size_t)b * 2 + layer) * 2 + dir) * 16 + head) * 64 * 128 + (size_t)(32 * ph + r) * 128;
#pragma unroll
        for (int nt = 0; nt < 4; ++nt)
#pragma unroll
            for (int q = 0; q < 4; ++q) { const f32x4 v = *(const f32x4*)(st + 32 * nt + 8 * q + 4 * hh); ST[nt][4 * q] = v[0]; ST[nt][4 * q + 1] = v[1]; ST[nt][4 * q + 2] = v[2]; ST[nt][4 * q + 3] = v[3]; }
    } else {
#pragma unroll
        for (int nt = 0; nt < 4; ++nt)
#pragma unroll
            for (int i = 0; i < 16; ++i) ST[nt][i] = 0.f;
    }
    const int ssb = tid & 15, sch = (tid >> 4) & 15, xch = tid >> 4; const bool isC = tid >= 256;
#define SSD_LOAD(PROW, BCr, XVr, DTr, DAr) do { \
        _Pragma("unroll") for (int i = 0; i < 4; ++i) BCr[i] = *(const bf16x8*)(XBC + yaddr((PROW) + 4 * ssb + i, (isC ? 1536 : 1024) + g * 128 + 8 * sch)); \
        _Pragma("unroll") for (int i = 0; i < 4; ++i) XVr[i] = *(const bf16x8*)(XBC + yaddr((PROW) + 4 * ssb + i, g * 256 + 8 * xch)); \
        if (w < 4) { const size_t di = (size_t)((PROW) + lane) * 32 + dir * 16 + g * 4 + w; DTr = DT[di]; DAr = DTA[di]; } } while (0)
    bf16x8 bc[4], xv[4]; float dtv = 0.f, dta = 0.f;
    SSD_LOAD(row0 + 64 * (dir ? NC - 1 : 0), bc, xv, dtv, dta);
    for (int c = 0; c < NC; ++c) {
        const int pb = dir ? NC - 1 - c : c, prow = row0 + 64 * pb;
        { LAS bf16_t* dstR = isC ? Cs : Bs;
#pragma unroll
          for (int i = 0; i < 4; ++i) *(LAS bf16x8*)(dstR + (4 * ssb + i) * 136 + 8 * sch) = bc[i];
          if (!isC) {
#pragma unroll
              for (int e = 0; e < 8; ++e) { s16x4 q4 = {bc[0][e], bc[1][e], bc[2][e], bc[3][e]}; *(LAS s16x4*)(BT + (8 * sch + e) * 72 + 4 * ssb) = q4; } }
#pragma unroll
          for (int e = 0; e < 8; ++e) { s16x4 q4 = {xv[0][e], xv[1][e], xv[2][e], xv[3][e]}; *(LAS s16x4*)(XT + (8 * xch + e) * 72 + 4 * ssb) = q4; }
        }
        if (w < 4) {
            float cs = dta;
#pragma unroll
            for (int o = 1; o < 64; o <<= 1) { const float t = __shfl_up(cs, o); if (lane >= o) cs += t; }
            const float total = __shfl(cs, 63);
            const float cum = dir == 0 ? cs : total - cs + dta;
            cumS[w * 64 + lane] = cum; dtS[w * 64 + lane] = dtv; fS[w * 64 + lane] = dtv * __expf(total - cum); eS[w * 64 + lane] = __expf(cum);
            if (lane == 0) totS[w] = __expf(total);
        }
        WG_BAR();
        if (c + 1 < NC) SSD_LOAD(row0 + 64 * (dir ? NC - 2 - c : c + 1), bc, xv, dtv, dta);
        if (w < 4) {
            const int ti = w >> 1, si = w & 1;
            const bool need = dir == 0 ? (si <= ti) : (si >= ti);
            f32x16 a;
#pragma unroll
            for (int i = 0; i < 16; ++i) a[i] = 0.f;
            if (need) {
#pragma unroll
                for (int kk = 0; kk < 8; ++kk) { const bf16x8 fa = *(const LAS bf16x8*)(Cs + (32 * ti + r) * 136 + 16 * kk + 8 * hh), fb = *(const LAS bf16x8*)(Bs + (32 * si + r) * 136 + 16 * kk + 8 * hh);
                    a = MFMA32(fa, fb, a); }
            }
#pragma unroll
            for (int i = 0; i < 16; ++i) Gs[(32 * ti + crow(i, hh)) * 68 + 32 * si + r] = a[i];
        }
        WG_BAR();
        const LAS bf16_t* xrow = XT + (hg * 64 + 32 * ph + r) * 72 + 8 * hh;
#pragma unroll 1
        for (int ti = 0; ti < 2; ++ti) {
            f32x16 y;
#pragma unroll
            for (int i = 0; i < 16; ++i) y[i] = 0.f;
            const int t = 32 * ti + r; const float ct = cumS[hg * 64 + t];
#pragma unroll
            for (int nt = 0; nt < 4; ++nt)
#pragma unroll
                for (int s2 = 0; s2 < 2; ++s2) { const bf16x8 fb = pack_step(ST[nt], s2);
                    const LAS bf16_t* cp = Cs + t * 136 + 32 * nt + 16 * s2 + 4 * hh;
                    const bf16x8 fa = cat4(*(const LAS s16x4*)cp, *(const LAS s16x4*)(cp + 8)); y = MFMA32(fa, fb, y); }
#pragma unroll
            for (int q = 0; q < 4; ++q) { const f32x4 ev = *(const LAS f32x4*)(eS + hg * 64 + 32 * ti + 8 * q + 4 * hh);
                y[4 * q] *= ev[0]; y[4 * q + 1] *= ev[1]; y[4 * q + 2] *= ev[2]; y[4 * q + 3] *= ev[3]; }
#pragma unroll
            for (int kk = 0; kk < 4; ++kk) {
                const bool blk = dir == 0 ? (16 * kk <= 32 * ti + 31) : (16 * kk + 15 >= 32 * ti);
                if (blk) {
                    const int s0 = 16 * kk + 8 * hh;
                    const f32x4 g0 = *(const LAS f32x4*)(Gs + t * 68 + s0), g1 = *(const LAS f32x4*)(Gs + t * 68 + s0 + 4);
                    const f32x4 c0 = *(const LAS f32x4*)(cumS + hg * 64 + s0), c1 = *(const LAS f32x4*)(cumS + hg * 64 + s0 + 4);
                    const f32x4 d0 = *(const LAS f32x4*)(dtS + hg * 64 + s0), d1 = *(const LAS f32x4*)(dtS + hg * 64 + s0 + 4);
                    float wv[8];
#pragma unroll
                    for (int j = 0; j < 4; ++j) { const int s = s0 + j; const bool ok = dir == 0 ? (s <= t) : (s >= t);
                        wv[j] = ok ? g0[j] * __expf(fminf(ct - c0[j], 0.f)) * d0[j] : 0.f; }
#pragma unroll
                    for (int j = 0; j < 4; ++j) { const int s = s0 + 4 + j; const bool ok = dir == 0 ? (s <= t) : (s >= t);
                        wv[4 + j] = ok ? g1[j] * __expf(fminf(ct - c1[j], 0.f)) * d1[j] : 0.f; }
                    u32x4 p; p.x = pk2(wv[0], wv[1]); p.y = pk2(wv[2], wv[3]); p.z = pk2(wv[4], wv[5]); p.w = pk2(wv[6], wv[7]);
                    y = MFMA32(__builtin_bit_cast(bf16x8, p), *(const LAS bf16x8*)(xrow + 16 * kk), y);
                }
            }
#pragma unroll
            for (int i = 0; i < 16; ++i) (YD + ((size_t)(head >> 2) * MT + prow + 32 * ti + (i & 3) + 8 * (i >> 2)) * YLD + (head & 3) * 64 + 32 * ph)[(unsigned)(4 * hh * YLD + r)] = f2bf(y[i]);
        }
        const float dec = totS[hg];
#pragma unroll
        for (int nt = 0; nt < 4; ++nt)
#pragma unroll
            for (int i = 0; i < 16; ++i) ST[nt][i] *= dec;
#pragma unroll
        for (int kk = 0; kk < 4; ++kk) { const int s0 = 16 * kk + 8 * hh;
            const f32x4 f0 = *(const LAS f32x4*)(fS + hg * 64 + s0), f1 = *(const LAS f32x4*)(fS + hg * 64 + s0 + 4);
            const bf16x8 xk = *(const LAS bf16x8*)(xrow + 16 * kk);
            u32x4 p; p.x = pk2(bf2f_s(xk[0]) * f0[0], bf2f_s(xk[1]) * f0[1]); p.y = pk2(bf2f_s(xk[2]) * f0[2], bf2f_s(xk[3]) * f0[3]);
            p.z = pk2(bf2f_s(xk[4]) * f1[0], bf2f_s(xk[5]) * f1[1]); p.w = pk2(bf2f_s(xk[6]) * f1[2], bf2f_s(xk[7]) * f1[3]);
            const bf16x8 xh = __builtin_bit_cast(bf16x8, p);
#pragma unroll
            for (int nt = 0; nt < 4; ++nt) { const bf16x8 fa = *(const LAS bf16x8*)(BT + (32 * nt + r) * 72 + 16 * kk + 8 * hh); ST[nt] = MFMA32(fa, xh, ST[nt]); }
        }
        WG_BAR();
    }
    if (!lat) { float* so = F.out + OUT_SSM + ((((size_t)b * 2 + layer) * 2 + dir) * 16 + head) * 64 * 128 + (size_t)(32 * ph + r) * 128;
#pragma unroll
        for (int nt = 0; nt < 4; ++nt)
#pragma unroll
            for (int q = 0; q < 4; ++q) { f32x4 v = {ST[nt][4 * q], ST[nt][4 * q + 1], ST[nt][4 * q + 2], ST[nt][4 * q + 3]}; *(f32x4*)(so + 32 * nt + 8 * q + 4 * hh) = v; }
    }
}

DI void norm_phase(const Frame& F, const float* Xa, const float* Xb, const float* nw, const float* mod  , bf16_t* XN) {
    int tid_ = threadIdx.x; asm volatile("" : "+v"(tid_));
    const int lane = tid_ & 63, gw = F.bid * NWAVES + __builtin_amdgcn_readfirstlane(tid_ >> 6), NGW = F.G * NWAVES;
    f32x4 wf[8], sf[8]; int cur_mi = -1;
    for (int row = gw; row < MT; row += NGW) {
        const f32x4* xr = (const f32x4*)((row < M_CTX ? Xa : Xb) + (size_t)row * DM) + lane;
        f32x4 v[8]; float s = 0.f;
#pragma unroll
        for (int j = 0; j < 8; ++j) { v[j] = xr[64 * j]; s += (v[j][0] * v[j][0] + v[j][1] * v[j][1]) + (v[j][2] * v[j][2] + v[j][3] * v[j][3]); }
        const int mi = row < M_CTX ? 0 : 1 + ((row - M_CTX) >> 10);
        if (mi != cur_mi) { cur_mi = mi;
            const f32x4* sh = (const f32x4*)(mod + (size_t)mi * NMOD) + lane; const f32x4* sc = (const f32x4*)(mod + (size_t)mi * NMOD + DM) + lane; const f32x4* wv = (const f32x4*)nw + lane;
#pragma unroll
            for (int j = 0; j < 8; ++j) { wf[j] = wv[64 * j] * (sc[64 * j] + 1.0f); sf[j] = sh[64 * j]; } }
        const float rstd = 1.0f / sqrtf(wave_sum(s) * (1.0f / DM) + RMS_EPS);
#pragma unroll
        for (int j = 0; j < 8; ++j) { const f32x4 a = v[j] * rstd * wf[j] + sf[j]; u32x2 w; w.x = pk2(a[0], a[1]); w.y = pk2(a[2], a[3]); *(u32x2*)(XN + kb64(MT, row, 256 * j + 4 * lane)) = w; }
    }
}
DI void norm_phase_b(const Frame& F, const bf16_t* XB, const float* nw, const float* mod, bf16_t* XN) {
    int tid_ = threadIdx.x; asm volatile("" : "+v"(tid_));
    const int lane = tid_ & 63, gw = F.bid * NWAVES + __builtin_amdgcn_readfirstlane(tid_ >> 6), NGW = F.G * NWAVES;
    f32x4 wf[8], sf[8]; int cur_mi = -1;
    for (int row = gw; row < MT; row += NGW) {
        const bf16_t* xr = XB + ((size_t)(lane >> 5) * MT + row) * YLD + 8 * (lane & 31);
        u32x4 t[4];
#pragma unroll
        for (int j = 0; j < 4; ++j) t[j] = *(const u32x4*)(xr + (size_t)(2 * j) * MT * YLD);
        f32x4 v[8]; float s = 0.f;
#pragma unroll
        for (int j = 0; j < 4; ++j) { v[2 * j] = (f32x4){bflo(t[j].x), bfhi(t[j].x), bflo(t[j].y), bfhi(t[j].y)}; v[2 * j + 1] = (f32x4){bflo(t[j].z), bfhi(t[j].z), bflo(t[j].w), bfhi(t[j].w)}; }
#pragma unroll
        for (int j = 0; j < 8; ++j) s += (v[j][0] * v[j][0] + v[j][1] * v[j][1]) + (v[j][2] * v[j][2] + v[j][3] * v[j][3]);
        const int mi = row < M_CTX ? 0 : 1 + ((row - M_CTX) >> 10);
        if (mi != cur_mi) { cur_mi = mi;
            const f32x4* sh = (const f32x4*)(mod + (size_t)mi * NMOD) + 2 * lane; const f32x4* sc = (const f32x4*)(mod + (size_t)mi * NMOD + DM) + 2 * lane; const f32x4* wv = (const f32x4*)nw + 2 * lane;
#pragma unroll
            for (int j = 0; j < 8; ++j) { const int o = 128 * (j >> 1) + (j & 1); wf[j] = wv[o] * (sc[o] + 1.0f); sf[j] = sh[o]; } }
        const float rstd = 1.0f / sqrtf(wave_sum(s) * (1.0f / DM) + RMS_EPS);
#pragma unroll
        for (int j = 0; j < 4; ++j) { const f32x4 a = v[2 * j] * rstd * wf[2 * j] + sf[2 * j], b = v[2 * j + 1] * rstd * wf[2 * j + 1] + sf[2 * j + 1];
            u32x4 w; w.x = pk2(a[0], a[1]); w.y = pk2(a[2], a[3]); w.z = pk2(b[0], b[1]); w.w = pk2(b[2], b[3]); *(u32x4*)(XN + kb64(MT, row, 512 * j + 8 * lane)) = w; }
    }
}
DI void final_norm_phase(const Frame& F, const bf16_t* XB, float* Xo, const float* nw) {
    int tid_ = threadIdx.x; asm volatile("" : "+v"(tid_));
    const int lane = tid_ & 63, gw = F.bid * NWAVES + __builtin_amdgcn_readfirstlane(tid_ >> 6), NGW = F.G * NWAVES;
    for (int row = gw; row < MT; row += NGW) {
        const bf16_t* xr = XB + ((size_t)(lane >> 5) * MT + row) * YLD + 8 * (lane & 31);
        u32x4 t[4];
#pragma unroll
        for (int j = 0; j < 4; ++j) t[j] = *(const u32x4*)(xr + (size_t)(2 * j) * MT * YLD);
        f32x4 v[8]; float s = 0.f;
#pragma unroll
        for (int j = 0; j < 4; ++j) { v[2 * j] = (f32x4){bflo(t[j].x), bfhi(t[j].x), bflo(t[j].y), bfhi(t[j].y)}; v[2 * j + 1] = (f32x4){bflo(t[j].z), bfhi(t[j].z), bflo(t[j].w), bfhi(t[j].w)}; }
#pragma unroll
        for (int j = 0; j < 8; ++j) s += (v[j][0] * v[j][0] + v[j][1] * v[j][1]) + (v[j][2] * v[j][2] + v[j][3] * v[j][3]);
        const float rstd = 1.0f / sqrtf(wave_sum(s) * (1.0f / DM) + RMS_EPS);
        const f32x4* wv = (const f32x4*)nw + 2 * lane; f32x4* yo = (f32x4*)(Xo + (size_t)row * DM) + 2 * lane;
#pragma unroll
        for (int j = 0; j < 8; ++j) { const int o = 128 * (j >> 1) + (j & 1); yo[o] = v[j] * rstd * wv[o]; }
    }
}
DI void seq_of_row(int row, int& t, int& L) { if (row < M_CTX) { t = row & 255; L = 256; } else { t = (row - M_CTX) & 1023; L = 1024; } }
DI void prep_phase(const Frame& F, int layer) {
    unsigned char* const ws_ = F.ws;
    const bf16_t* Y = (const bf16_t*)(ws_ + WS_BIG); const float* YS = (const float*)(ws_ + WS_YS);
    bf16_t* XBC = (bf16_t*)(ws_ + WS_XBC); float* DT = (float*)(ws_ + WS_DT); float* DTA = (float*)(ws_ + WS_DTA); bf16_t* LA = (bf16_t*)(ws_ + WS_LA); bf16_t* KR = (bf16_t*)(ws_ + WS_KR);
    int tid_ = threadIdx.x; asm volatile("" : "+v"(tid_));
    const int gt = F.bid * 512 + tid_, NT = F.G * 512;
    const float* cw = F.in[19] + (size_t)layer * 5 * 2048; const float* cb = F.in[20] + (size_t)layer * 2048;
    for (int it = gt; it < (MT / 8) * 256; it += NT) {
        const int r0 = (it >> 8) * 8, ch = (it & 255) * 8; int t0, L; seq_of_row(r0, t0, L);
        u32x4 xr[12];
#pragma unroll
        for (int j = 0; j < 12; ++j) { const int tt = t0 + j - 2; xr[j] = (u32x4){0u, 0u, 0u, 0u}; if (tt >= 0 && tt < L) xr[j] = *(const u32x4*)(Y + yaddr(r0 + j - 2, YC_XBC + ch)); }
        f32x4 w0[5], w1[5];
#pragma unroll
        for (int j = 0; j < 5; ++j) { w0[j] = *(const f32x4*)(cw + j * 2048 + ch); w1[j] = *(const f32x4*)(cw + j * 2048 + ch + 4); }
        const f32x4 b0 = *(const f32x4*)(cb + ch), b1 = *(const f32x4*)(cb + ch + 4);
#pragma unroll
        for (int i = 0; i < 8; ++i) {
            f32x4 a0 = b0, a1 = b1;
#pragma unroll
            for (int j = 0; j < 5; ++j) { const u32x4 xv = xr[i + j];
                a0 = a0 + w0[j] * (f32x4){bflo(xv.x), bfhi(xv.x), bflo(xv.y), bfhi(xv.y)}; a1 = a1 + w1[j] * (f32x4){bflo(xv.z), bfhi(xv.z), bflo(xv.w), bfhi(xv.w)}; }
            u32x4 o; o.x = pk2(fast_silu(a0[0]), fast_silu(a0[1])); o.y = pk2(fast_silu(a0[2]), fast_silu(a0[3])); o.z = pk2(fast_silu(a1[0]), fast_silu(a1[1])); o.w = pk2(fast_silu(a1[2]), fast_silu(a1[3]));
            *(u32x4*)(XBC + yaddr(r0 + i, ch)) = o;
        }
    }
    const float* dtb = F.in[21] + layer * 32; const float* alog = F.in[22] + layer * 32;
    for (int it = gt; it < MT * 32; it += NT) { const int i = it & 31; const float d = softplusf(YS[(size_t)(it >> 5) * 64 + 32 + i] + dtb[i]); DT[it] = d; DTA[it] = -__expf(alog[i]) * d; }
    const float* wup = F.in[16] + (size_t)layer * 2 * 16 * 512; const float* bup = F.in[17] + (size_t)layer * 2 * 512;
    for (int it = gt; it < (MT / 8) * 256; it += NT) {
        const int r0 = (it >> 8) * 8, dir = (it >> 7) & 1, j4 = (it & 127) * 4;
        f32x4 wu[16];
#pragma unroll
        for (int rr = 0; rr < 16; ++rr) wu[rr] = *(const f32x4*)(wup + (size_t)(dir * 16 + rr) * 512 + j4);
        const f32x4 bz = *(const f32x4*)(bup + dir * 512 + j4);
#pragma unroll
        for (int i = 0; i < 8; ++i) {
            const float* gd = YS + (size_t)(r0 + i) * 64 + dir * 16;
            const f32x4 g0 = *(const f32x4*)gd, g1 = *(const f32x4*)(gd + 4), g2 = *(const f32x4*)(gd + 8), g3 = *(const f32x4*)(gd + 12);
            f32x4 z = bz;
            z = z + g0[0] * wu[0] + g0[1] * wu[1] + g0[2] * wu[2] + g0[3] * wu[3]; z = z + g1[0] * wu[4] + g1[1] * wu[5] + g1[2] * wu[6] + g1[3] * wu[7];
            z = z + g2[0] * wu[8] + g2[1] * wu[9] + g2[2] * wu[10] + g2[3] * wu[11]; z = z + g3[0] * wu[12] + g3[1] * wu[13] + g3[2] * wu[14] + g3[3] * wu[15];
            u32x2 ow; ow.x = pk2(-softplusf(-z[0]) * (1.0f / 16.0f), -softplusf(-z[1]) * (1.0f / 16.0f)); ow.y = pk2(-softplusf(-z[2]) * (1.0f / 16.0f), -softplusf(-z[3]) * (1.0f / 16.0f));
            *(u32x2*)(LA + ((size_t)(dir * 4 + (j4 >> 7)) * MT + r0 + i) * 128 + (j4 & 127)) = ow;
        }
    }
    bf16_t* QR = (bf16_t*)(ws_ + WS_QR);
    for (int it = gt; it < M_LAT * 80; it += NT) {
        const int tl = it / 80, rem = it - tl * 80, hd = rem >> 3, half = (rem >> 2) & 1, i0 = (rem & 3) * 8;
        const int t = tl & 1023; const float pos = (float)(half ? (t & 63) : (t >> 6));
        const size_t src = yaddr(M_CTX + tl, (hd < 2 ? YC_AK + hd * 128 : YC_AQ + (hd - 2) * 128) + half * 64 + i0);
        const u32x4 xa = *(const u32x4*)(Y + src), xb = *(const u32x4*)(Y + src + 32);
        const unsigned a4[4] = {xa.x, xa.y, xa.z, xa.w}, b4[4] = {xb.x, xb.y, xb.z, xb.w}; unsigned oa[4], ob[4];
#pragma unroll
        for (int q = 0; q < 4; ++q) { float y1[2], y2[2];
#pragma unroll
            for (int e = 0; e < 2; ++e) { const int i = i0 + 2 * q + e; const float ang = pos * __builtin_amdgcn_exp2f(-(float)i * 0.41524101186092029f), cs = __cosf(ang), sn = __sinf(ang);
                const float x1 = e ? bfhi(a4[q]) : bflo(a4[q]), x2 = e ? bfhi(b4[q]) : bflo(b4[q]); y1[e] = x1 * cs - x2 * sn; y2[e] = x2 * cs + x1 * sn; }
            oa[q] = pk2(y1[0], y1[1]); ob[q] = pk2(y2[0], y2[1]); }
        bf16_t* dst = (hd < 2 ? KR + (size_t)tl * 256 + hd * 128 : QR + (size_t)tl * 1024 + (hd - 2) * 128) + half * 64 + i0;
        *(u32x4*)dst = (u32x4){oa[0], oa[1], oa[2], oa[3]}; *(u32x4*)(dst + 32) = (u32x4){ob[0], ob[1], ob[2], ob[3]};
    }
    for (int it = gt; it < M_CTX * 64; it += NT) { const int row = it >> 6, c8 = (it & 63) * 8, b = row >> 8, t = row & 255;
        const u32x4 xv = *(const u32x4*)(Y + yaddr(row, YC_AK + c8));
        float* o = F.out + (c8 < 256 ? OUT_CK : OUT_CV) + ((size_t)(b * 2 + layer) * 256 + t) * 256 + (c8 & 255);
        *(f32x4*)o = (f32x4){bflo(xv.x), bfhi(xv.x), bflo(xv.y), bfhi(xv.y)}; *(f32x4*)(o + 4) = (f32x4){bflo(xv.z), bfhi(xv.z), bflo(xv.w), bfhi(xv.w)}; }
}
DI void combine_phase(const Frame& F, int layer) {
    unsigned char* const ws_ = F.ws;
    const bf16_t* Y = (const bf16_t*)(ws_ + WS_BIG); const bf16_t* XBC = (const bf16_t*)(ws_ + WS_XBC);
    const bf16_t* OG = (const bf16_t*)(ws_ + WS_ODG); const bf16_t* OS = (const bf16_t*)(ws_ + WS_ODS); bf16_t* OC = (bf16_t*)(ws_ + WS_OCAT);
    const float* gnw = F.in[18] + layer * 256; const float* snw = F.in[24] + layer * 1024; const float* dsk = F.in[23] + layer * 16;
    int tid_ = threadIdx.x; asm volatile("" : "+v"(tid_));
    const int lane = tid_ & 63, gw = F.bid * NWAVES + __builtin_amdgcn_readfirstlane(tid_ >> 6), NGW = F.G * NWAVES, c0 = lane * 16;
    for (int row = gw; row < MT; row += NGW) {
        float o[16]; float ss = 0.f;
        { const u32x4 a0 = *(const u32x4*)(OG + yaddr(row, c0)), a1 = *(const u32x4*)(OG + yaddr(row, c0 + 8)), b0 = *(const u32x4*)(OG + (size_t)MT * 1024 + yaddr(row, c0)), b1 = *(const u32x4*)(OG + (size_t)MT * 1024 + yaddr(row, c0 + 8));
          const unsigned aa[8] = {a0.x, a0.y, a0.z, a0.w, a1.x, a1.y, a1.z, a1.w}, bb[8] = {b0.x, b0.y, b0.z, b0.w, b1.x, b1.y, b1.z, b1.w};
#pragma unroll
          for (int q = 0; q < 8; ++q) { o[2 * q] = bflo(aa[q]) + bflo(bb[q]); o[2 * q + 1] = bfhi(aa[q]) + bfhi(bb[q]); ss += o[2 * q] * o[2 * q] + o[2 * q + 1] * o[2 * q + 1]; } }
        ss += __shfl_xor(ss, 1); ss += __shfl_xor(ss, 2); ss += __shfl_xor(ss, 4); ss += __shfl_xor(ss, 8);
        float rstd = 1.0f / sqrtf(ss * (1.0f / 256.0f) + RMS_EPS);
        { const u32x4 g0 = *(const u32x4*)(Y + yaddr(row, YC_GR + c0)), g1 = *(const u32x4*)(Y + yaddr(row, YC_GR + c0 + 8));
          const unsigned gg[8] = {g0.x, g0.y, g0.z, g0.w, g1.x, g1.y, g1.z, g1.w}; unsigned ow[8];
          const f32x4* gw4 = (const f32x4*)(gnw + (c0 & 255)); const f32x4 n0 = gw4[0], n1 = gw4[1], n2 = gw4[2], n3 = gw4[3]; const float gn[16] = {n0[0], n0[1], n0[2], n0[3], n1[0], n1[1], n1[2], n1[3], n2[0], n2[1], n2[2], n2[3], n3[0], n3[1], n3[2], n3[3]};
#pragma unroll
          for (int q = 0; q < 8; ++q) ow[q] = pk2(o[2 * q] * rstd * gn[2 * q] * fast_silu(bflo(gg[q])), o[2 * q + 1] * rstd * gn[2 * q + 1] * fast_silu(bfhi(gg[q])));
          *(u32x4*)(OC + kb64(MT, row, c0)) = (u32x4){ow[0], ow[1], ow[2], ow[3]}; *(u32x4*)(OC + kb64(MT, row, c0 + 8)) = (u32x4){ow[4], ow[5], ow[6], ow[7]}; }
        ss = 0.f; const float dk = dsk[lane >> 2];
        { const u32x4 x0 = *(const u32x4*)(XBC + yaddr(row, c0)), x1 = *(const u32x4*)(XBC + yaddr(row, c0 + 8));
          const u32x4 z0 = *(const u32x4*)(Y + yaddr(row, YC_SZ + c0)), z1 = *(const u32x4*)(Y + yaddr(row, YC_SZ + c0 + 8));
          const unsigned xx[8] = {x0.x, x0.y, x0.z, x0.w, x1.x, x1.y, x1.z, x1.w}, zz[8] = {z0.x, z0.y, z0.z, z0.w, z1.x, z1.y, z1.z, z1.w};
          const u32x4 a0 = *(const u32x4*)(OS + yaddr(row, c0)), a1 = *(const u32x4*)(OS + yaddr(row, c0 + 8)), b0 = *(const u32x4*)(OS + (size_t)MT * 1024 + yaddr(row, c0)), b1 = *(const u32x4*)(OS + (size_t)MT * 1024 + yaddr(row, c0 + 8));
          const unsigned aa[8] = {a0.x, a0.y, a0.z, a0.w, a1.x, a1.y, a1.z, a1.w}, bb[8] = {b0.x, b0.y, b0.z, b0.w, b1.x, b1.y, b1.z, b1.w};
#pragma unroll
          for (int e = 0; e < 16; ++e) { const unsigned xw = xx[e >> 1], zw = zz[e >> 1], aw = aa[e >> 1], bw = bb[e >> 1];
              const float xf = (e & 1) ? bfhi(xw) : bflo(xw), zf = (e & 1) ? bfhi(zw) : bflo(zw), af = (e & 1) ? bfhi(aw) : bflo(aw), bf = (e & 1) ? bfhi(bw) : bflo(bw);
              const float y = (af + bf + dk * xf) * fast_silu(zf); o[e] = y; ss += y * y; } }
        rstd = 1.0f / sqrtf(wave_sum(ss) * (1.0f / 1024.0f) + RMS_EPS);
        { unsigned ow[8];
          const f32x4* sw4 = (const f32x4*)(snw + c0); const f32x4 n0 = sw4[0], n1 = sw4[1], n2 = sw4[2], n3 = sw4[3]; const float sn[16] = {n0[0], n0[1], n0[2], n0[3], n1[0], n1[1], n1[2], n1[3], n2[0], n2[1], n2[2], n2[3], n3[0], n3[1], n3[2], n3[3]};
#pragma unroll
          for (int q = 0; q < 8; ++q) ow[q] = pk2(o[2 * q] * rstd * sn[2 * q], o[2 * q + 1] * rstd * sn[2 * q + 1]);
          *(u32x4*)(OC + kb64(MT, row, 1024 + c0)) = (u32x4){ow[0], ow[1], ow[2], ow[3]}; *(u32x4*)(OC + kb64(MT, row, 1024 + c0 + 8)) = (u32x4){ow[4], ow[5], ow[6], ow[7]}; }
    }
}

DI void msum_phase(const Frame& F) {
    unsigned char* const ws_ = F.ws;
    int tid_ = threadIdx.x; asm volatile("" : "+v"(tid_));
    const bf16_t* PB = (const bf16_t*)(ws_ + WS_ODG); bf16_t* Mb = (bf16_t*)(ws_ + WS_XBC);
    const int gt = F.bid * 512 + tid_, NT = F.G * 512;
    for (int it0 = gt; it0 < MT * DM / 8; it0 += 4 * NT) {
        u32x4 a[4], b[4], c[4];
#pragma unroll
        for (int q = 0; q < 4; ++q) { const int it = it0 + q * NT; if (it < MT * DM / 8) { a[q] = *(const u32x4*)(PB + (size_t)it * 8); b[q] = *(const u32x4*)(PB + (size_t)MT * DM + (size_t)it * 8); c[q] = *(const u32x4*)(PB + (size_t)2 * MT * DM + (size_t)it * 8); } }
#pragma unroll
        for (int q = 0; q < 4; ++q) { const int it = it0 + q * NT; if (it < MT * DM / 8) {
            u32x4 o;
            o.x = pk2(bflo(a[q].x) + bflo(b[q].x) + bflo(c[q].x), bfhi(a[q].x) + bfhi(b[q].x) + bfhi(c[q].x)); o.y = pk2(bflo(a[q].y) + bflo(b[q].y) + bflo(c[q].y), bfhi(a[q].y) + bfhi(b[q].y) + bfhi(c[q].y));
            o.z = pk2(bflo(a[q].z) + bflo(b[q].z) + bflo(c[q].z), bfhi(a[q].z) + bfhi(b[q].z) + bfhi(c[q].z)); o.w = pk2(bflo(a[q].w) + bflo(b[q].w) + bflo(c[q].w), bfhi(a[q].w) + bfhi(b[q].w) + bfhi(c[q].w));
            *(u32x4*)(Mb + kb64(MT, (it >> 5) % MT, (it / (32 * MT)) * 256 + (it & 31) * 8)) = o; } }
    }
}

DI void transpose_item(const float* W, int K, int N, bf16_t* WT, int NR, int k0, int n0, int dst0, LAS float* scr, int lane) {
#pragma unroll 8
    for (int i = 0; i < 32; ++i) { const int kk = 2 * i + (lane >> 5); scr[kk * 33 + (lane & 31)] = W[(size_t)(k0 + kk) * N + n0 + (lane & 31)]; }
    LDS_WAIT(); asm volatile("" ::: "memory");
    const int c = lane & 7;
#pragma unroll
    for (int j = 0; j < 4; ++j) { const int n = (lane >> 3) + 8 * j; const LAS float* s = scr + (8 * c) * 33 + n;
        u32x4 o; o.x = pk2(s[0 * 33], s[1 * 33]); o.y = pk2(s[2 * 33], s[3 * 33]); o.z = pk2(s[4 * 33], s[5 * 33]); o.w = pk2(s[6 * 33], s[7 * 33]);
        *(u32x4*)(WT + ((size_t)(k0 >> 6) * NR + dst0 + n) * 64 + 8 * c) = o; }
    LDS_WAIT(); asm volatile("" ::: "memory");
}
DI int win_dst(int n) { return n < 3072 ? n : (n < 3104 ? YC_GD + (n - 3072) : (n < 6176 ? n - 32 : (n < 6208 ? YC_DT + (n - 6176) : n - 64))); }
DI void prologue_phase(const Frame& F, LAS unsigned char* lds) {
    unsigned char* const ws_ = F.ws;
    int tid_ = threadIdx.x; asm volatile("" : "+v"(tid_));
    const int tid = tid_, lane = tid & 63, wave = __builtin_amdgcn_readfirstlane(tid >> 6);
    {
        LAS float* sv = (LAS float*)lds;
        LAS float* red = (LAS float*)(lds + 24576);
        for (int i = tid; i < 3 * 2048; i += 512) { const int mi = i >> 11, k = i & 2047; const float x = mi == 0 ? F.in[7][k] : F.in[2][(mi - 1) * 2048 + k]; sv[i] = x / (1.0f + __expf(-x)); }
        __syncthreads();
        float* MOD = (float*)(ws_ + WS_MOD);
        const int tx = tid & 15, ty = tid >> 4;
        for (int it = F.bid; it < 2 * 288; it += F.G) {
            const int l = it / 288, cb = it % 288;
            const float* wp = F.in[8] + ((size_t)l * 2048 + 64 * ty) * NMOD + 64 * cb + 4 * tx;
            f32x4 a0 = {0.f, 0.f, 0.f, 0.f}, a1 = a0, a2 = a0;
#pragma unroll 8
            for (int k = 0; k < 64; ++k) { const f32x4 wv = *(const f32x4*)(wp + (size_t)k * NMOD); const int kk = 64 * ty + k;
                a0 = a0 + sv[kk] * wv; a1 = a1 + sv[2048 + kk] * wv; a2 = a2 + sv[4096 + kk] * wv; }
            *(LAS f32x4*)(red + (ty * 3 + 0) * 64 + 4 * tx) = a0; *(LAS f32x4*)(red + (ty * 3 + 1) * 64 + 4 * tx) = a1; *(LAS f32x4*)(red + (ty * 3 + 2) * 64 + 4 * tx) = a2;
            __syncthreads();
            if (tid < 192) { const int mi = tid >> 6, col = tid & 63; float s = 0.f;
#pragma unroll 8
                for (int y = 0; y < 32; ++y) s += red[(y * 3 + mi) * 64 + col];
                MOD[((size_t)l * 3 + mi) * NMOD + 64 * cb + col] = s + F.in[9][(size_t)l * NMOD + 64 * cb + col]; }
            __syncthreads();
        }
    }
    {
        LAS float* scr = (LAS float*)(lds + wave * 8448);
        const int gw = F.bid * NWAVES + wave, NGW = F.G * NWAVES;
        constexpr int PER_L = 52800;
        for (int it = gw; it < 2 * PER_L; it += NGW) {
            const int l = it / PER_L; int r = it - l * PER_L;
            if (r < 33792) { const int mi = r / 5632, rr = r - mi * 5632;
                if (mi < 4) { const int f = mi >> 1, up = mi & 1; const float* W = F.in[f ? (up ? 32 : 31) : (up ? 12 : 11)] + (size_t)l * DM * FF;
                    const int kb = rr / 176, nb = rr - kb * 176, n0 = 32 * nb;
                    transpose_item(W, DM, FF, (bf16_t*)(ws_ + WS_WGU + (size_t)(l * 2 + f) * SZ_WGU), NGU, 64 * kb, n0, 256 * (n0 >> 7) + 128 * up + (n0 & 127), scr, lane); }
                else { const int f = mi - 4; const float* W = F.in[f ? 33 : 13] + (size_t)l * FF * DM; const int kb = rr >> 6, nb = rr & 63;
                    transpose_item(W, FF, DM, (bf16_t*)(ws_ + WS_WD + (size_t)(l * 2 + f) * SZ_WD), DM, 64 * kb, 32 * nb, 32 * nb, scr, lane); }
                continue; }
            r -= 33792;
            if (r < 13888) { const int kb = r / 434, nb = r - kb * 434; transpose_item(F.in[15] + (size_t)l * DM * D_IN, DM, D_IN, (bf16_t*)(ws_ + WS_WIN + (size_t)l * SZ_WIN), NY, 64 * kb, 32 * nb, win_dst(32 * nb), scr, lane); continue; }
            r -= 13888;
            if (r < 3072) { const int i = r >> 10, rr = r & 1023, kb = rr >> 6, nb = rr & 63;
                transpose_item(F.in[26 + i] + (size_t)l * 1024 * DM, 1024, DM, (bf16_t*)(ws_ + WS_WBR + (size_t)(l * 3 + i) * SZ_WBR), DM, 64 * kb, 32 * nb, 32 * nb, scr, lane); continue; }
            r -= 3072;
            { const int kb = r >> 6, nb = r & 63; transpose_item(F.in[29] + (size_t)l * DM * DM, DM, DM, (bf16_t*)(ws_ + WS_WOUT + (size_t)l * SZ_WOUT), DM, 64 * kb, 32 * nb, 32 * nb, scr, lane); }
        }
    }
    const int gt = F.bid * 512 + tid, NTT = F.G * 512;
    for (int it = gt; it < 2 * 192 * 256; it += NTT) { const int l = it / (192 * 256), r = it - l * (192 * 256);
        *(u32x4*)(ws_ + WS_WIN + (size_t)l * SZ_WIN + kb64(NY, D_IN + (r >> 8), (r & 255) * 8) * 2) = (u32x4){0u, 0u, 0u, 0u}; }
    for (int it = gt; it < 2 * 65536; it += NTT) { const int which = it >> 16, r = it & 65535, l = r >> 15, b = (r >> 14) & 1, e = (r & 16383) * 8;
        const float* src = F.in[3 + which] + ((size_t)(b * 2 + l) * 512 * 256) + e;
        const f32x4 v0 = *(const f32x4*)src, v1 = *(const f32x4*)(src + 4);
        u32x4 o; o.x = pk2(v0[0], v0[1]); o.y = pk2(v0[2], v0[3]); o.z = pk2(v1[0], v1[1]); o.w = pk2(v1[2], v1[3]);
        *(u32x4*)(ws_ + (which ? WS_CVB : WS_CKB) + ((size_t)(l * 2 + b) * 512 * 256 + e) * 2) = o; }
}

struct UTiles { const bf16_t* k1; const bf16_t* v1; int ld1, n1; const bf16_t* k2; const bf16_t* v2; int dpos2;
    DI att::Tile operator()(int j) const { att::Tile t;
        if (j < n1) { t.k = k1 + (size_t)j * 64 * ld1; t.v = v1 + (size_t)j * 64 * ld1; t.ldk = ld1; t.ldv = ld1; t.dpos = 0; t.masked = 0; }
        else { const int s = 64 * (j - n1); t.k = k2 + (size_t)s * 256; t.v = v2 + (size_t)s * YLD; t.ldk = 256; t.ldv = YLD; t.dpos = dpos2 + s; t.masked = 1; }
        return t; } };
DI int q_next(unsigned* ctr, volatile LAS int* slot) {
    __syncthreads();
    if (threadIdx.x == 0) *slot = (int)__hip_atomic_fetch_add(ctr, 1u, RLX_AGENT);
    __syncthreads();
    return *slot;
}
DI void mixer_phase(const Frame& F, unsigned char* lds_g, int layer_q) {
    unsigned char* const ws_ = F.ws;
    const int layer = layer_q & 1;
    LAS unsigned char* lds = (LAS unsigned char*)lds_g;
    volatile LAS int* slot = (volatile LAS int*)(lds + MISC_OFF + 64);
    unsigned* qc = (unsigned*)(ws_ + WS_CTL) + CW_Q + layer_q * 3 * 64;
    const bf16_t* Y = (const bf16_t*)(ws_ + WS_BIG); bf16_t* OC = (bf16_t*)(ws_ + WS_OCAT);
    const float* sinkp = F.in[25] + layer * 8;
    for (;;) {
        const int qi = q_next(qc, slot); if (qi >= 864) break;
        if (qi < 16 || (qi >= 96 && qi < 352)) gla_chain(F, lds, qi < 16 ? qi : qi - 96 + 16, layer);
        else if (qi < 32 || (qi >= 352 && qi < 608)) ssd_chain(F, lds, qi < 32 ? qi - 16 : qi - 352 + 16, layer);
        else {
            const int it = qi < 96 ? qi - 32 : qi - 608 + 64;
            UTiles ts; int row0, hq, NT, ldq; const bf16_t* Qp;
            if (it < 64) { const int b = it >> 5, qb = it & 3; hq = (it >> 2) & 7; const int kvh = hq >> 2;
                row0 = M_CTX + b * 1024 + qb * 256; const int s0 = qb == 0 ? 0 : 256 * qb - 128, s1 = qb == 3 ? 1024 : 256 * qb + 384;
                ts.k1 = (const bf16_t*)(ws_ + WS_CKB) + (size_t)(layer * 2 + b) * 512 * 256 + kvh * 128; ts.v1 = (const bf16_t*)(ws_ + WS_CVB) + (size_t)(layer * 2 + b) * 512 * 256 + kvh * 128; ts.ld1 = 256; ts.n1 = 8;
                ts.k2 = (const bf16_t*)(ws_ + WS_KR) + (size_t)(b * 1024 + s0) * 256 + kvh * 128; ts.v2 = Y + yaddr(M_CTX + b * 1024 + s0, YC_AV + kvh * 128); ts.dpos2 = s0 - qb * 256;
                NT = 8 + (s1 - s0) / 64; Qp = (const bf16_t*)(ws_ + WS_QR) + (size_t)(b * 1024 + qb * 256) * 1024 + hq * 128; ldq = 1024;
            } else { const int u = it - 64, b = u >> 3; hq = u & 7; const int kvh = hq >> 2; row0 = b * 256;
                ts.k1 = Y + yaddr(row0, YC_AK + kvh * 128); ts.v1 = Y + yaddr(row0, YC_AV + kvh * 128); ts.ld1 = YLD; ts.n1 = 4; ts.k2 = ts.k1; ts.v2 = ts.v1; ts.dpos2 = 0;
                NT = 4; Qp = Y + yaddr(row0, YC_AQ + hq * 128); ldq = YLD; }
            att::attn_unit(Qp, ldq, ts, NT, sinkp[hq], OC + kb64(MT, row0, 2048 + hq * 128), 64, (char*)lds_g);
        }
    }

}

#ifndef SITE_MASK
#define SITE_MASK 1023
#endif

constexpr int N_PH = 56;
struct Args { const float* in[35]; float* out; unsigned char* ws; int ph_lo, ph_hi; };
static_assert(sizeof(Args) == 37 * 8 + 8, "Args has no padding");
__global__ void __launch_bounds__(NWAVES * 64, 2) trunk_fwd(Args args) {
    extern __shared__ __attribute__((aligned(16))) unsigned char lds[];
    LAS unsigned char* L = (LAS unsigned char*)lds;
    Frame F; F.ws = args.ws; F.out = args.out; F.in = args.in;
    F.G = gridDim.x; F.bid = blockIdx.x;
    const int lo = args.ph_lo, hi = args.ph_hi;
    for (int u = threadIdx.x; u < (LDS_BYTES - RING_BYTES) / 4; u += NWAVES * 64) ((LAS unsigned*)(L + RING_BYTES))[u] = 0u;
    __syncthreads();
    XcdBarrier bar; bar.bar = (unsigned*)(F.ws + WS_CTL) + CW_BAR; bar.x = 0; bar.st = nullptr;
    if (hi - lo > 1) bar = xcd_barrier_post((unsigned*)(F.ws + WS_CTL) + CW_BAR, (volatile LAS unsigned*)(L + MISC_OFF) + 8);
#define RUN(p) (lo <= (p) && (p) < hi)
#define SEAM(p) do { if ((p) + 1 < hi) xcd_barrier(bar); } while (0)
    bf16_t* X = (bf16_t*)(F.ws + WS_XB);
    float* MOD = (float*)(F.ws + WS_MOD);
    bf16_t* XN = (bf16_t*)(F.ws + WS_XN); bf16_t* Y = (bf16_t*)(F.ws + WS_BIG); bf16_t* H = (bf16_t*)(F.ws + WS_BIG);
    bf16_t* Mb = (bf16_t*)(F.ws + WS_XBC); bf16_t* OC = (bf16_t*)(F.ws + WS_OCAT);

    #if SITE_MASK & 1
    if (RUN(0)) { for (int rep = 0; rep < NREP(1); ++rep) { prologue_phase(F, L); SEAM(0); } }
#endif
    for (int step = 0; step < 6; ++step) {
        const int l = step / 3, sb = step - 3 * l, pid = 1 + 9 * step;
        const bool ffn = sb != 1; const int f = sb >> 1;
        const float* modl = MOD + (size_t)l * 3 * NMOD + (size_t)sb * 3 * DM;
#if SITE_MASK & 2
        if (RUN(pid + 0)) { const float* nw = F.in[sb == 0 ? 10 : (sb == 1 ? 14 : 30)] + (size_t)l * DM; for (int rep = 0; rep < NREP(2); ++rep) { if (step == 0) norm_phase(F, F.in[0], F.in[1] - (size_t)M_CTX * DM, nw, modl, XN); else norm_phase_b(F, X, nw, modl, XN); SEAM(pid + 0); } }
#endif
        if (ffn) {
#if SITE_MASK & 4
            if (RUN(pid + 1)) {
                pg8::Prob P; P.A = (const char*)XN; P.Bt = (const char*)(F.ws + WS_WGU + (size_t)(l * 2 + f) * SZ_WGU); P.lda = 64; P.ldb = 64; P.kstepA = (size_t)MT * 128; P.kstepB = (size_t)NGU * 128; P.nM = MT / 256; P.nN = NGU / 256; P.ntk = DM / 64; P.nseg = 1; P.a_seg = 0; P.b_seg = 0; P.G = F.G; { const int b_ = opaque_s(F.bid); P.c = XCD_CONTIG ? ((b_ & 31) * 8 + (b_ >> 5)) : b_; }
                EpiSwiGLU E{H}; for (int rep = 0; rep < NREP(4); ++rep) { pg8::gemm_phase(L, P, E); SEAM(pid + 1); } }
#endif
        } else {
#if SITE_MASK & 8
            if (RUN(pid + 2)) {
                pg8::Prob P; P.A = (const char*)XN; P.Bt = (const char*)(F.ws + WS_WIN + (size_t)l * SZ_WIN); P.lda = 64; P.ldb = 64; P.kstepA = (size_t)MT * 128; P.kstepB = (size_t)NY * 128; P.nM = MT / 256; P.nN = NY / 256; P.ntk = DM / 64; P.nseg = 1; P.a_seg = 0; P.b_seg = 0; P.G = F.G; { const int b_ = opaque_s(F.bid); P.c = XCD_CONTIG ? ((b_ & 31) * 8 + (b_ >> 5)) : b_; }
                EpiY E{Y, (float*)(F.ws + WS_YS)}; for (int rep = 0; rep < NREP(8); ++rep) { pg8::gemm_phase(L, P, E); SEAM(pid + 2); } }
#endif
#if SITE_MASK & 16
            if (RUN(pid + 3)) { for (int rep = 0; rep < NREP(16); ++rep) { prep_phase(F, l); SEAM(pid + 3); } }
#endif
#if SITE_MASK & 32
            if (RUN(pid + 4)) { for (int rep = 0; rep < NREP(32); ++rep) { mixer_phase(F, lds, l + 2 * rep); SEAM(pid + 4); } }
#endif
#if SITE_MASK & 64
            if (RUN(pid + 5)) { for (int rep = 0; rep < NREP(64); ++rep) { combine_phase(F, l); SEAM(pid + 5); } }
#endif
#if SITE_MASK & 128
            if (RUN(pid + 6)) {
                pg8::Prob P; P.A = (const char*)OC; P.Bt = (const char*)(F.ws + WS_WBR + (size_t)l * 3 * SZ_WBR); P.lda = 64; P.ldb = 64; P.kstepA = (size_t)MT * 128; P.kstepB = (size_t)DM * 128; P.nM = MT / 256; P.nN = DM / 256; P.ntk = 1024 / 64; P.nseg = 3; P.a_seg = (size_t)16 * MT * 128; P.b_seg = SZ_WBR; P.G = F.G; { const int b_ = opaque_s(F.bid); P.c = XCD_CONTIG ? ((b_ & 31) * 8 + (b_ >> 5)) : b_; }
                EpiBranch E{Y, (bf16_t*)(F.ws + WS_ODG)}; for (int rep = 0; rep < NREP(128); ++rep) { pg8::gemm_phase(L, P, E); SEAM(pid + 6); } }
            if (RUN(pid + 7)) { msum_phase(F); SEAM(pid + 7); }
#endif
        }
#if SITE_MASK & 256
        if (RUN(pid + 8)) {
            pg8::ProbSK P; P.G = F.G; { const int b_ = opaque_s(F.bid); P.vc = (F.G & 7) ? b_ : (b_ & 7) * (F.G >> 3) + (b_ >> 3); }
            if (ffn) { P.A = (const char*)H; P.Bt = (const char*)(F.ws + WS_WD + (size_t)(l * 2 + f) * SZ_WD); P.q4 = FF / 64 / 4; }
            else { P.A = (const char*)Mb; P.Bt = (const char*)(F.ws + WS_WOUT + (size_t)l * SZ_WOUT); P.q4 = DM / 64 / 4; }
            P.lda = 64; P.ldb = 64; P.kstepA = (size_t)MT * 128; P.kstepB = (size_t)DM * 128;
            P.slab = (const float*)(F.ws + WS_SLAB);
            for (int rep = 0; rep < NREP(256); ++rep) {
                P.flags = (unsigned*)(F.ws + WS_CTL) + CW_SK + (step + 6 * rep) * 256 * 64;
                if (step == 0 && rep == 0) { EpiSK<EpiResid<true>> E{EpiResid<true>{X, modl + 2 * DM, 0.5f, F.in[0], F.in[1] - (size_t)M_CTX * DM}, (float*)(F.ws + WS_SLAB), P.flags}; pg8::gemm_phase(L, P, E); }
                else { EpiSK<EpiResid<false>> E{EpiResid<false>{X, modl + 2 * DM, rep ? 0.0f : (ffn ? 0.5f : 1.0f), nullptr, nullptr}, (float*)(F.ws + WS_SLAB), P.flags}; pg8::gemm_phase(L, P, E); }
                SEAM(pid + 8); } }
#endif
    }
#if SITE_MASK & 512
    if (RUN(55)) final_norm_phase(F, X, F.out, F.in[34]);
#endif
#undef RUN
#undef SEAM
}

#ifndef MK_PER_PHASE
#define MK_PER_PHASE 0
#endif
extern "C" void kernel_launch(void* const* d_in, const int* in_sizes, int n_in, void* d_out, int out_size, void* d_ws, size_t ws_size, hipStream_t stream) {
    static int grid = 0;
    if (grid == 0) {
        if (n_in != 35 || out_size != (int)OUT_TOTAL || ws_size < WS_END) { fprintf(stderr, "kernel_launch: unexpected shapes: n_in %d out %d ws %zu (need %zu)\n", n_in, out_size, ws_size, (size_t)WS_END); grid = -1; return; }
        int dev = 0, cus = 0, per_cu = 0;
        if (hipGetDevice(&dev) != hipSuccess || hipDeviceGetAttribute(&cus, hipDeviceAttributeMultiprocessorCount, dev) != hipSuccess) { grid = -1; return; }
        if (hipFuncSetAttribute((const void*)trunk_fwd, hipFuncAttributeMaxDynamicSharedMemorySize, LDS_BYTES) != hipSuccess) { fprintf(stderr, "kernel_launch: hipFuncSetAttribute failed\n"); grid = -1; return; }
        if (hipOccupancyMaxActiveBlocksPerMultiprocessor(&per_cu, (const void*)trunk_fwd, NWAVES * 64, LDS_BYTES) != hipSuccess || per_cu < 1) { fprintf(stderr, "kernel_launch: occupancy query says %d blocks per CU\n", per_cu); }
        (void)hipGetLastError();
        grid = cus;
    }
    if (grid < 0) return;
    (void)hipMemsetAsync((char*)d_ws + WS_CTL, 0, CTL_ZERO_BYTES, stream);
    Args a{};
    for (int i = 0; i < 35; ++i) a.in[i] = (const float*)d_in[i];
    a.out = (float*)d_out; a.ws = (unsigned char*)d_ws;
#if MK_PER_PHASE
    for (int p = 0; p < N_PH; ++p) {
        if (p >= 1 && p <= 54) { const int step = (p - 1) / 9, site = (p - 1) % 9; const bool ffn = (step % 3) != 1;
            if (site == 1 && !ffn) continue; if (site >= 2 && site <= 7 && ffn) continue; }
        a.ph_lo = p; a.ph_hi = p + 1;
        hipLaunchKernelGGL(trunk_fwd, dim3(grid), dim3(NWAVES * 64), LDS_BYTES, stream, a);
    }
#else
    a.ph_lo = 0; a.ph_hi = N_PH;
    hipLaunchKernelGGL(trunk_fwd, dim3(grid), dim3(NWAVES * 64), LDS_BYTES, stream, a);
#endif
    const hipError_t le = hipPeekAtLastError();
    if (le != hipSuccess) fprintf(stderr, "kernel_launch: launch failed: %s\n", hipGetErrorName(le));
}
```

```cpp
#include <hip/hip_runtime.h>
#include <cstdio>
#include <cstdint>

#ifndef MIX_MASK
#define MIX_MASK 7
#endif
#ifndef PG8_ALIGN
#define PG8_ALIGN 1
#endif
#ifndef XCD_CONTIG
#define XCD_CONTIG 0
#endif
#ifdef PROBE_DUP_OVERRIDE
#define PROBE_DUP PROBE_DUP_OVERRIDE
#endif
#ifndef PROBE_DUP
#define PROBE_DUP 0
#endif
#define NREP(bit) ((PROBE_DUP & (bit)) ? 2 : 1)
#define GAS __attribute__((address_space(1)))
#define LAS __attribute__((address_space(3)))
#define DI __device__ __forceinline__
typedef unsigned short bf16_t;
typedef short bf16x8 __attribute__((ext_vector_type(8)));
typedef short s16x4 __attribute__((ext_vector_type(4)));
typedef float f32x4 __attribute__((ext_vector_type(4)));
typedef float f32x2 __attribute__((ext_vector_type(2)));
typedef float f32x8 __attribute__((ext_vector_type(8)));
typedef float f32x16 __attribute__((ext_vector_type(16)));
typedef unsigned u32x4 __attribute__((ext_vector_type(4)));
typedef unsigned u32x2 __attribute__((ext_vector_type(2)));
typedef __bf16 bf16x2_t __attribute__((ext_vector_type(2)));
typedef GAS unsigned gu32;

constexpr int DM = 2048, FF = 5632, NMOD = 9 * DM;
constexpr int M_CTX = 8192, M_LAT = 2048, MT = 10240;
constexpr int NGU = 2 * FF;
constexpr int D_IN = 13888, NY = 14080;
constexpr int YC_GQ = 0, YC_GK = 512, YC_GV = 1024, YC_GR = 2048, YC_SZ = 3072, YC_XBC = 4096, YC_AQ = 6144, YC_AK = 7168, YC_AV = 7424, YC_BR = 7680, YC_GD = 13824, YC_DT = 13856;
constexpr float RMS_EPS = 1e-6f;

constexpr size_t OUT_YP = 0, OUT_YS = 16777216, OUT_CK = 20971520, OUT_CV = 25165824, OUT_GLA = 29360128, OUT_SSM = 46137344, OUT_TOTAL = 62914560;

constexpr size_t MiB = 1u << 20;
constexpr size_t WS_CTL = 0, CTL_ZERO_BYTES = 2 * MiB;
constexpr size_t WS_MOD = 2 * MiB;
constexpr size_t WS_DT = 3 * MiB;
constexpr size_t WS_DTA = WS_DT + (size_t)MT * 32 * 4;
constexpr size_t WS_YS = 6 * MiB;
constexpr size_t WS_CKB = 9 * MiB;
constexpr size_t WS_CVB = 10 * MiB;
constexpr size_t WS_KR = 11 * MiB;
constexpr size_t WS_WGU = 12 * MiB;
constexpr size_t SZ_WGU = (size_t)NGU * DM * 2;
constexpr size_t WS_WD = WS_WGU + 4 * SZ_WGU;
constexpr size_t SZ_WD = (size_t)DM * FF * 2;
constexpr size_t WS_WIN = WS_WD + 4 * SZ_WD;
constexpr size_t SZ_WIN = (size_t)NY * DM * 2;
constexpr size_t WS_WBR = WS_WIN + 2 * SZ_WIN;
constexpr size_t SZ_WBR = (size_t)DM * 1024 * 2;
constexpr size_t WS_WOUT = WS_WBR + 6 * SZ_WBR;
constexpr size_t SZ_WOUT = (size_t)DM * DM * 2;
constexpr size_t WS_XN = WS_WOUT + 2 * SZ_WOUT;
constexpr size_t WS_BIG = WS_XN + (size_t)MT * DM * 2;
constexpr size_t WS_XBC = WS_BIG + (size_t)MT * NY * 2;
constexpr size_t WS_LA = WS_XBC + (size_t)MT * 2048 * 2;
constexpr size_t WS_ODG = WS_LA + (size_t)MT * 1024 * 4;
constexpr size_t WS_ODS = WS_ODG + (size_t)2 * MT * 1024 * 4;
constexpr size_t WS_XB = WS_ODS + (size_t)2 * MT * 1024 * 2;
constexpr size_t WS_OCAT = WS_ODS + (size_t)2 * MT * 1024 * 4;
constexpr size_t WS_QR = WS_OCAT + (size_t)MT * 3072 * 2;
constexpr size_t WS_SLAB = WS_QR + (size_t)M_LAT * 1024 * 2;
constexpr size_t WS_END = WS_SLAB + (size_t)256 * 65536 * 4;
static_assert(WS_WGU % 256 == 0 && WS_XN % 256 == 0 && WS_BIG % 256 == 0 && WS_OCAT % 256 == 0, "ws alignment");
constexpr int CW_BAR = 4096;
constexpr int CW_Q = 16384;
constexpr int CW_SK = 32768;

constexpr int RING_BYTES = 131072;
constexpr int MISC_OFF = RING_BYTES + 320;
constexpr int LDS_BYTES = 147456;
constexpr int NWAVES = 8;

DI unsigned pk2(float lo, float hi) { f32x2 v = {lo, hi}; bf16x2_t b = __builtin_convertvector(v, bf16x2_t); return __builtin_bit_cast(unsigned, b); }
DI float bflo(unsigned u) { return __uint_as_float(u << 16); }
DI float bfhi(unsigned u) { return __uint_as_float(u & 0xffff0000u); }
DI float bf2f(unsigned short s) { return __uint_as_float(((unsigned)s) << 16); }
DI float bf2f_s(short s) { return __uint_as_float(((unsigned)(unsigned short)s) << 16); }
DI unsigned short f2bf(float f) { return (unsigned short)(pk2(f, 0.f) & 0xffffu); }
DI float wave_sum(float v) {
#pragma unroll
    for (int o = 1; o < 64; o <<= 1) v += __shfl_xor(v, o);
    return v;
}
DI float fast_exp(float x) { return __builtin_amdgcn_exp2f(x * 1.4426950408889634f); }
DI float fast_sigmoid(float x) { return __builtin_amdgcn_rcpf(1.0f + fast_exp(-x)); }
DI float fast_silu(float x) { return x * fast_sigmoid(x); }
DI float softplusf(float x) { return fmaxf(x, 0.f) + __logf(1.0f + __expf(-fabsf(x))); }
DI size_t kb64(int rows, int row, int k) { return ((size_t)(k >> 6) * rows + row) * 64 + (k & 63); }
constexpr int YLD = 256;
DI size_t yaddr(int row, int col) { return ((size_t)(col >> 8) * MT + row) * YLD + (col & 255); }
DI int opaque_s(int x) { asm volatile("" : "+s"(x)); return x; }
DI int crow(int r, int hi) { return (r & 3) + 8 * (r >> 2) + 4 * hi; }
#define LDS_WAIT() asm volatile("s_waitcnt lgkmcnt(0)" ::: "memory")
#define VM_WAIT() asm volatile("s_waitcnt vmcnt(0)" ::: "memory")
#define RLX_AGENT __ATOMIC_RELAXED, __HIP_MEMORY_SCOPE_AGENT

namespace pg8 {
constexpr int BM = 256, BK = 64, HALF = 128, HTB = HALF * BK * 2, STAGE_BYTES = 8 * HTB, NXCD = 8, WGM = 8;
__host__ __device__ __forceinline__ int lds_byte(int r, int c) { const int st = (r >> 4) * 2 + (c >> 5), rr = r & 15, cc = c & 31, ob = rr * 64 + cc * 2; return st * 1024 + (ob ^ (((ob >> 9) & 1) << 5)); }
__host__ __device__ __forceinline__ void stage_rc(int b, int& R, int& C) { const int st = b / 1024, sb = b % 1024, swz = sb ^ (((sb >> 9) & 1) << 5); R = (st >> 1) * 16 + swz / 64; C = (st & 1) * 32 + (swz % 64) / 2; }
__host__ __device__ __forceinline__ int perm32(int rho) { const int n = rho >> 4, i = rho & 15; return 8 * (i >> 2) + 4 * n + (i & 3); }

struct Unit { int pm, pn, seg, k0, nt, role; };
struct Prob {
    const char* A; const char* Bt; int lda, ldb;
    size_t kstepA, kstepB;
    int nM, nN, ntk, nseg; size_t a_seg, b_seg;
    int G, c;
    DI bool next(int i, Unit& u) const {
        const int nwg = nM * nN; long L = (long)i * G + c; if (L >= (long)nwg * nseg) return false;
        u.seg = (int)(L / nwg); L -= (long)u.seg * nwg; u.k0 = 0; u.nt = ntk; u.role = 0;
        int wgid = (int)L; { const int q = nwg / NXCD, r = nwg % NXCD, xcd = wgid % NXCD, off = wgid / NXCD; wgid = (xcd < r ? xcd * (q + 1) : r * (q + 1) + (xcd - r) * q) + off; }
        const int nig = WGM * nN, gid = wgid / nig, fm = gid * WGM, gsz = (nM - fm) < WGM ? (nM - fm) : WGM;
        u.pm = fm + ((wgid % nig) % gsz); u.pn = (wgid % nig) / gsz; return true;
    }
    DI const char* aptr(const Unit& u) const { return A + (size_t)u.pm * BM * lda * 2 + (size_t)u.seg * a_seg; }
    DI const char* bptr(const Unit& u) const { return Bt + (size_t)u.pn * BM * ldb * 2 + (size_t)u.seg * b_seg; }
    DI void acc_init(const Unit&, f32x4 (&acc)[2][2][4][2], int) const {
#pragma unroll
        for (int a = 0; a < 2; ++a)
#pragma unroll
            for (int b = 0; b < 2; ++b)
#pragma unroll
                for (int m = 0; m < 4; ++m)
#pragma unroll
                    for (int n = 0; n < 2; ++n) acc[a][b][m][n] = (f32x4){0.f, 0.f, 0.f, 0.f};
    }
};
struct ProbSK {
    const char* A; const char* Bt; int lda, ldb, q4, vc, G;
    size_t kstepA, kstepB;
    DI bool next(int i, Unit& u) const {
        const int v = (i >> 1) * G + vc; if (v >= 256) return false;
        const int r = v & 3, gq = v >> 2; const bool quarter = (r < 3) == ((i & 1) == 0); int t;
        if (quarter) { t = 256 + gq; u.k0 = r * q4; u.nt = q4; u.role = r < 3 ? 1 : 2; }
        else { t = r == 3 ? gq : 64 + gq * 3 + r; u.k0 = 0; u.nt = 4 * q4; u.role = 0; }
        u.pm = t >> 3; u.pn = t & 7; u.seg = v; return true;
    }
    DI const char* aptr(const Unit& u) const { return A + (size_t)u.pm * BM * lda * 2 + (size_t)u.k0 * kstepA; }
    DI const char* bptr(const Unit& u) const { return Bt + (size_t)u.pn * BM * ldb * 2 + (size_t)u.k0 * kstepB; }
    const float* slab; unsigned* flags;
    DI void acc_init(const Unit& u, f32x4 (&acc)[2][2][4][2], int tid) const {
        if (u.role == 2) {
            if (tid < 64) {
                unsigned sp = 0;
                for (int j = 1; j <= 3; ++j)
                    while ((unsigned)__builtin_amdgcn_readfirstlane(__hip_atomic_load(flags + (u.seg - j) * 64, RLX_AGENT)) < 8u) { __builtin_amdgcn_s_sleep(2); if (++sp > (1u << 22)) break; }
                __builtin_amdgcn_fence(__ATOMIC_ACQUIRE, "agent");
                asm volatile("s_waitcnt vmcnt(0)" ::: "memory");
            }
            asm volatile("" ::: "memory"); __builtin_amdgcn_s_barrier(); asm volatile("" ::: "memory");
            const char* base = (const char*)(slab + (size_t)(u.seg - 3) * 65536); unsigned voff = (unsigned)tid * 16u; asm volatile("" : "+v"(voff));
#pragma unroll
            for (int a = 0; a < 2; ++a)
#pragma unroll
                for (int b = 0; b < 2; ++b)
#pragma unroll
                    for (int m = 0; m < 4; ++m) { const char* p = base + (size_t)(((a * 2 + b) * 4 + m) * 8192) + voff;
                        const u32x4 x = *(const u32x4*)p, y = *(const u32x4*)(p + 262144), z = *(const u32x4*)(p + 524288);
                        acc[a][b][m][0] = (f32x4){bflo(x.x) + bflo(y.x) + bflo(z.x), bfhi(x.x) + bfhi(y.x) + bfhi(z.x), bflo(x.y) + bflo(y.y) + bflo(z.y), bfhi(x.y) + bfhi(y.y) + bfhi(z.y)};
                        acc[a][b][m][1] = (f32x4){bflo(x.z) + bflo(y.z) + bflo(z.z), bfhi(x.z) + bfhi(y.z) + bfhi(z.z), bflo(x.w) + bflo(y.w) + bflo(z.w), bfhi(x.w) + bfhi(y.w) + bfhi(z.w)}; }
            asm volatile("s_waitcnt vmcnt(0)" ::: "memory");
        } else {
#pragma unroll
            for (int a = 0; a < 2; ++a)
#pragma unroll
                for (int b = 0; b < 2; ++b)
#pragma unroll
                    for (int m = 0; m < 4; ++m)
#pragma unroll
                        for (int n = 0; n < 2; ++n) acc[a][b][m][n] = (f32x4){0.f, 0.f, 0.f, 0.f};
        }
    }
};

template <class Epi, class PB>
DI void gemm_phase(LAS unsigned char* lds, const PB& S, const Epi& E) {
    int tid_ = threadIdx.x; asm volatile("" : "+v"(tid_));
    const int tid = tid_, wid = __builtin_amdgcn_readfirstlane(tid >> 6), lane = tid & 63, wr = wid >> 2, wc = wid & 3, fr = lane & 15, fq = lane >> 4;
    unsigned voffA[2], voffB[2];
#pragma unroll
    for (int i = 0; i < 2; ++i) { int R, C; stage_rc(tid * 16 + i * 8192, R, C); const int Rb = Epi::PERM ? ((R & ~31) + perm32(R & 31)) : R;
        voffA[i] = (unsigned)(R * S.lda + C) * 2u; voffB[i] = (unsigned)(Rb * S.ldb + C) * 2u; }
    const size_t kstepA = S.kstepA, kstepB = S.kstepB;
    const size_t hstepA = (size_t)HALF * S.lda * 2, hstepB = (size_t)HALF * S.ldb * 2;
    const unsigned ldsw = (unsigned)wid * 1024u;
    const int aoff = lds_byte(wr * 64 + fr, fq * 8), boff = lds_byte(wc * 32 + fr, fq * 8);
#define PG8_SA(b, h) (((b) * 2 + (h)) * HTB)
#define PG8_SB(b, h) ((4 + (b) * 2 + (h)) * HTB)
#define PG8_STAGE(bufoff, gbase, voff) do { _Pragma("unroll") for (int _i = 0; _i < 2; ++_i) \
        __builtin_amdgcn_global_load_lds((const unsigned*)((const char*)(gbase) + (voff)[_i]), (LAS unsigned*)(lds + (bufoff) + ldsw + _i * 8192), 16, 0, 0); } while (0)
#define PG8_LDA(dst, b, h) do { _Pragma("unroll") for (int m = 0; m < 4; ++m) _Pragma("unroll") for (int k = 0; k < 2; ++k) dst[m][k] = *(const LAS bf16x8*)(lds + PG8_SA(b, h) + aoff + m * 2048 + k * 1024); } while (0)
#define PG8_LDB(dst, b, h) do { _Pragma("unroll") for (int n = 0; n < 2; ++n) _Pragma("unroll") for (int k = 0; k < 2; ++k) dst[n][k] = *(const LAS bf16x8*)(lds + PG8_SB(b, h) + boff + n * 2048 + k * 1024); } while (0)
#define PG8_MMA(ai, bj, At, Bt) do { __builtin_amdgcn_s_setprio(1); _Pragma("unroll") for (int m = 0; m < 4; ++m) _Pragma("unroll") for (int n = 0; n < 2; ++n) _Pragma("unroll") for (int k = 0; k < 2; ++k) \
        acc[ai][bj][m][n] = __builtin_amdgcn_mfma_f32_16x16x32_bf16(Bt[n][k], At[m][k], acc[ai][bj][m][n], 0, 0, 0); __builtin_amdgcn_s_setprio(0); } while (0)
#define PG8_WAIT_V(n) asm volatile("s_waitcnt vmcnt(" #n ")" ::: "memory")
#define PG8_WAIT_L(n) asm volatile("s_waitcnt lgkmcnt(" #n ")" ::: "memory")
#define PG8_BAR __builtin_amdgcn_s_barrier()
#define PG8_SCHED __builtin_amdgcn_sched_barrier(0)
    Unit cur, nxt; int ui = 0;
    if (!S.next(0, cur)) return;
    f32x4 acc[2][2][4][2];
#pragma unroll
    for (int a = 0; a < 2; ++a)
#pragma unroll
        for (int b = 0; b < 2; ++b)
#pragma unroll
            for (int m = 0; m < 4; ++m)
#pragma unroll
                for (int n = 0; n < 2; ++n) acc[a][b][m][n] = (f32x4){0.f, 0.f, 0.f, 0.f};
    bf16x8 At[4][2], B0[2][2], B1[2][2];
    const char* cA = S.aptr(cur); const char* cB = S.bptr(cur);
    PG8_STAGE(PG8_SB(0, 0), cB, voffB); PG8_STAGE(PG8_SB(0, 1), cB + hstepB, voffB); PG8_STAGE(PG8_SA(0, 0), cA, voffA); PG8_STAGE(PG8_SA(0, 1), cA + hstepA, voffA);
    if (wr == 1) PG8_BAR;
    PG8_WAIT_V(2); PG8_BAR;
    PG8_STAGE(PG8_SB(1, 0), cB + kstepB, voffB); PG8_STAGE(PG8_SA(1, 0), cA + kstepA, voffA); PG8_STAGE(PG8_SB(1, 1), cB + hstepB + kstepB, voffB);
    PG8_WAIT_V(6); PG8_BAR;
    for (;;) {
        const bool has_next = S.next(ui + 1, nxt);
        const char* nA = has_next ? S.aptr(nxt) : cA; const char* nB = has_next ? S.bptr(nxt) : cB;
        const int nt = cur.nt;
        for (int t = 0; t < nt; t += 2) {
            const bool last = (t == nt - 2);
            const char* a1 = cA + (size_t)(t + 1) * kstepA;
            const char* a2 = last ? nA : cA + (size_t)(t + 2) * kstepA; const char* b2 = last ? nB : cB + (size_t)(t + 2) * kstepB;
            const char* a3 = a2 + kstepA; const char* b3 = b2 + kstepB;
            PG8_LDB(B0, 0, 0); PG8_LDB(B1, 0, 1); PG8_SCHED; PG8_LDA(At, 0, 0); PG8_STAGE(PG8_SA(1, 1), a1 + hstepA, voffA);
            PG8_WAIT_V(8); PG8_WAIT_L(0); PG8_BAR; PG8_MMA(0, 0, At, B0); PG8_MMA(0, 1, At, B1); PG8_BAR; PG8_SCHED;
            PG8_LDA(At, 0, 1); PG8_STAGE(PG8_SB(0, 0), b2, voffB); PG8_STAGE(PG8_SB(0, 1), b2 + hstepB, voffB); PG8_STAGE(PG8_SA(0, 0), a2, voffA);
            PG8_WAIT_V(8); PG8_WAIT_L(0); PG8_BAR; PG8_MMA(1, 0, At, B0); PG8_MMA(1, 1, At, B1); PG8_BAR; PG8_SCHED;
            PG8_LDB(B0, 1, 0); PG8_LDB(B1, 1, 1); PG8_SCHED; PG8_LDA(At, 1, 0); PG8_STAGE(PG8_SA(0, 1), a2 + hstepA, voffA);
            PG8_WAIT_V(8); PG8_WAIT_L(0); PG8_BAR; PG8_MMA(0, 0, At, B0); PG8_MMA(0, 1, At, B1); PG8_BAR; PG8_SCHED;
            PG8_LDA(At, 1, 1); PG8_STAGE(PG8_SB(1, 0), b3, voffB); PG8_STAGE(PG8_SB(1, 1), b3 + hstepB, voffB); PG8_STAGE(PG8_SA(1, 0), a3, voffA);
            PG8_WAIT_V(8); PG8_WAIT_L(0); PG8_BAR; PG8_MMA(1, 0, At, B0); PG8_MMA(1, 1, At, B1); PG8_BAR; PG8_SCHED;
        }
#if PG8_ALIGN
        if (wr == 0) PG8_BAR;
#endif
        E(acc, cur, wr, wc, fr, fq);
        if (!has_next) break;
        S.acc_init(nxt, acc, tid);
        cur = nxt; cA = nA; cB = nB; ++ui;
#if PG8_ALIGN
        if (wr == 1) PG8_BAR;
#endif
    }
    PG8_WAIT_V(0);
#if !PG8_ALIGN
    if (wr == 0) PG8_BAR;
#endif
    PG8_BAR;
#undef PG8_SA
#undef PG8_SB
#undef PG8_STAGE
#undef PG8_LDA
#undef PG8_LDB
#undef PG8_MMA
#undef PG8_WAIT_V
#undef PG8_WAIT_L
#undef PG8_BAR
#undef PG8_SCHED
}
}

DI int mod_index(int pm) { return pm < 32 ? 0 : 1 + ((pm - 32) >> 2); }
struct EpiSwiGLU {
    static constexpr bool PERM = true;
    bf16_t* H;
    DI void operator()(f32x4 (&acc)[2][2][4][2], const pg8::Unit& u, int wr, int wc, int fr, int fq) const {
        const int row0 = u.pm * 256 + wr * 64 + fr, col0 = u.pn * 128 + wc * 32 + 8 * fq;
#pragma unroll
        for (int ai = 0; ai < 2; ++ai)
#pragma unroll
            for (int m = 0; m < 4; ++m) {
                bf16_t* rowp = H + kb64(MT, row0 + ai * 128 + m * 16, col0);
                const f32x4 g0 = acc[ai][0][m][0], g1 = acc[ai][0][m][1], u0 = acc[ai][1][m][0], u1 = acc[ai][1][m][1];
                u32x4 w;
                w.x = pk2(fast_silu(g0[0]) * u0[0], fast_silu(g0[1]) * u0[1]); w.y = pk2(fast_silu(g0[2]) * u0[2], fast_silu(g0[3]) * u0[3]);
                w.z = pk2(fast_silu(g1[0]) * u1[0], fast_silu(g1[1]) * u1[1]); w.w = pk2(fast_silu(g1[2]) * u1[2], fast_silu(g1[3]) * u1[3]);
                *(u32x4*)rowp = w;
            }
    }
};
template <bool F32IN> struct EpiResid {
    static constexpr bool PERM = true; static constexpr int MB = F32IN ? 2 : 4;
    bf16_t* X; const float* gvec; float coef;
    const float* Xa; const float* Xb;
    DI void operator()(f32x4 (&acc)[2][2][4][2], const pg8::Unit& u, int wr, int wc, int fr, int fq) const {
        const int row0 = u.pm * 256 + wr * 64 + fr, col0 = u.pn * 256 + wc * 32 + 8 * fq;
        const float* Xi = u.pm < 32 ? Xa : Xb;
        const float* gv = gvec + (size_t)mod_index(u.pm) * NMOD + col0;
        f32x4 g[2][2];
#pragma unroll
        for (int bj = 0; bj < 2; ++bj)
#pragma unroll
            for (int n = 0; n < 2; ++n) g[bj][n] = *(const f32x4*)(gv + bj * 128 + n * 4) * coef;
        if (F32IN) {
#pragma unroll
            for (int ai = 0; ai < 2; ++ai)
#pragma unroll
                for (int mb = 0; mb < 4; mb += 2) {
                    f32x4 tv[2][2][2];
#pragma unroll
                    for (int mm = 0; mm < 2; ++mm) { const size_t ro = (size_t)(row0 + ai * 128 + (mb + mm) * 16) * DM + col0;
#pragma unroll
                        for (int bj = 0; bj < 2; ++bj) { tv[mm][bj][0] = *(const f32x4*)(Xi + ro + bj * 128); tv[mm][bj][1] = *(const f32x4*)(Xi + ro + bj * 128 + 4); } }
#pragma unroll
                    for (int mm = 0; mm < 2; ++mm) { const int m = mb + mm; bf16_t* rowp = X + ((size_t)u.pn * MT + row0 + ai * 128 + m * 16) * YLD + wc * 32 + 8 * fq;
#pragma unroll
                        for (int bj = 0; bj < 2; ++bj) { const f32x4 r0 = tv[mm][bj][0] + g[bj][0] * acc[ai][bj][m][0], r1 = tv[mm][bj][1] + g[bj][1] * acc[ai][bj][m][1];
                            u32x4 w; w.x = pk2(r0[0], r0[1]); w.y = pk2(r0[2], r0[3]); w.z = pk2(r1[0], r1[1]); w.w = pk2(r1[2], r1[3]); *(u32x4*)(rowp + bj * 128) = w; } }
                }
        } else {
            u32x4 tv[2][4][2];
            bf16_t* Xw = X + ((size_t)u.pn * MT + u.pm * 256 + wr * 64) * YLD + wc * 32;
            const unsigned lo = (unsigned)(fr * YLD + 8 * fq);
#define ER_LOAD(i) tv[(i) >> 3][((i) >> 1) & 3][(i) & 1] = *(const u32x4*)(Xw + (size_t)((((i) >> 3) * 128 + (((i) >> 1) & 3) * 16) * YLD + ((i) & 1) * 128) + lo)
#define ER_DONE(i) do { const int ai = (i) >> 3, m = ((i) >> 1) & 3, bj = (i) & 1; const u32x4 t = tv[ai][m][bj]; \
                const f32x4 r0 = (f32x4){bflo(t.x), bfhi(t.x), bflo(t.y), bfhi(t.y)} + g[bj][0] * acc[ai][bj][m][0], r1 = (f32x4){bflo(t.z), bfhi(t.z), bflo(t.w), bfhi(t.w)} + g[bj][1] * acc[ai][bj][m][1]; \
                u32x4 w; w.x = pk2(r0[0], r0[1]); w.y = pk2(r0[2], r0[3]); w.z = pk2(r1[0], r1[1]); w.w = pk2(r1[2], r1[3]); \
                *(u32x4*)(Xw + (size_t)((ai * 128 + m * 16) * YLD + bj * 128) + lo) = w; } while (0)
#pragma unroll
            for (int i = 0; i < 12; ++i) ER_LOAD(i);
            asm volatile("" ::: "memory");
#pragma unroll
            for (int i = 0; i < 4; ++i) ER_DONE(i);
            asm volatile("" ::: "memory");
#pragma unroll
            for (int i = 12; i < 16; ++i) ER_LOAD(i);
            asm volatile("" ::: "memory");
#pragma unroll
            for (int i = 4; i < 16; ++i) ER_DONE(i);
#undef ER_LOAD
#undef ER_DONE
        }
    }
};
template <class Epi> struct EpiSK {
    static constexpr bool PERM = Epi::PERM;
    Epi E; float* slab; unsigned* flags;
    DI void operator()(f32x4 (&acc)[2][2][4][2], const pg8::Unit& u, int wr, int wc, int fr, int fq) const {
        const int tid = threadIdx.x;
        const unsigned voff = (unsigned)tid * 16u;
        if (u.role == 1) {
            const char* base = (const char*)(slab + (size_t)u.seg * 65536);
#pragma unroll
            for (int ai = 0; ai < 2; ++ai)
#pragma unroll
                for (int bj = 0; bj < 2; ++bj)
#pragma unroll
                    for (int m = 0; m < 4; ++m) { const f32x4 a0 = acc[ai][bj][m][0], a1 = acc[ai][bj][m][1];
                        u32x4 w; w.x = pk2(a0[0], a0[1]); w.y = pk2(a0[2], a0[3]); w.z = pk2(a1[0], a1[1]); w.w = pk2(a1[2], a1[3]);
                        asm volatile("global_store_dwordx4 %0, %1, %2 sc1" :: "v"(voff), "v"(w), "s"(base) : "memory"); base += 8192; asm volatile("" : "+s"(base)); }
            asm volatile("s_waitcnt vmcnt(0)" ::: "memory");
            if ((tid & 63) == 0) __hip_atomic_fetch_add(flags + u.seg * 64, 1u, RLX_AGENT);
            return;
        }
        if (PROBE_DUP != 0 && E.coef == 0.f) return;
        E(acc, u, wr, wc, fr, fq);
    }
};
struct EpiY {
    static constexpr bool PERM = true;
    bf16_t* Y; float* YS;
    DI void operator()(f32x4 (&acc)[2][2][4][2], const pg8::Unit& u, int wr, int wc, int fr, int fq) const {
        const int row0 = u.pm * 256 + wr * 64 + fr, col0 = u.pn * 256 + wc * 32 + 8 * fq;
#pragma unroll
        for (int ai = 0; ai < 2; ++ai)
#pragma unroll
            for (int m = 0; m < 4; ++m) {
                bf16_t* rowp = Y + ((size_t)u.pn * MT + row0 + ai * 128 + m * 16) * YLD + wc * 32 + 8 * fq;
#pragma unroll
                for (int bj = 0; bj < 2; ++bj) { const f32x4 v0 = acc[ai][bj][m][0], v1 = acc[ai][bj][m][1];
                    u32x4 w; w.x = pk2(v0[0], v0[1]); w.y = pk2(v0[2], v0[3]); w.z = pk2(v1[0], v1[1]); w.w = pk2(v1[2], v1[3]);
                    *(u32x4*)(rowp + bj * 128) = w; }
            }
        if (u.pn == 54 && wc < 2) {
#pragma unroll
            for (int ai = 0; ai < 2; ++ai)
#pragma unroll
                for (int m = 0; m < 4; ++m) { float* p = YS + (size_t)(row0 + ai * 128 + m * 16) * 64 + wc * 32 + 8 * fq;
                    *(f32x4*)p = acc[ai][0][m][0]; *(f32x4*)(p + 4) = acc[ai][0][m][1]; }
        }
    }
};
struct EpiBranch {
    static constexpr bool PERM = true;
    const bf16_t* Y; bf16_t* PB;
    DI void operator()(f32x4 (&acc)[2][2][4][2], const pg8::Unit& u, int wr, int wc, int fr, int fq) const {
        const int row0 = u.pm * 256 + wr * 64 + fr, col0 = u.pn * 256 + wc * 32 + 8 * fq;
        bf16_t* P = PB + (size_t)u.seg * MT * DM;
#pragma unroll
        for (int ai = 0; ai < 2; ++ai) {
            u32x4 gb[4][2];
#pragma unroll
            for (int m = 0; m < 4; ++m)
#pragma unroll
                for (int bj = 0; bj < 2; ++bj) gb[m][bj] = *(const u32x4*)(Y + ((size_t)(YC_BR / 256 + u.seg * 8 + u.pn) * MT + row0 + ai * 128 + m * 16) * YLD + wc * 32 + 8 * fq + bj * 128);
#pragma unroll
            for (int m = 0; m < 4; ++m) {
                const size_t row = (size_t)(row0 + ai * 128 + m * 16);
#pragma unroll
                for (int bj = 0; bj < 2; ++bj) {
                    const u32x4 g = gb[m][bj]; const f32x4 v0 = acc[ai][bj][m][0], v1 = acc[ai][bj][m][1];
                    u32x4 w;
                    w.x = pk2(fast_sigmoid(bflo(g.x)) * v0[0], fast_sigmoid(bfhi(g.x)) * v0[1]); w.y = pk2(fast_sigmoid(bflo(g.y)) * v0[2], fast_sigmoid(bfhi(g.y)) * v0[3]);
                    w.z = pk2(fast_sigmoid(bflo(g.z)) * v1[0], fast_sigmoid(bfhi(g.z)) * v1[1]); w.w = pk2(fast_sigmoid(bflo(g.w)) * v1[2], fast_sigmoid(bfhi(g.w)) * v1[3]);
                    *(u32x4*)(P + ((size_t)u.pn * MT + row) * YLD + wc * 32 + 8 * fq + bj * 128) = w;
                }
            }
        }
    }
};

#define XB_TMO      128
#define XB_XCNT(j)  (256  + 64 * (j))
#define XB_XSUB(j)  (1280 + 64 * (j))
#define XB_XGEN(j)  (2304 + 64 * (j))
#define XB_TOP      3328
#define XB_TOPGEN   3392
#define XCD_BAR_WORDS 3456
#define XB_SPIN_CAP (1u << 18)
DI unsigned xb_ld(GAS unsigned* p)              { return __hip_atomic_load(p, __ATOMIC_RELAXED, __HIP_MEMORY_SCOPE_AGENT); }
DI unsigned xb_add(GAS unsigned* p, unsigned v) { return __hip_atomic_fetch_add(p, v, __ATOMIC_RELAXED, __HIP_MEMORY_SCOPE_AGENT); }
DI unsigned xb_xcc_id() { return (unsigned)__builtin_amdgcn_s_getreg((3 << 11) | 20) & 0xFu; }
#define XB_SPIN(cond, bar) do { unsigned _sp = 0; while (cond) { __builtin_amdgcn_s_sleep(1); \
    if ((++_sp & 255u) == 0u) { if (xb_ld(&(bar)[XB_TMO])) break; if (_sp > XB_SPIN_CAP) { xb_add(&(bar)[XB_TMO], 1u); break; } } } } while (0)
struct XcdBarrier { unsigned* bar; unsigned x; volatile LAS unsigned* st; };
DI XcdBarrier xcd_barrier_post(unsigned* bar, volatile LAS unsigned* st) {
    XcdBarrier b; b.bar = bar; b.x = xb_xcc_id(); b.st = st;
    if (threadIdx.x == 0) (void)xb_add(&((GAS unsigned*)bar)[XB_XCNT(b.x)], 1u);
    return b;
}
DI void xcd_barrier_complete(GAS unsigned* bar, unsigned x, unsigned& nloc, unsigned& nx) {
    const unsigned G = gridDim.x * gridDim.y * gridDim.z;
    unsigned sum, cnt, mine, sp = 0u;
    for (;;) {
        sum = 0u; cnt = 0u; mine = 0u;
#pragma unroll
        for (unsigned j = 0; j < 16; ++j) { const unsigned c = xb_ld(&bar[XB_XCNT(j)]); sum += c; cnt += (c > 0u) ? 1u : 0u; mine = (j == x) ? c : mine; }
        if (sum == G) break;
        __builtin_amdgcn_s_sleep(1);
        if ((++sp & 255u) == 0u) { if (xb_ld(&bar[XB_TMO])) break; if (sp > XB_SPIN_CAP) { xb_add(&bar[XB_TMO], 1u); break; } }
    }
    nloc = mine > 0u ? mine : 1u; nx = cnt > 0u ? cnt : 1u;
}
DI void xcd_barrier(const XcdBarrier& b) {
    asm volatile("s_waitcnt vmcnt(0)" ::: "memory");
    __syncthreads();
    if (threadIdx.x == 0) {
        GAS unsigned* bar = (GAS unsigned*)b.bar; asm volatile("" : "+s"(bar));
        __builtin_amdgcn_s_waitcnt(0);
        unsigned nloc = b.st[0], nx = b.st[1];
        if (nloc == 0u) { xcd_barrier_complete(bar, b.x, nloc, nx); b.st[0] = nloc; b.st[1] = nx; }
        const unsigned old = xb_add(&bar[XB_XSUB(b.x)], 1u);
        const unsigned gen = old / nloc;
        if (old + 1u == (gen + 1u) * nloc) {
            __builtin_amdgcn_fence(__ATOMIC_RELEASE, "agent");
            asm volatile("s_waitcnt vmcnt(0)" ::: "memory");
            const unsigned og = xb_add(&bar[XB_TOP], 1u);
            const unsigned tg = og / nx;
            if (og + 1u == (tg + 1u) * nx) xb_add(&bar[XB_TOPGEN], 1u);
            else XB_SPIN(xb_ld(&bar[XB_TOPGEN]) == tg, bar);
            __builtin_amdgcn_fence(__ATOMIC_ACQUIRE, "agent");
            xb_add(&bar[XB_XGEN(b.x)], 1u);
            asm volatile("s_waitcnt vmcnt(0)" ::: "memory");
        } else {
            XB_SPIN(xb_ld(&bar[XB_XGEN(b.x)]) == gen, bar);
            __builtin_amdgcn_fence(__ATOMIC_ACQUIRE, "agent");
            asm volatile("s_waitcnt vmcnt(0)" ::: "memory");
        }
    }
    __syncthreads();
}

namespace att {
constexpr int D = 128, NW = 8, QBLK = 32, KVBLK = 64;
constexpr float SCALE = 0.088388347648318440f;
constexpr float THR = 8.f;
constexpr size_t SHM_V = KVBLK * D * 2, SHM_K = KVBLK * D * 2;
#define KSWZ(row, colB) ((row) * 256 + ((colB) ^ (((row) & 7) << 4)))
#define SBAR() __builtin_amdgcn_sched_barrier(0)
DI unsigned cvtpk(float lo, float hi) { return pk2(lo, hi); }
struct Tile { const bf16_t* k; const bf16_t* v; int ldk, ldv, dpos, masked; };

DI void partialSM(f32x16& p0, f32x16& p1, float& m_reg, float& mn, float& alpha) {
  constexpr float C = SCALE * 1.4426950408889634f;
  float pmax = p0[0];
#pragma unroll
  for (int r = 1; r < 16; ++r) pmax = fmaxf(pmax, p0[r]);
#pragma unroll
  for (int r = 0; r < 16; ++r) pmax = fmaxf(pmax, p1[r]);
  { auto rr = __builtin_amdgcn_permlane32_swap(__float_as_uint(pmax), __float_as_uint(pmax), false, false);
    pmax = fmaxf(__uint_as_float(rr[0]), __uint_as_float(rr[1])); }
  if (__builtin_expect(__all(pmax - m_reg <= THR / SCALE), 1)) { mn = m_reg; alpha = 1.f; }
  else { mn = fmaxf(m_reg, pmax); alpha = __builtin_amdgcn_exp2f((m_reg - mn) * C); m_reg = mn; }
  float mnC = -mn * C;
#pragma unroll
  for (int r = 0; r < 16; ++r) p0[r] = fmaf(p0[r], C, mnC);
#pragma unroll
  for (int r = 0; r < 16; ++r) p1[r] = fmaf(p1[r], C, mnC);
#pragma unroll
  for (int r = 0; r < 16; ++r) p0[r] = __builtin_amdgcn_exp2f(p0[r]);
}
DI void finishSM(f32x16& p0, f32x16& p1, float alpha, float& l_reg, bf16x8& pa0, bf16x8& pa1, bf16x8& pa2, bf16x8& pa3) {
#pragma unroll
  for (int r = 0; r < 16; ++r) p1[r] = __builtin_amdgcn_exp2f(p1[r]);
  float ps = 0;
#pragma unroll
  for (int r = 0; r < 16; ++r) ps += p0[r];
#pragma unroll
  for (int r = 0; r < 16; ++r) ps += p1[r];
  { auto rr = __builtin_amdgcn_permlane32_swap(__float_as_uint(ps), __float_as_uint(ps), false, false);
    ps = __uint_as_float(rr[0]) + __uint_as_float(rr[1]); }
  l_reg = l_reg * alpha + ps;
#define PK4(P, BASE, OUT) do { unsigned a0 = cvtpk(P[BASE + 0], P[BASE + 1]), a1 = cvtpk(P[BASE + 2], P[BASE + 3]);   \
    unsigned b0 = cvtpk(P[BASE + 4], P[BASE + 5]), b1 = cvtpk(P[BASE + 6], P[BASE + 7]);                              \
    auto r0 = __builtin_amdgcn_permlane32_swap(a0, b0, false, false); auto r1 = __builtin_amdgcn_permlane32_swap(a1, b1, false, false); \
    u32x4 w = {r0[0], r1[0], r0[1], r1[1]}; OUT = __builtin_bit_cast(bf16x8, w); } while (0)
  PK4(p0, 0, pa0); PK4(p0, 8, pa1); PK4(p1, 0, pa2); PK4(p1, 8, pa3);
#undef PK4
}
DI void qkt(f32x16& p0, f32x16& p1, const char* Ks, const bf16x8* qr, int r32, int hi) {
#pragma unroll
  for (int i = 0; i < 16; ++i) { p0[i] = 0.f; p1[i] = 0.f; }
#pragma unroll
  for (int d0 = 0; d0 < 8; ++d0) { int cb = (d0 * 16 + hi * 8) * 2;
    bf16x8 b0 = *reinterpret_cast<const bf16x8*>(Ks + KSWZ(r32, cb));
    bf16x8 b1 = *reinterpret_cast<const bf16x8*>(Ks + KSWZ(32 + r32, cb));
    p0 = __builtin_amdgcn_mfma_f32_32x32x16_bf16(b0, qr[d0], p0, 0, 0, 0);
    p1 = __builtin_amdgcn_mfma_f32_32x32x16_bf16(b1, qr[d0], p1, 0, 0, 0); }
}
DI void amask(f32x16& p0, f32x16& p1, int dl, int hi) {
#pragma unroll
  for (int r = 0; r < 16; ++r) { const int kk = crow(r, hi);
    if ((unsigned)(dl + kk + 128) > 256u) p0[r] = -1e30f;
    if ((unsigned)(dl + kk + 32 + 128) > 256u) p1[r] = -1e30f; }
}
DI int v_st(int k, int c) { const int kk = (k & ~0xC) | ((k & 4) << 1) | ((k & 8) >> 1); return ((kk >> 3) * 4 + (c >> 5)) * 512 + ((kk & 7) * 32 + (c & 31)) * 2; }
DI int v_rd_base(int lane) { return ((lane & 3) << 3) | (((lane >> 2) & 3) << 6) | (((lane >> 4) & 1) << 5) | (((lane >> 5) & 1) << 8); }
constexpr int v_rd_off(int d0, int ks, int half) { return d0 * 512 + ks * 4096 + half * 2048; }
template <int OFF> DI s16x4 tr_read(int vb) {
  s16x4 r; asm volatile("ds_read_b64_tr_b16 %0, %1 offset:%2" : "=&v"(r) : "v"(vb), "i"(OFF) : "memory"); return r;
}
template <int D0> DI void pv_one(f32x16& od, int vb, bf16x8 pa0, bf16x8 pa1, bf16x8 pa2, bf16x8 pa3) {
  const s16x4 l0 = tr_read<v_rd_off(D0, 0, 0)>(vb), h0 = tr_read<v_rd_off(D0, 0, 1)>(vb), l1 = tr_read<v_rd_off(D0, 1, 0)>(vb), h1 = tr_read<v_rd_off(D0, 1, 1)>(vb);
  const s16x4 l2 = tr_read<v_rd_off(D0, 2, 0)>(vb), h2 = tr_read<v_rd_off(D0, 2, 1)>(vb), l3 = tr_read<v_rd_off(D0, 3, 0)>(vb), h3 = tr_read<v_rd_off(D0, 3, 1)>(vb);
  asm volatile("s_waitcnt lgkmcnt(0)" ::: "memory"); SBAR();
#define PK(L, H) (bf16x8){L[0], L[1], L[2], L[3], H[0], H[1], H[2], H[3]}
  od = __builtin_amdgcn_mfma_f32_32x32x16_bf16(pa0, PK(l0, h0), od, 0, 0, 0);
  od = __builtin_amdgcn_mfma_f32_32x32x16_bf16(pa1, PK(l1, h1), od, 0, 0, 0);
  od = __builtin_amdgcn_mfma_f32_32x32x16_bf16(pa2, PK(l2, h2), od, 0, 0, 0);
  od = __builtin_amdgcn_mfma_f32_32x32x16_bf16(pa3, PK(l3, h3), od, 0, 0, 0);
#undef PK
}
DI void pv_d0(f32x16* o, int vb, bf16x8 pa0, bf16x8 pa1, bf16x8 pa2, bf16x8 pa3) {
  pv_one<0>(o[0], vb, pa0, pa1, pa2, pa3); pv_one<1>(o[1], vb, pa0, pa1, pa2, pa3); pv_one<2>(o[2], vb, pa0, pa1, pa2, pa3); pv_one<3>(o[3], vb, pa0, pa1, pa2, pa3);
}
DI bf16x8 ld8(const bf16_t* p) { return *reinterpret_cast<const bf16x8*>(p); }

template <class TS>
DI void attn_unit(const bf16_t* __restrict__ Qb, int ldq, const TS& ts, int NT, float sink, bf16_t* __restrict__ Ob, int ldo, char* lds) {
  int tid_ = threadIdx.x; asm volatile("" : "+v"(tid_));
  const int tid = tid_, wid = tid >> 6, lane = tid & 63, r32 = lane & 31, hi = lane >> 5;
  char* V_lds = lds; char* K_lds = lds + 2 * SHM_V;
  float* ws = (float*)(lds + 2 * SHM_V + 2 * SHM_K) + wid * 64; float* li_l = ws; float* al_l = ws + 32;
  float m_reg = sink * (1.0f / SCALE), l_reg = 1.0f; f32x16 o[4]; bf16x8 qr[8];
#pragma unroll
  for (int d = 0; d < 4; ++d)
#pragma unroll
    for (int r = 0; r < 16; ++r) o[d][r] = 0.f;
  const bf16_t* Qw = Qb + (long)(wid * QBLK + r32) * ldq + hi * 8;
#pragma unroll
  for (int d0 = 0; d0 < 8; ++d0) qr[d0] = ld8(Qw + d0 * 16);
  const int sr = tid >> 4, sc = (tid & 15) * 8, vst0 = v_st(sr, sc), vst1 = v_st(32 + sr, sc);
  const int vb0 = (int)(uintptr_t)V_lds + v_rd_base(lane);
  const int dlane = -(wid * QBLK + r32);
  struct { bf16x8 vs0, vs1, ks0, ks1; } sr_[2];
#define SLOAD(i, J) do { const Tile T_ = ts(J); sr_[i].vs0 = ld8(T_.v + (long)sr * T_.ldv + sc); sr_[i].vs1 = ld8(T_.v + (long)(32 + sr) * T_.ldv + sc); \
    sr_[i].ks0 = ld8(T_.k + (long)sr * T_.ldk + sc); sr_[i].ks1 = ld8(T_.k + (long)(32 + sr) * T_.ldk + sc); } while (0)
#define SWRITE(b, i) do { *(bf16x8*)(V_lds + (b) * SHM_V + vst0) = sr_[i].vs0;          \
    *(bf16x8*)(V_lds + (b) * SHM_V + vst1) = sr_[i].vs1; int kc = sc * 2;               \
    *(bf16x8*)(K_lds + (b) * SHM_K + KSWZ(sr, kc)) = sr_[i].ks0;                       \
    *(bf16x8*)(K_lds + (b) * SHM_K + KSWZ(32 + sr, kc)) = sr_[i].ks1; } while (0)
#define SWAIT() asm volatile("s_waitcnt vmcnt(4)" ::: "memory")
#define RESC(a) do { if (__any((a) < 1.f)) { if (hi == 0) al_l[r32] = (a); asm volatile("s_waitcnt lgkmcnt(0)" ::: "memory"); \
    _Pragma("unroll") for (int d = 0; d < 4; ++d) _Pragma("unroll") for (int r = 0; r < 16; ++r) o[d][r] *= al_l[crow(r, hi)]; } } while (0)
#define MASK(P0, P1, J) do { const Tile T_ = ts(J); if (T_.masked) amask(P0, P1, T_.dpos + dlane, hi); } while (0)
  f32x16 pA0, pA1, pB0, pB1; float mnA, mnB, alA, alB; bf16x8 pa0, pa1, pa2, pa3;
  constexpr int SE = 0, SO = 1;
  SLOAD(SE, 0); asm volatile("s_waitcnt vmcnt(0)" ::: "memory"); SWRITE(0, SE); __syncthreads();
  qkt(pA0, pA1, K_lds, qr, r32, hi); MASK(pA0, pA1, 0); partialSM(pA0, pA1, m_reg, mnA, alA);
  SLOAD(SO, 1); if (2 < NT) SLOAD(SE, 2);
  SWAIT(); SWRITE(1, SO); __syncthreads();
  for (int j = 1; j + 1 < NT; j += 2) {
    SBAR(); qkt(pB0, pB1, K_lds + SHM_K, qr, r32, hi); MASK(pB0, pB1, j);
    finishSM(pA0, pA1, alA, l_reg, pa0, pa1, pa2, pa3); SBAR();
    SLOAD(SO, j + 2); SBAR();
    pv_d0(o, vb0, pa0, pa1, pa2, pa3); partialSM(pB0, pB1, m_reg, mnB, alB);
    __syncthreads(); SWAIT(); SWRITE(0, SE);
    RESC(alB); __syncthreads();
    SBAR(); qkt(pA0, pA1, K_lds, qr, r32, hi); MASK(pA0, pA1, j + 1);
    finishSM(pB0, pB1, alB, l_reg, pa0, pa1, pa2, pa3); SBAR();
    if (j + 3 < NT) SLOAD(SE, j + 3); SBAR();
    pv_d0(o, vb0 + (int)SHM_V, pa0, pa1, pa2, pa3); partialSM(pA0, pA1, m_reg, mnA, alA);
    __syncthreads(); SWAIT(); SWRITE(1, SO);
    RESC(alA); __syncthreads();
  }
  SBAR(); qkt(pB0, pB1, K_lds + SHM_K, qr, r32, hi); MASK(pB0, pB1, NT - 1);
  finishSM(pA0, pA1, alA, l_reg, pa0, pa1, pa2, pa3); SBAR();
  pv_d0(o, vb0, pa0, pa1, pa2, pa3); partialSM(pB0, pB1, m_reg, mnB, alB);
  __syncthreads(); RESC(alB);
  finishSM(pB0, pB1, alB, l_reg, pa0, pa1, pa2, pa3); SBAR();
  pv_d0(o, vb0 + (int)SHM_V, pa0, pa1, pa2, pa3);
  if (hi == 0) li_l[r32] = l_reg; asm volatile("s_waitcnt lgkmcnt(0)" ::: "memory");
  float rli[16];
#pragma unroll
  for (int r = 0; r < 16; ++r) rli[r] = __builtin_amdgcn_rcpf(li_l[crow(r, hi)]);
  bf16_t* Ow = Ob + (long)(wid * QBLK) * ldo;
#pragma unroll
  for (int r = 0; r < 16; ++r) { int orow = crow(r, hi);
#pragma unroll
    for (int d0 = 0; d0 < 4; ++d0) Ow[(long)orow * ldo + (long)(d0 >> 1) * ((long)MT * 64) + (d0 & 1) * 32 + r32] = f2bf(o[d0][r] * rli[r]); }
  __syncthreads();
#undef SLOAD
#undef SWRITE
#undef SWAIT
#undef RESC
#undef MASK
}
}

struct Frame {
    unsigned char* ws; float* out; const float* const* in;
    int G, bid;
};
#define MFMA32(a, b, c) __builtin_amdgcn_mfma_f32_32x32x16_bf16((a), (b), (c), 0, 0, 0)
DI bf16x8 pack_step(const f32x16& x, int s) {
    u32x4 p; p.x = pk2(x[8 * s + 0], x[8 * s + 1]); p.y = pk2(x[8 * s + 2], x[8 * s + 3]); p.z = pk2(x[8 * s + 4], x[8 * s + 5]); p.w = pk2(x[8 * s + 6], x[8 * s + 7]);
    return __builtin_bit_cast(bf16x8, p);
}
DI bf16x8 cat4(s16x4 lo, s16x4 hi) { return (bf16x8){lo[0], lo[1], lo[2], lo[3], hi[0], hi[1], hi[2], hi[3]}; }

constexpr int GL_QS = 0, GL_KS = 17408, GL_KT = 34816, GL_VT = 53248, GL_AS = 90112, GL_DS = 99328, GL_PART = 99840;
DI void gla_chain(const Frame& F, LAS unsigned char* lds, int item, int layer) {
    unsigned char* const ws_ = F.ws;
    int tid_ = threadIdx.x; asm volatile("" : "+v"(tid_));
    const int tid = tid_, lane = tid & 63, w = __builtin_amdgcn_readfirstlane(tid >> 6), r = lane & 31, hh = lane >> 5;
    const int dir = item & 1, h = (item >> 1) & 3, sq = item >> 3;
    const bool lat = sq < 2; const int b = lat ? sq : sq - 2;
    const int L = lat ? 1024 : 256, row0 = lat ? M_CTX + b * 1024 : b * 256, NC = L / 64;
    const bf16_t* Y = (const bf16_t*)(ws_ + WS_BIG); const bf16_t* LA = (const bf16_t*)(ws_ + WS_LA);
    bf16_t* OD = (bf16_t*)(ws_ + WS_ODG) + (size_t)dir * MT * 1024;
    LAS bf16_t* Qs = (LAS bf16_t*)(lds + GL_QS); LAS bf16_t* Ks = (LAS bf16_t*)(lds + GL_KS); LAS bf16_t* KT = (LAS bf16_t*)(lds + GL_KT);
    LAS bf16_t* VT = (LAS bf16_t*)(lds + GL_VT); LAS bf16_t* As = (LAS bf16_t*)(lds + GL_AS); LAS float* dS = (LAS float*)(lds + GL_DS); LAS float* partS = (LAS float*)(lds + GL_PART);
    f32x16 S[4];
    if (lat) { const float* st = F.in[5] + ((((size_t)b * 2 + layer) * 2 + dir) * 4 + h) * 128 * 256;
#pragma unroll
        for (int kt = 0; kt < 4; ++kt)
#pragma unroll
            for (int i = 0; i < 16; ++i) S[kt][i] = st[(size_t)(32 * kt + crow(i, hh)) * 256 + 32 * w + r];
    } else {
#pragma unroll
        for (int kt = 0; kt < 4; ++kt)
#pragma unroll
            for (int i = 0; i < 16; ++i) S[kt][i] = 0.f;
    }
    const int kp = tid & 63, sg = tid >> 6, vcc = tid >> 4, vsb = tid & 15;
#define WG_BAR() do { asm volatile("s_waitcnt lgkmcnt(0)" ::: "memory"); __builtin_amdgcn_s_barrier(); asm volatile("" ::: "memory"); } while (0)
#define GLA_LOAD(PROW, LAr, QVr, KVr, VVr) do { \
        _Pragma("unroll") for (int i = 0; i < 8; ++i) LAr[i] = *(const unsigned*)(LA + ((size_t)(dir * 4 + h) * MT + (PROW) + 8 * sg + i) * 128 + 2 * kp); \
        _Pragma("unroll") for (int i = 0; i < 4; ++i) VVr[i] = *(const bf16x8*)(Y + yaddr((PROW) + 4 * vsb + i, YC_GV + h * 256 + 8 * vcc)); \
        _Pragma("unroll") for (int i = 0; i < 8; ++i) { const size_t ro = yaddr((PROW) + 8 * sg + i, h * 128 + 2 * kp); QVr[i] = *(const unsigned*)(Y + ro + yaddr(0, YC_GQ)); KVr[i] = *(const unsigned*)(Y + ro + yaddr(0, YC_GK)); } } while (0)
    unsigned la[8], qv[8], kv[8]; bf16x8 vv[4];
    GLA_LOAD(row0 + 64 * (dir ? NC - 1 : 0), la, qv, kv, vv);
    for (int c = 0; c < NC; ++c) {
        const int pb = dir ? NC - 1 - c : c, prow = row0 + 64 * pb;
        { f32x2 part = {0.f, 0.f};
#pragma unroll
          for (int i = 0; i < 8; ++i) part += (f32x2){bflo(la[i]), bfhi(la[i])};
          *(LAS f32x2*)(partS + sg * 128 + 2 * kp) = part; }
        WG_BAR();
        f32x2 run = {0.f, 0.f}, total = {0.f, 0.f};
#pragma unroll
        for (int j = 0; j < 8; ++j) { const f32x2 p = *(const LAS f32x2*)(partS + j * 128 + 2 * kp); total += p; if (dir == 0 ? (j < sg) : (j > sg)) run += p; }
        const float eta = __expf(total[0]), etb = __expf(total[1]);
        float kha[8], khb[8];
#pragma unroll
        for (int ii = 0; ii < 8; ++ii) { const int i = dir == 0 ? ii : 7 - ii; run += (f32x2){bflo(la[i]), bfhi(la[i])}; const int t = 8 * sg + i;
            const float xa = run[0] * 1.4426950408889634f, xb = run[1] * 1.4426950408889634f;
            const float ka = bflo(kv[i]) * __builtin_amdgcn_exp2f(-xa), kb = bfhi(kv[i]) * __builtin_amdgcn_exp2f(-xb);
            *(LAS unsigned*)(Qs + t * 136 + 2 * kp) = pk2(bflo(qv[i]) * 0.088388347648318440f * __builtin_amdgcn_exp2f(xa), bfhi(qv[i]) * 0.088388347648318440f * __builtin_amdgcn_exp2f(xb));
            *(LAS unsigned*)(Ks + t * 136 + 2 * kp) = pk2(ka, kb); kha[i] = ka * eta; khb[i] = kb * etb; }
        { u32x4 w0, w1; w0.x = pk2(kha[0], kha[1]); w0.y = pk2(kha[2], kha[3]); w0.z = pk2(kha[4], kha[5]); w0.w = pk2(kha[6], kha[7]);
          w1.x = pk2(khb[0], khb[1]); w1.y = pk2(khb[2], khb[3]); w1.z = pk2(khb[4], khb[5]); w1.w = pk2(khb[6], khb[7]);
          *(LAS u32x4*)(KT + (2 * kp) * 72 + 8 * sg) = w0; *(LAS u32x4*)(KT + (2 * kp + 1) * 72 + 8 * sg) = w1; }
        if (sg == 0) *(LAS f32x2*)(dS + 2 * kp) = (f32x2){eta, etb};
#pragma unroll
        for (int e = 0; e < 8; ++e) { s16x4 q4 = {vv[0][e], vv[1][e], vv[2][e], vv[3][e]}; *(LAS s16x4*)(VT + (8 * vcc + e) * 72 + 4 * vsb) = q4; }
        WG_BAR();
        if (c + 1 < NC) GLA_LOAD(row0 + 64 * (dir ? NC - 2 - c : c + 1), la, qv, kv, vv);
        if (w < 4) {
            const int ti = w >> 1, si = w & 1;
            const bool need = dir == 0 ? (si <= ti) : (si >= ti);
            f32x16 a;
#pragma unroll
            for (int i = 0; i < 16; ++i) a[i] = 0.f;
            if (need) {
#pragma unroll
                for (int kk = 0; kk < 8; ++kk) { const bf16x8 fa = *(const LAS bf16x8*)(Qs + (32 * ti + r) * 136 + 16 * kk + 8 * hh), fb = *(const LAS bf16x8*)(Ks + (32 * si + r) * 136 + 16 * kk + 8 * hh);
                    a = MFMA32(fa, fb, a); }
            }
            const int s = 32 * si + r;
#pragma unroll
            for (int i = 0; i < 16; ++i) { const int t = 32 * ti + crow(i, hh); const bool ok = dir == 0 ? (s <= t) : (s >= t); As[t * 72 + s] = f2bf(ok ? a[i] : 0.f); }
        }
        WG_BAR();
        bf16x8 bv[4];
#pragma unroll
        for (int kk = 0; kk < 4; ++kk) bv[kk] = *(const LAS bf16x8*)(VT + (32 * w + r) * 72 + 16 * kk + 8 * hh);
#pragma unroll
        for (int ti = 0; ti < 2; ++ti) {
            f32x16 o;
#pragma unroll
            for (int i = 0; i < 16; ++i) o[i] = 0.f;
#pragma unroll
            for (int kk = 0; kk < 4; ++kk) { const bf16x8 fa = *(const LAS bf16x8*)(As + (32 * ti + r) * 72 + 16 * kk + 8 * hh); o = MFMA32(fa, bv[kk], o); }
#pragma unroll
            for (int kt = 0; kt < 4; ++kt)
#pragma unroll
                for (int s2 = 0; s2 < 2; ++s2) { const bf16x8 fb = pack_step(S[kt], s2);
                    const LAS bf16_t* qp = Qs + (32 * ti + r) * 136 + 32 * kt + 16 * s2 + 4 * hh;
                    const bf16x8 fa = cat4(*(const LAS s16x4*)qp, *(const LAS s16x4*)(qp + 8)); o = MFMA32(fa, fb, o); }
#pragma unroll
            for (int i = 0; i < 16; ++i) (OD + ((size_t)h * MT + prow + 32 * ti + (i & 3) + 8 * (i >> 2)) * YLD + 32 * w)[(unsigned)(4 * hh * YLD + r)] = f2bf(o[i]);
        }
#pragma unroll
        for (int kt = 0; kt < 4; ++kt) {
#pragma unroll
            for (int g = 0; g < 4; ++g) { const f32x4 dv = *(const LAS f32x4*)(dS + 32 * kt + 8 * g + 4 * hh);
                S[kt][4 * g + 0] *= dv[0]; S[kt][4 * g + 1] *= dv[1]; S[kt][4 * g + 2] *= dv[2]; S[kt][4 * g + 3] *= dv[3]; }
#pragma unroll
            for (int kk = 0; kk < 4; ++kk) { const bf16x8 fa = *(const LAS bf16x8*)(KT + (32 * kt + r) * 72 + 16 * kk + 8 * hh); S[kt] = MFMA32(fa, bv[kk], S[kt]); }
        }
    }
    if (!lat) { float* so = F.out + OUT_GLA + ((((size_t)b * 2 + layer) * 2 + dir) * 4 + h) * 128 * 256;
#pragma unroll
        for (int kt = 0; kt < 4; ++kt)
#pragma unroll
            for (int i = 0; i < 16; ++i) so[(size_t)(32 * kt + crow(i, hh)) * 256 + 32 * w + r] = S[kt][i];
    }
    WG_BAR();
#undef GLA_LOAD
}

constexpr int SD_BS = 0, SD_CS = 17408, SD_BT = 34816, SD_XT = 53248, SD_GS = 90112, SD_CUM = 107520, SD_DT = 108544, SD_F = 109568, SD_E = 110592, SD_TOT = 111616;
DI void ssd_chain(const Frame& F, LAS unsigned char* lds, int item, int layer, int hp) {
    unsigned char* const ws_ = F.ws;
    int tid_ = threadIdx.x; asm volatile("" : "+v"(tid_));
    const int tid = tid_, lane = tid & 63, w = __builtin_amdgcn_readfirstlane(tid >> 6), r = lane & 31, hh = lane >> 5;
    const int dir = item & 1, g = (item >> 1) & 3, sq = item >> 3;
    const bool lat = sq < 2; const int b = lat ? sq : sq - 2;
    const int L = lat ? 1024 : 256, row0 = lat ? M_CTX + b * 1024 : b * 256, NC = L / 64;
    const int hg = hp < 0 ? (w >> 1) : (2 * hp + (w >> 2)), ph = hp < 0 ? (w & 1) : ((w >> 1) & 1), head = g * 4 + hg;
    const int ti0 = hp < 0 ? 0 : (w & 1), ti1 = hp < 0 ? 2 : ti0 + 1;
    const bf16_t* XBC = (const bf16_t*)(ws_ + WS_XBC); const float* DT = (const float*)(ws_ + WS_DT); const float* DTA = (const float*)(ws_ + WS_DTA);
    bf16_t* YD = (bf16_t*)(ws_ + WS_ODS) + (size_t)dir * MT * 1024;
    LAS bf16_t* Bs = (LAS bf16_t*)(lds + SD_BS); LAS bf16_t* Cs = (LAS bf16_t*)(lds + SD_CS); LAS bf16_t* BT = (LAS bf16_t*)(lds + SD_BT); LAS bf16_t* XT = (LAS bf16_t*)(lds + SD_XT);
    LAS float* Gs = (LAS float*)(lds + SD_GS); LAS float* cumS = (LAS float*)(lds + SD_CUM); LAS float* dtS = (LAS float*)(lds + SD_DT); LAS float* fS = (LAS float*)(lds + SD_F);
    LAS float* eS = (LAS float*)(lds + SD_E); LAS float* totS = (LAS float*)(lds + SD_TOT);
    f32x16 ST[4];
    if (lat) { const float* st = F.in[6] + ((((size_t)b * 2 + layer) * 2 + dir) * 16 + head) * 64 * 128 + (size_t)(32 * ph + r) * 128;
#pragma unroll
        for (int nt = 0; nt < 4; ++nt)
#pragma unroll
            for (int q = 0; q < 4; ++q) { const f32x4 v = *(const f32x4*)(st + 32 * nt + 8 * q + 4 * hh); ST[nt][4 * q] = v[0]; ST[nt][4 * q + 1] = v[1]; ST[nt][4 * q + 2] = v[2]; ST[nt][4 * q + 3] = v[3]; }
    } else {
#pragma unroll
        for (int nt = 0; nt < 4; ++nt)
#pragma unroll
            for (int i = 0; i < 16; ++i) ST[nt][i] = 0.f;
    }
    const int ssb = tid & 15, sch = (tid >> 4) & 15, xch = tid >> 4; const bool isC = tid >= 256;
#define SSD_LOAD(PROW, BCr, XVr, DTr, DAr) do { \
        _Pragma("unroll") for (int i = 0; i < 4; ++i) BCr[i] = *(const bf16x8*)(XBC + yaddr((PROW) + 4 * ssb + i, (isC ? 1536 : 1024) + g * 128 + 8 * sch)); \
        _Pragma("unroll") for (int i = 0; i < 4; ++i) XVr[i] = *(const bf16x8*)(XBC + yaddr((PROW) + 4 * ssb + i, g * 256 + 8 * xch)); \
        if (w < 4) { const size_t di = (size_t)((PROW) + lane) * 32 + dir * 16 + g * 4 + w; DTr = DT[di]; DAr = DTA[di]; } } while (0)
    bf16x8 bc[4], xv[4]; float dtv = 0.f, dta = 0.f;
    SSD_LOAD(row0 + 64 * (dir ? NC - 1 : 0), bc, xv, dtv, dta);
    for (int c = 0; c < NC; ++c) {
        const int pb = dir ? NC - 1 - c : c, prow = row0 + 64 * pb;
        { LAS bf16_t* dstR = isC ? Cs : Bs;
#pragma unroll
          for (int i = 0; i < 4; ++i) *(LAS bf16x8*)(dstR + (4 * ssb + i) * 136 + 8 * sch) = bc[i];
          if (!isC) {
#pragma unroll
              for (int e = 0; e < 8; ++e) { s16x4 q4 = {bc[0][e], bc[1][e], bc[2][e], bc[3][e]}; *(LAS s16x4*)(BT + (8 * sch + e) * 72 + 4 * ssb) = q4; } }
#pragma unroll
          for (int e = 0; e < 8; ++e) { s16x4 q4 = {xv[0][e], xv[1][e], xv[2][e], xv[3][e]}; *(LAS s16x4*)(XT + (8 * xch + e) * 72 + 4 * ssb) = q4; }
        }
        if (w < 4) {
            float cs = dta;
#pragma unroll
            for (int o = 1; o < 64; o <<= 1) { const float t = __shfl_up(cs, o); if (lane >= o) cs += t; }
            const float total = __shfl(cs, 63);
            const float cum = dir == 0 ? cs : total - cs + dta;
            cumS[w * 64 + lane] = cum; dtS[w * 64 + lane] = dtv; fS[w * 64 + lane] = dtv * __expf(total - cum); eS[w * 64 + lane] = __expf(cum);
            if (lane == 0) totS[w] = __expf(total);
        }
        WG_BAR();
        if (c + 1 < NC) SSD_LOAD(row0 + 64 * (dir ? NC - 2 - c : c + 1), bc, xv, dtv, dta);
        if (w < 4) {
            const int ti = w >> 1, si = w & 1;
            const bool need = dir == 0 ? (si <= ti) : (si >= ti);
            f32x16 a;
#pragma unroll
            for (int i = 0; i < 16; ++i) a[i] = 0.f;
            if (need) {
#pragma unroll
                for (int kk = 0; kk < 8; ++kk) { const bf16x8 fa = *(const LAS bf16x8*)(Cs + (32 * ti + r) * 136 + 16 * kk + 8 * hh), fb = *(const LAS bf16x8*)(Bs + (32 * si + r) * 136 + 16 * kk + 8 * hh);
                    a = MFMA32(fa, fb, a); }
            }
#pragma unroll
            for (int i = 0; i < 16; ++i) Gs[(32 * ti + crow(i, hh)) * 68 + 32 * si + r] = a[i];
        }
        WG_BAR();
        const LAS bf16_t* xrow = XT + (hg * 64 + 32 * ph + r) * 72 + 8 * hh;
#pragma unroll 1
        for (int ti = ti0; ti < ti1; ++ti) {
            f32x16 y;
#pragma unroll
            for (int i = 0; i < 16; ++i) y[i] = 0.f;
            const int t = 32 * ti + r; const float ct = cumS[hg * 64 + t];
#pragma unroll
            for (int nt = 0; nt < 4; ++nt)
#pragma unroll
                for (int s2 = 0; s2 < 2; ++s2) { const bf16x8 fb = pack_step(ST[nt], s2);
                    const LAS bf16_t* cp = Cs + t * 136 + 32 * nt + 16 * s2 + 4 * hh;
                    const bf16x8 fa = cat4(*(const LAS s16x4*)cp, *(const LAS s16x4*)(cp + 8)); y = MFMA32(fa, fb, y); }
#pragma unroll
            for (int q = 0; q < 4; ++q) { const f32x4 ev = *(const LAS f32x4*)(eS + hg * 64 + 32 * ti + 8 * q + 4 * hh);
                y[4 * q] *= ev[0]; y[4 * q + 1] *= ev[1]; y[4 * q + 2] *= ev[2]; y[4 * q + 3] *= ev[3]; }
#pragma unroll
            for (int kk = 0; kk < 4; ++kk) {
                const bool blk = dir == 0 ? (16 * kk <= 32 * ti + 31) : (16 * kk + 15 >= 32 * ti);
                if (blk) {
                    const int s0 = 16 * kk + 8 * hh;
                    const f32x4 g0 = *(const LAS f32x4*)(Gs + t * 68 + s0), g1 = *(const LAS f32x4*)(Gs + t * 68 + s0 + 4);
                    const f32x4 c0 = *(const LAS f32x4*)(cumS + hg * 64 + s0), c1 = *(const LAS f32x4*)(cumS + hg * 64 + s0 + 4);
                    const f32x4 d0 = *(const LAS f32x4*)(dtS + hg * 64 + s0), d1 = *(const LAS f32x4*)(dtS + hg * 64 + s0 + 4);
                    float wv[8];
#pragma unroll
                    for (int j = 0; j < 4; ++j) { const int s = s0 + j; const bool ok = dir == 0 ? (s <= t) : (s >= t);
                        wv[j] = ok ? g0[j] * __expf(fminf(ct - c0[j], 0.f)) * d0[j] : 0.f; }
#pragma unroll
                    for (int j = 0; j < 4; ++j) { const int s = s0 + 4 + j; const bool ok = dir == 0 ? (s <= t) : (s >= t);
                        wv[4 + j] = ok ? g1[j] * __expf(fminf(ct - c1[j], 0.f)) * d1[j] : 0.f; }
                    u32x4 p; p.x = pk2(wv[0], wv[1]); p.y = pk2(wv[2], wv[3]); p.z = pk2(wv[4], wv[5]); p.w = pk2(wv[6], wv[7]);
                    y = MFMA32(__builtin_bit_cast(bf16x8, p), *(const LAS bf16x8*)(xrow + 16 * kk), y);
                }
            }
#pragma unroll
            for (int i = 0; i < 16; ++i) (YD + ((size_t)(head >> 2) * MT + prow + 32 * ti + (i & 3) + 8 * (i >> 2)) * YLD + (head & 3) * 64 + 32 * ph)[(unsigned)(4 * hh * YLD + r)] = f2bf(y[i]);
        }
        const float dec = totS[hg];
#pragma unroll
        for (int nt = 0; nt < 4; ++nt)
#pragma unroll
            for (int i = 0; i < 16; ++i) ST[nt][i] *= dec;
#pragma unroll
        for (int kk = 0; kk < 4; ++kk) { const int s0 = 16 * kk + 8 * hh;
            const f32x4 f0 = *(const LAS f32x4*)(fS + hg * 64 + s0), f1 = *(const LAS f32x4*)(fS + hg * 64 + s0 + 4);
            const bf16x8 xk = *(const LAS bf16x8*)(xrow + 16 * kk);
            u32x4 p; p.x = pk2(bf2f_s(xk[0]) * f0[0], bf2f_s(xk[1]) * f0[1]); p.y = pk2(bf2f_s(xk[2]) * f0[2], bf2f_s(xk[3]) * f0[3]);
            p.z = pk2(bf2f_s(xk[4]) * f1[0], bf2f_s(xk[5]) * f1[1]); p.w = pk2(bf2f_s(xk[6]) * f1[2], bf2f_s(xk[7]) * f1[3]);
            const bf16x8 xh = __builtin_bit_cast(bf16x8, p);
#pragma unroll
            for (int nt = 0; nt < 4; ++nt) { const bf16x8 fa = *(const LAS bf16x8*)(BT + (32 * nt + r) * 72 + 16 * kk + 8 * hh); ST[nt] = MFMA32(fa, xh, ST[nt]); }
        }
        WG_BAR();
    }
    if (!lat) { float* so = F.out + OUT_SSM + ((((size_t)b * 2 + layer) * 2 + dir) * 16 + head) * 64 * 128 + (size_t)(32 * ph + r) * 128;
#pragma unroll
        for (int nt = 0; nt < 4; ++nt)
#pragma unroll
            for (int q = 0; q < 4; ++q) { f32x4 v = {ST[nt][4 * q], ST[nt][4 * q + 1], ST[nt][4 * q + 2], ST[nt][4 * q + 3]}; *(f32x4*)(so + 32 * nt + 8 * q + 4 * hh) = v; }
    }
}

DI void norm_phase(const Frame& F, const float* Xa, const float* Xb, const float* nw, const float* mod  , bf16_t* XN) {
    int tid_ = threadIdx.x; asm volatile("" : "+v"(tid_));
    const int lane = tid_ & 63, gw = F.bid * NWAVES + __builtin_amdgcn_readfirstlane(tid_ >> 6), NGW = F.G * NWAVES;
    f32x4 wf[8], sf[8]; int cur_mi = -1;
    for (int row = gw; row < MT; row += NGW) {
        const f32x4* xr = (const f32x4*)((row < M_CTX ? Xa : Xb) + (size_t)row * DM) + lane;
        f32x4 v[8]; float s = 0.f;
#pragma unroll
        for (int j = 0; j < 8; ++j) { v[j] = xr[64 * j]; s += (v[j][0] * v[j][0] + v[j][1] * v[j][1]) + (v[j][2] * v[j][2] + v[j][3] * v[j][3]); }
        const int mi = row < M_CTX ? 0 : 1 + ((row - M_CTX) >> 10);
        if (mi != cur_mi) { cur_mi = mi;
            const f32x4* sh = (const f32x4*)(mod + (size_t)mi * NMOD) + lane; const f32x4* sc = (const f32x4*)(mod + (size_t)mi * NMOD + DM) + lane; const f32x4* wv = (const f32x4*)nw + lane;
#pragma unroll
            for (int j = 0; j < 8; ++j) { wf[j] = wv[64 * j] * (sc[64 * j] + 1.0f); sf[j] = sh[64 * j]; } }
        const float rstd = 1.0f / sqrtf(wave_sum(s) * (1.0f / DM) + RMS_EPS);
#pragma unroll
        for (int j = 0; j < 8; ++j) { const f32x4 a = v[j] * rstd * wf[j] + sf[j]; u32x2 w; w.x = pk2(a[0], a[1]); w.y = pk2(a[2], a[3]); *(u32x2*)(XN + kb64(MT, row, 256 * j + 4 * lane)) = w; }
    }
}
DI void norm_phase_b(const Frame& F, const bf16_t* XB, const float* nw, const float* mod, bf16_t* XN) {
    int tid_ = threadIdx.x; asm volatile("" : "+v"(tid_));
    const int lane = tid_ & 63, gw = F.bid * NWAVES + __builtin_amdgcn_readfirstlane(tid_ >> 6), NGW = F.G * NWAVES;
    f32x4 wf[8], sf[8]; int cur_mi = -1;
    for (int row = gw; row < MT; row += NGW) {
        const bf16_t* xr = XB + ((size_t)(lane >> 5) * MT + row) * YLD + 8 * (lane & 31);
        u32x4 t[4];
#pragma unroll
        for (int j = 0; j < 4; ++j) t[j] = *(const u32x4*)(xr + (size_t)(2 * j) * MT * YLD);
        f32x4 v[8]; float s = 0.f;
#pragma unroll
        for (int j = 0; j < 4; ++j) { v[2 * j] = (f32x4){bflo(t[j].x), bfhi(t[j].x), bflo(t[j].y), bfhi(t[j].y)}; v[2 * j + 1] = (f32x4){bflo(t[j].z), bfhi(t[j].z), bflo(t[j].w), bfhi(t[j].w)}; }
#pragma unroll
        for (int j = 0; j < 8; ++j) s += (v[j][0] * v[j][0] + v[j][1] * v[j][1]) + (v[j][2] * v[j][2] + v[j][3] * v[j][3]);
        const int mi = row < M_CTX ? 0 : 1 + ((row - M_CTX) >> 10);
        if (mi != cur_mi) { cur_mi = mi;
            const f32x4* sh = (const f32x4*)(mod + (size_t)mi * NMOD) + 2 * lane; const f32x4* sc = (const f32x4*)(mod + (size_t)mi * NMOD + DM) + 2 * lane; const f32x4* wv = (const f32x4*)nw + 2 * lane;
#pragma unroll
            for (int j = 0; j < 8; ++j) { const int o = 128 * (j >> 1) + (j & 1); wf[j] = wv[o] * (sc[o] + 1.0f); sf[j] = sh[o]; } }
        const float rstd = 1.0f / sqrtf(wave_sum(s) * (1.0f / DM) + RMS_EPS);
#pragma unroll
        for (int j = 0; j < 4; ++j) { const f32x4 a = v[2 * j] * rstd * wf[2 * j] + sf[2 * j], b = v[2 * j + 1] * rstd * wf[2 * j + 1] + sf[2 * j + 1];
            u32x4 w; w.x = pk2(a[0], a[1]); w.y = pk2(a[2], a[3]); w.z = pk2(b[0], b[1]); w.w = pk2(b[2], b[3]); *(u32x4*)(XN + kb64(MT, row, 512 * j + 8 * lane)) = w; }
    }
}
DI void final_norm_phase(const Frame& F, const bf16_t* XB, float* Xo, const float* nw) {
    int tid_ = threadIdx.x; asm volatile("" : "+v"(tid_));
    const int lane = tid_ & 63, gw = F.bid * NWAVES + __builtin_amdgcn_readfirstlane(tid_ >> 6), NGW = F.G * NWAVES;
    for (int row = gw; row < MT; row += NGW) {
        const bf16_t* xr = XB + ((size_t)(lane >> 5) * MT + row) * YLD + 8 * (lane & 31);
        u32x4 t[4];
#pragma unroll
        for (int j = 0; j < 4; ++j) t[j] = *(const u32x4*)(xr + (size_t)(2 * j) * MT * YLD);
        f32x4 v[8]; float s = 0.f;
#pragma unroll
        for (int j = 0; j < 4; ++j) { v[2 * j] = (f32x4){bflo(t[j].x), bfhi(t[j].x), bflo(t[j].y), bfhi(t[j].y)}; v[2 * j + 1] = (f32x4){bflo(t[j].z), bfhi(t[j].z), bflo(t[j].w), bfhi(t[j].w)}; }
#pragma unroll
        for (int j = 0; j < 8; ++j) s += (v[j][0] * v[j][0] + v[j][1] * v[j][1]) + (v[j][2] * v[j][2] + v[j][3] * v[j][3]);
        const float rstd = 1.0f / sqrtf(wave_sum(s) * (1.0f / DM) + RMS_EPS);
        const f32x4* wv = (const f32x4*)nw + 2 * lane; f32x4* yo = (f32x4*)(Xo + (size_t)row * DM) + 2 * lane;
#pragma unroll
        for (int j = 0; j < 8; ++j) { const int o = 128 * (j >> 1) + (j & 1); yo[o] = v[j] * rstd * wv[o]; }
    }
}
DI void seq_of_row(int row, int& t, int& L) { if (row < M_CTX) { t = row & 255; L = 256; } else { t = (row - M_CTX) & 1023; L = 1024; } }
DI void prep_phase(const Frame& F, int layer) {
    unsigned char* const ws_ = F.ws;
    const bf16_t* Y = (const bf16_t*)(ws_ + WS_BIG); const float* YS = (const float*)(ws_ + WS_YS);
    bf16_t* XBC = (bf16_t*)(ws_ + WS_XBC); float* DT = (float*)(ws_ + WS_DT); float* DTA = (float*)(ws_ + WS_DTA); bf16_t* LA = (bf16_t*)(ws_ + WS_LA); bf16_t* KR = (bf16_t*)(ws_ + WS_KR);
    int tid_ = threadIdx.x; asm volatile("" : "+v"(tid_));
    const int gt = F.bid * 512 + tid_, NT = F.G * 512;
    const float* cw = F.in[19] + (size_t)layer * 5 * 2048; const float* cb = F.in[20] + (size_t)layer * 2048;
    for (int it = gt; it < (MT / 8) * 256; it += NT) {
        const int r0 = (it >> 8) * 8, ch = (it & 255) * 8; int t0, L; seq_of_row(r0, t0, L);
        u32x4 xr[12];
#pragma unroll
        for (int j = 0; j < 12; ++j) { const int tt = t0 + j - 2; xr[j] = (u32x4){0u, 0u, 0u, 0u}; if (tt >= 0 && tt < L) xr[j] = *(const u32x4*)(Y + yaddr(r0 + j - 2, YC_XBC + ch)); }
        f32x4 w0[5], w1[5];
#pragma unroll
        for (int j = 0; j < 5; ++j) { w0[j] = *(const f32x4*)(cw + j * 2048 + ch); w1[j] = *(const f32x4*)(cw + j * 2048 + ch + 4); }
        const f32x4 b0 = *(const f32x4*)(cb + ch), b1 = *(const f32x4*)(cb + ch + 4);
#pragma unroll
        for (int i = 0; i < 8; ++i) {
            f32x4 a0 = b0, a1 = b1;
#pragma unroll
            for (int j = 0; j < 5; ++j) { const u32x4 xv = xr[i + j];
                a0 = a0 + w0[j] * (f32x4){bflo(xv.x), bfhi(xv.x), bflo(xv.y), bfhi(xv.y)}; a1 = a1 + w1[j] * (f32x4){bflo(xv.z), bfhi(xv.z), bflo(xv.w), bfhi(xv.w)}; }
            u32x4 o; o.x = pk2(fast_silu(a0[0]), fast_silu(a0[1])); o.y = pk2(fast_silu(a0[2]), fast_silu(a0[3])); o.z = pk2(fast_silu(a1[0]), fast_silu(a1[1])); o.w = pk2(fast_silu(a1[2]), fast_silu(a1[3]));
            *(u32x4*)(XBC + yaddr(r0 + i, ch)) = o;
        }
    }
    const float* dtb = F.in[21] + layer * 32; const float* alog = F.in[22] + layer * 32;
    for (int it = gt; it < MT * 32; it += NT) { const int i = it & 31; const float d = softplusf(YS[(size_t)(it >> 5) * 64 + 32 + i] + dtb[i]); DT[it] = d; DTA[it] = -__expf(alog[i]) * d; }
    const float* wup = F.in[16] + (size_t)layer * 2 * 16 * 512; const float* bup = F.in[17] + (size_t)layer * 2 * 512;
    for (int it = gt; it < (MT / 8) * 256; it += NT) {
        const int r0 = (it >> 8) * 8, dir = (it >> 7) & 1, j4 = (it & 127) * 4;
        f32x4 wu[16];
#pragma unroll
        for (int rr = 0; rr < 16; ++rr) wu[rr] = *(const f32x4*)(wup + (size_t)(dir * 16 + rr) * 512 + j4);
        const f32x4 bz = *(const f32x4*)(bup + dir * 512 + j4);
#pragma unroll
        for (int i = 0; i < 8; ++i) {
            const float* gd = YS + (size_t)(r0 + i) * 64 + dir * 16;
            const f32x4 g0 = *(const f32x4*)gd, g1 = *(const f32x4*)(gd + 4), g2 = *(const f32x4*)(gd + 8), g3 = *(const f32x4*)(gd + 12);
            f32x4 z = bz;
            z = z + g0[0] * wu[0] + g0[1] * wu[1] + g0[2] * wu[2] + g0[3] * wu[3]; z = z + g1[0] * wu[4] + g1[1] * wu[5] + g1[2] * wu[6] + g1[3] * wu[7];
            z = z + g2[0] * wu[8] + g2[1] * wu[9] + g2[2] * wu[10] + g2[3] * wu[11]; z = z + g3[0] * wu[12] + g3[1] * wu[13] + g3[2] * wu[14] + g3[3] * wu[15];
            u32x2 ow; ow.x = pk2(-softplusf(-z[0]) * (1.0f / 16.0f), -softplusf(-z[1]) * (1.0f / 16.0f)); ow.y = pk2(-softplusf(-z[2]) * (1.0f / 16.0f), -softplusf(-z[3]) * (1.0f / 16.0f));
            *(u32x2*)(LA + ((size_t)(dir * 4 + (j4 >> 7)) * MT + r0 + i) * 128 + (j4 & 127)) = ow;
        }
    }
    bf16_t* QR = (bf16_t*)(ws_ + WS_QR);
    for (int it = gt; it < M_LAT * 80; it += NT) {
        const int tl = it / 80, rem = it - tl * 80, hd = rem >> 3, half = (rem >> 2) & 1, i0 = (rem & 3) * 8;
        const int t = tl & 1023; const float pos = (float)(half ? (t & 63) : (t >> 6));
        const size_t src = yaddr(M_CTX + tl, (hd < 2 ? YC_AK + hd * 128 : YC_AQ + (hd - 2) * 128) + half * 64 + i0);
        const u32x4 xa = *(const u32x4*)(Y + src), xb = *(const u32x4*)(Y + src + 32);
        const unsigned a4[4] = {xa.x, xa.y, xa.z, xa.w}, b4[4] = {xb.x, xb.y, xb.z, xb.w}; unsigned oa[4], ob[4];
#pragma unroll
        for (int q = 0; q < 4; ++q) { float y1[2], y2[2];
#pragma unroll
            for (int e = 0; e < 2; ++e) { const int i = i0 + 2 * q + e; const float ang = pos * __builtin_amdgcn_exp2f(-(float)i * 0.41524101186092029f), cs = __cosf(ang), sn = __sinf(ang);
                const float x1 = e ? bfhi(a4[q]) : bflo(a4[q]), x2 = e ? bfhi(b4[q]) : bflo(b4[q]); y1[e] = x1 * cs - x2 * sn; y2[e] = x2 * cs + x1 * sn; }
            oa[q] = pk2(y1[0], y1[1]); ob[q] = pk2(y2[0], y2[1]); }
        bf16_t* dst = (hd < 2 ? KR + (size_t)tl * 256 + hd * 128 : QR + (size_t)tl * 1024 + (hd - 2) * 128) + half * 64 + i0;
        *(u32x4*)dst = (u32x4){oa[0], oa[1], oa[2], oa[3]}; *(u32x4*)(dst + 32) = (u32x4){ob[0], ob[1], ob[2], ob[3]};
    }
    for (int it = gt; it < M_CTX * 64; it += NT) { const int row = it >> 6, c8 = (it & 63) * 8, b = row >> 8, t = row & 255;
        const u32x4 xv = *(const u32x4*)(Y + yaddr(row, YC_AK + c8));
        float* o = F.out + (c8 < 256 ? OUT_CK : OUT_CV) + ((size_t)(b * 2 + layer) * 256 + t) * 256 + (c8 & 255);
        *(f32x4*)o = (f32x4){bflo(xv.x), bfhi(xv.x), bflo(xv.y), bfhi(xv.y)}; *(f32x4*)(o + 4) = (f32x4){bflo(xv.z), bfhi(xv.z), bflo(xv.w), bfhi(xv.w)}; }
}
DI void combine_phase(const Frame& F, int layer) {
    unsigned char* const ws_ = F.ws;
    const bf16_t* Y = (const bf16_t*)(ws_ + WS_BIG); const bf16_t* XBC = (const bf16_t*)(ws_ + WS_XBC);
    const bf16_t* OG = (const bf16_t*)(ws_ + WS_ODG); const bf16_t* OS = (const bf16_t*)(ws_ + WS_ODS); bf16_t* OC = (bf16_t*)(ws_ + WS_OCAT);
    const float* gnw = F.in[18] + layer * 256; const float* snw = F.in[24] + layer * 1024; const float* dsk = F.in[23] + layer * 16;
    int tid_ = threadIdx.x; asm volatile("" : "+v"(tid_));
    const int lane = tid_ & 63, gw = F.bid * NWAVES + __builtin_amdgcn_readfirstlane(tid_ >> 6), NGW = F.G * NWAVES, c0 = lane * 16;
    for (int row = gw; row < MT; row += NGW) {
        float o[16]; float ss = 0.f;
        { const u32x4 a0 = *(const u32x4*)(OG + yaddr(row, c0)), a1 = *(const u32x4*)(OG + yaddr(row, c0 + 8)), b0 = *(const u32x4*)(OG + (size_t)MT * 1024 + yaddr(row, c0)), b1 = *(const u32x4*)(OG + (size_t)MT * 1024 + yaddr(row, c0 + 8));
          const unsigned aa[8] = {a0.x, a0.y, a0.z, a0.w, a1.x, a1.y, a1.z, a1.w}, bb[8] = {b0.x, b0.y, b0.z, b0.w, b1.x, b1.y, b1.z, b1.w};
#pragma unroll
          for (int q = 0; q < 8; ++q) { o[2 * q] = bflo(aa[q]) + bflo(bb[q]); o[2 * q + 1] = bfhi(aa[q]) + bfhi(bb[q]); ss += o[2 * q] * o[2 * q] + o[2 * q + 1] * o[2 * q + 1]; } }
        ss += __shfl_xor(ss, 1); ss += __shfl_xor(ss, 2); ss += __shfl_xor(ss, 4); ss += __shfl_xor(ss, 8);
        float rstd = 1.0f / sqrtf(ss * (1.0f / 256.0f) + RMS_EPS);
        { const u32x4 g0 = *(const u32x4*)(Y + yaddr(row, YC_GR + c0)), g1 = *(const u32x4*)(Y + yaddr(row, YC_GR + c0 + 8));
          const unsigned gg[8] = {g0.x, g0.y, g0.z, g0.w, g1.x, g1.y, g1.z, g1.w}; unsigned ow[8];
          const f32x4* gw4 = (const f32x4*)(gnw + (c0 & 255)); const f32x4 n0 = gw4[0], n1 = gw4[1], n2 = gw4[2], n3 = gw4[3]; const float gn[16] = {n0[0], n0[1], n0[2], n0[3], n1[0], n1[1], n1[2], n1[3], n2[0], n2[1], n2[2], n2[3], n3[0], n3[1], n3[2], n3[3]};
#pragma unroll
          for (int q = 0; q < 8; ++q) ow[q] = pk2(o[2 * q] * rstd * gn[2 * q] * fast_silu(bflo(gg[q])), o[2 * q + 1] * rstd * gn[2 * q + 1] * fast_silu(bfhi(gg[q])));
          *(u32x4*)(OC + kb64(MT, row, c0)) = (u32x4){ow[0], ow[1], ow[2], ow[3]}; *(u32x4*)(OC + kb64(MT, row, c0 + 8)) = (u32x4){ow[4], ow[5], ow[6], ow[7]}; }
        ss = 0.f; const float dk = dsk[lane >> 2];
        { const u32x4 x0 = *(const u32x4*)(XBC + yaddr(row, c0)), x1 = *(const u32x4*)(XBC + yaddr(row, c0 + 8));
          const u32x4 z0 = *(const u32x4*)(Y + yaddr(row, YC_SZ + c0)), z1 = *(const u32x4*)(Y + yaddr(row, YC_SZ + c0 + 8));
          const unsigned xx[8] = {x0.x, x0.y, x0.z, x0.w, x1.x, x1.y, x1.z, x1.w}, zz[8] = {z0.x, z0.y, z0.z, z0.w, z1.x, z1.y, z1.z, z1.w};
          const u32x4 a0 = *(const u32x4*)(OS + yaddr(row, c0)), a1 = *(const u32x4*)(OS + yaddr(row, c0 + 8)), b0 = *(const u32x4*)(OS + (size_t)MT * 1024 + yaddr(row, c0)), b1 = *(const u32x4*)(OS + (size_t)MT * 1024 + yaddr(row, c0 + 8));
          const unsigned aa[8] = {a0.x, a0.y, a0.z, a0.w, a1.x, a1.y, a1.z, a1.w}, bb[8] = {b0.x, b0.y, b0.z, b0.w, b1.x, b1.y, b1.z, b1.w};
#pragma unroll
          for (int e = 0; e < 16; ++e) { const unsigned xw = xx[e >> 1], zw = zz[e >> 1], aw = aa[e >> 1], bw = bb[e >> 1];
              const float xf = (e & 1) ? bfhi(xw) : bflo(xw), zf = (e & 1) ? bfhi(zw) : bflo(zw), af = (e & 1) ? bfhi(aw) : bflo(aw), bf = (e & 1) ? bfhi(bw) : bflo(bw);
              const float y = (af + bf + dk * xf) * fast_silu(zf); o[e] = y; ss += y * y; } }
        rstd = 1.0f / sqrtf(wave_sum(ss) * (1.0f / 1024.0f) + RMS_EPS);
        { unsigned ow[8];
          const f32x4* sw4 = (const f32x4*)(snw + c0); const f32x4 n0 = sw4[0], n1 = sw4[1], n2 = sw4[2], n3 = sw4[3]; const float sn[16] = {n0[0], n0[1], n0[2], n0[3], n1[0], n1[1], n1[2], n1[3], n2[0], n2[1], n2[2], n2[3], n3[0], n3[1], n3[2], n3[3]};
#pragma unroll
          for (int q = 0; q < 8; ++q) ow[q] = pk2(o[2 * q] * rstd * sn[2 * q], o[2 * q + 1] * rstd * sn[2 * q + 1]);
          *(u32x4*)(OC + kb64(MT, row, 1024 + c0)) = (u32x4){ow[0], ow[1], ow[2], ow[3]}; *(u32x4*)(OC + kb64(MT, row, 1024 + c0 + 8)) = (u32x4){ow[4], ow[5], ow[6], ow[7]}; }
    }
}

DI void msum_phase(const Frame& F) {
    unsigned char* const ws_ = F.ws;
    int tid_ = threadIdx.x; asm volatile("" : "+v"(tid_));
    const bf16_t* PB = (const bf16_t*)(ws_ + WS_ODG); bf16_t* Mb = (bf16_t*)(ws_ + WS_XBC);
    const int gt = F.bid * 512 + tid_, NT = F.G * 512;
    for (int it0 = gt; it0 < MT * DM / 8; it0 += 4 * NT) {
        u32x4 a[4], b[4], c[4];
#pragma unroll
        for (int q = 0; q < 4; ++q) { const int it = it0 + q * NT; if (it < MT * DM / 8) { a[q] = *(const u32x4*)(PB + (size_t)it * 8); b[q] = *(const u32x4*)(PB + (size_t)MT * DM + (size_t)it * 8); c[q] = *(const u32x4*)(PB + (size_t)2 * MT * DM + (size_t)it * 8); } }
#pragma unroll
        for (int q = 0; q < 4; ++q) { const int it = it0 + q * NT; if (it < MT * DM / 8) {
            u32x4 o;
            o.x = pk2(bflo(a[q].x) + bflo(b[q].x) + bflo(c[q].x), bfhi(a[q].x) + bfhi(b[q].x) + bfhi(c[q].x)); o.y = pk2(bflo(a[q].y) + bflo(b[q].y) + bflo(c[q].y), bfhi(a[q].y) + bfhi(b[q].y) + bfhi(c[q].y));
            o.z = pk2(bflo(a[q].z) + bflo(b[q].z) + bflo(c[q].z), bfhi(a[q].z) + bfhi(b[q].z) + bfhi(c[q].z)); o.w = pk2(bflo(a[q].w) + bflo(b[q].w) + bflo(c[q].w), bfhi(a[q].w) + bfhi(b[q].w) + bfhi(c[q].w));
            *(u32x4*)(Mb + kb64(MT, (it >> 5) % MT, (it / (32 * MT)) * 256 + (it & 31) * 8)) = o; } }
    }
}

DI void transpose_item(const float* W, int K, int N, bf16_t* WT, int NR, int k0, int n0, int dst0, LAS float* scr, int lane) {
#pragma unroll 8
    for (int i = 0; i < 32; ++i) { const int kk = 2 * i + (lane >> 5); scr[kk * 33 + (lane & 31)] = W[(size_t)(k0 + kk) * N + n0 + (lane & 31)]; }
    LDS_WAIT(); asm volatile("" ::: "memory");
    const int c = lane & 7;
#pragma unroll
    for (int j = 0; j < 4; ++j) { const int n = (lane >> 3) + 8 * j; const LAS float* s = scr + (8 * c) * 33 + n;
        u32x4 o; o.x = pk2(s[0 * 33], s[1 * 33]); o.y = pk2(s[2 * 33], s[3 * 33]); o.z = pk2(s[4 * 33], s[5 * 33]); o.w = pk2(s[6 * 33], s[7 * 33]);
        *(u32x4*)(WT + ((size_t)(k0 >> 6) * NR + dst0 + n) * 64 + 8 * c) = o; }
    LDS_WAIT(); asm volatile("" ::: "memory");
}
DI int win_dst(int n) { return n < 3072 ? n : (n < 3104 ? YC_GD + (n - 3072) : (n < 6176 ? n - 32 : (n < 6208 ? YC_DT + (n - 6176) : n - 64))); }
DI void prologue_phase(const Frame& F, LAS unsigned char* lds) {
    unsigned char* const ws_ = F.ws;
    int tid_ = threadIdx.x; asm volatile("" : "+v"(tid_));
    const int tid = tid_, lane = tid & 63, wave = __builtin_amdgcn_readfirstlane(tid >> 6);
    {
        LAS float* sv = (LAS float*)lds;
        LAS float* red = (LAS float*)(lds + 24576);
        for (int i = tid; i < 3 * 2048; i += 512) { const int mi = i >> 11, k = i & 2047; const float x = mi == 0 ? F.in[7][k] : F.in[2][(mi - 1) * 2048 + k]; sv[i] = x / (1.0f + __expf(-x)); }
        __syncthreads();
        float* MOD = (float*)(ws_ + WS_MOD);
        const int tx = tid & 15, ty = tid >> 4;
        for (int it = F.bid; it < 2 * 288; it += F.G) {
            const int l = it / 288, cb = it % 288;
            const float* wp = F.in[8] + ((size_t)l * 2048 + 64 * ty) * NMOD + 64 * cb + 4 * tx;
            f32x4 a0 = {0.f, 0.f, 0.f, 0.f}, a1 = a0, a2 = a0;
#pragma unroll 8
            for (int k = 0; k < 64; ++k) { const f32x4 wv = *(const f32x4*)(wp + (size_t)k * NMOD); const int kk = 64 * ty + k;
                a0 = a0 + sv[kk] * wv; a1 = a1 + sv[2048 + kk] * wv; a2 = a2 + sv[4096 + kk] * wv; }
            *(LAS f32x4*)(red + (ty * 3 + 0) * 64 + 4 * tx) = a0; *(LAS f32x4*)(red + (ty * 3 + 1) * 64 + 4 * tx) = a1; *(LAS f32x4*)(red + (ty * 3 + 2) * 64 + 4 * tx) = a2;
            __syncthreads();
            if (tid < 192) { const int mi = tid >> 6, col = tid & 63; float s = 0.f;
#pragma unroll 8
                for (int y = 0; y < 32; ++y) s += red[(y * 3 + mi) * 64 + col];
                MOD[((size_t)l * 3 + mi) * NMOD + 64 * cb + col] = s + F.in[9][(size_t)l * NMOD + 64 * cb + col]; }
            __syncthreads();
        }
    }
    {
        LAS float* scr = (LAS float*)(lds + wave * 8448);
        const int gw = F.bid * NWAVES + wave, NGW = F.G * NWAVES;
        constexpr int PER_L = 52800;
        for (int it = gw; it < 2 * PER_L; it += NGW) {
            const int l = it / PER_L; int r = it - l * PER_L;
            if (r < 33792) { const int mi = r / 5632, rr = r - mi * 5632;
                if (mi < 4) { const int f = mi >> 1, up = mi & 1; const float* W = F.in[f ? (up ? 32 : 31) : (up ? 12 : 11)] + (size_t)l * DM * FF;
                    const int kb = rr / 176, nb = rr - kb * 176, n0 = 32 * nb;
                    transpose_item(W, DM, FF, (bf16_t*)(ws_ + WS_WGU + (size_t)(l * 2 + f) * SZ_WGU), NGU, 64 * kb, n0, 256 * (n0 >> 7) + 128 * up + (n0 & 127), scr, lane); }
                else { const int f = mi - 4; const float* W = F.in[f ? 33 : 13] + (size_t)l * FF * DM; const int kb = rr >> 6, nb = rr & 63;
                    transpose_item(W, FF, DM, (bf16_t*)(ws_ + WS_WD + (size_t)(l * 2 + f) * SZ_WD), DM, 64 * kb, 32 * nb, 32 * nb, scr, lane); }
                continue; }
            r -= 33792;
            if (r < 13888) { const int kb = r / 434, nb = r - kb * 434; transpose_item(F.in[15] + (size_t)l * DM * D_IN, DM, D_IN, (bf16_t*)(ws_ + WS_WIN + (size_t)l * SZ_WIN), NY, 64 * kb, 32 * nb, win_dst(32 * nb), scr, lane); continue; }
            r -= 13888;
            if (r < 3072) { const int i = r >> 10, rr = r & 1023, kb = rr >> 6, nb = rr & 63;
                transpose_item(F.in[26 + i] + (size_t)l * 1024 * DM, 1024, DM, (bf16_t*)(ws_ + WS_WBR + (size_t)(l * 3 + i) * SZ_WBR), DM, 64 * kb, 32 * nb, 32 * nb, scr, lane); continue; }
            r -= 3072;
            { const int kb = r >> 6, nb = r & 63; transpose_item(F.in[29] + (size_t)l * DM * DM, DM, DM, (bf16_t*)(ws_ + WS_WOUT + (size_t)l * SZ_WOUT), DM, 64 * kb, 32 * nb, 32 * nb, scr, lane); }
        }
    }
    const int gt = F.bid * 512 + tid, NTT = F.G * 512;
    for (int it = gt; it < 2 * 192 * 256; it += NTT) { const int l = it / (192 * 256), r = it - l * (192 * 256);
        *(u32x4*)(ws_ + WS_WIN + (size_t)l * SZ_WIN + kb64(NY, D_IN + (r >> 8), (r & 255) * 8) * 2) = (u32x4){0u, 0u, 0u, 0u}; }
    for (int it = gt; it < 2 * 65536; it += NTT) { const int which = it >> 16, r = it & 65535, l = r >> 15, b = (r >> 14) & 1, e = (r & 16383) * 8;
        const float* src = F.in[3 + which] + ((size_t)(b * 2 + l) * 512 * 256) + e;
        const f32x4 v0 = *(const f32x4*)src, v1 = *(const f32x4*)(src + 4);
        u32x4 o; o.x = pk2(v0[0], v0[1]); o.y = pk2(v0[2], v0[3]); o.z = pk2(v1[0], v1[1]); o.w = pk2(v1[2], v1[3]);
        *(u32x4*)(ws_ + (which ? WS_CVB : WS_CKB) + ((size_t)(l * 2 + b) * 512 * 256 + e) * 2) = o; }
}

struct UTiles { const bf16_t* k1; const bf16_t* v1; int ld1, n1; const bf16_t* k2; const bf16_t* v2; int dpos2;
    DI att::Tile operator()(int j) const { att::Tile t;
        if (j < n1) { t.k = k1 + (size_t)j * 64 * ld1; t.v = v1 + (size_t)j * 64 * ld1; t.ldk = ld1; t.ldv = ld1; t.dpos = 0; t.masked = 0; }
        else { const int s = 64 * (j - n1); t.k = k2 + (size_t)s * 256; t.v = v2 + (size_t)s * YLD; t.ldk = 256; t.ldv = YLD; t.dpos = dpos2 + s; t.masked = 1; }
        return t; } };
DI int q_next(unsigned* ctr, volatile LAS int* slot) {
    __syncthreads();
    if (threadIdx.x == 0) *slot = (int)__hip_atomic_fetch_add(ctr, 1u, RLX_AGENT);
    __syncthreads();
    return *slot;
}
DI void mixer_phase(const Frame& F, unsigned char* lds_g, int layer_q) {
    unsigned char* const ws_ = F.ws;
    const int layer = layer_q & 1;
    LAS unsigned char* lds = (LAS unsigned char*)lds_g;
    volatile LAS int* slot = (volatile LAS int*)(lds + MISC_OFF + 64);
    unsigned* qc = (unsigned*)(ws_ + WS_CTL) + CW_Q + layer_q * 3 * 64;
    const bf16_t* Y = (const bf16_t*)(ws_ + WS_BIG); bf16_t* OC = (bf16_t*)(ws_ + WS_OCAT);
    const float* sinkp = F.in[25] + layer * 8;
    for (;;) {
        const int qi = q_next(qc, slot); if (qi >= 880) break;
        if (qi < 16 || (qi >= 112 && qi < 368)) gla_chain(F, lds, qi < 16 ? qi : qi - 112 + 16, layer);
        else if (qi < 48) ssd_chain(F, lds, (qi - 16) >> 1, layer, (qi - 16) & 1);
        else if (qi >= 368 && qi < 624) ssd_chain(F, lds, qi - 368 + 16, layer, -1);
        else {
            const int it = qi < 112 ? qi - 48 : qi - 624 + 64;
            UTiles ts; int row0, hq, NT, ldq; const bf16_t* Qp;
            if (it < 64) { const int b = it >> 5, qb = it & 3; hq = (it >> 2) & 7; const int kvh = hq >> 2;
                row0 = M_CTX + b * 1024 + qb * 256; const int s0 = qb == 0 ? 0 : 256 * qb - 128, s1 = qb == 3 ? 1024 : 256 * qb + 384;
                ts.k1 = (const bf16_t*)(ws_ + WS_CKB) + (size_t)(layer * 2 + b) * 512 * 256 + kvh * 128; ts.v1 = (const bf16_t*)(ws_ + WS_CVB) + (size_t)(layer * 2 + b) * 512 * 256 + kvh * 128; ts.ld1 = 256; ts.n1 = 8;
                ts.k2 = (const bf16_t*)(ws_ + WS_KR) + (size_t)(b * 1024 + s0) * 256 + kvh * 128; ts.v2 = Y + yaddr(M_CTX + b * 1024 + s0, YC_AV + kvh * 128); ts.dpos2 = s0 - qb * 256;
                NT = 8 + (s1 - s0) / 64; Qp = (const bf16_t*)(ws_ + WS_QR) + (size_t)(b * 1024 + qb * 256) * 1024 + hq * 128; ldq = 1024;
            } else { const int u = it - 64, b = u >> 3; hq = u & 7; const int kvh = hq >> 2; row0 = b * 256;
                ts.k1 = Y + yaddr(row0, YC_AK + kvh * 128); ts.v1 = Y + yaddr(row0, YC_AV + kvh * 128); ts.ld1 = YLD; ts.n1 = 4; ts.k2 = ts.k1; ts.v2 = ts.v1; ts.dpos2 = 0;
                NT = 4; Qp = Y + yaddr(row0, YC_AQ + hq * 128); ldq = YLD; }
            att::attn_unit(Qp, ldq, ts, NT, sinkp[hq], OC + kb64(MT, row0, 2048 + hq * 128), 64, (char*)lds_g);
        }
    }

}

#ifndef SITE_MASK
#define SITE_MASK 1023
#endif

constexpr int N_PH = 56;
struct Args { const float* in[35]; float* out; unsigned char* ws; int ph_lo, ph_hi; };
static_assert(sizeof(Args) == 37 * 8 + 8, "Args has no padding");
__global__ void __launch_bounds__(NWAVES * 64, 2) trunk_fwd(Args args) {
    extern __shared__ __attribute__((aligned(16))) unsigned char lds[];
    LAS unsigned char* L = (LAS unsigned char*)lds;
    Frame F; F.ws = args.ws; F.out = args.out; F.in = args.in;
    F.G = gridDim.x; F.bid = blockIdx.x;
    const int lo = args.ph_lo, hi = args.ph_hi;
    for (int u = threadIdx.x; u < (LDS_BYTES - RING_BYTES) / 4; u += NWAVES * 64) ((LAS unsigned*)(L + RING_BYTES))[u] = 0u;
    __syncthreads();
    XcdBarrier bar; bar.bar = (unsigned*)(F.ws + WS_CTL) + CW_BAR; bar.x = 0; bar.st = nullptr;
    if (hi - lo > 1) bar = xcd_barrier_post((unsigned*)(F.ws + WS_CTL) + CW_BAR, (volatile LAS unsigned*)(L + MISC_OFF) + 8);
#define RUN(p) (lo <= (p) && (p) < hi)
#define SEAM(p) do { if ((p) + 1 < hi) xcd_barrier(bar); } while (0)
    bf16_t* X = (bf16_t*)(F.ws + WS_XB);
    float* MOD = (float*)(F.ws + WS_MOD);
    bf16_t* XN = (bf16_t*)(F.ws + WS_XN); bf16_t* Y = (bf16_t*)(F.ws + WS_BIG); bf16_t* H = (bf16_t*)(F.ws + WS_BIG);
    bf16_t* Mb = (bf16_t*)(F.ws + WS_XBC); bf16_t* OC = (bf16_t*)(F.ws + WS_OCAT);

    #if SITE_MASK & 1
    if (RUN(0)) { for (int rep = 0; rep < NREP(1); ++rep) { prologue_phase(F, L); SEAM(0); } }
#endif
    for (int step = 0; step < 6; ++step) {
        const int l = step / 3, sb = step - 3 * l, pid = 1 + 9 * step;
        const bool ffn = sb != 1; const int f = sb >> 1;
        const float* modl = MOD + (size_t)l * 3 * NMOD + (size_t)sb * 3 * DM;
#if SITE_MASK & 2
        if (RUN(pid + 0)) { const float* nw = F.in[sb == 0 ? 10 : (sb == 1 ? 14 : 30)] + (size_t)l * DM; for (int rep = 0; rep < NREP(2); ++rep) { if (step == 0) norm_phase(F, F.in[0], F.in[1] - (size_t)M_CTX * DM, nw, modl, XN); else norm_phase_b(F, X, nw, modl, XN); SEAM(pid + 0); } }
#endif
        if (ffn) {
#if SITE_MASK & 4
            if (RUN(pid + 1)) {
                pg8::Prob P; P.A = (const char*)XN; P.Bt = (const char*)(F.ws + WS_WGU + (size_t)(l * 2 + f) * SZ_WGU); P.lda = 64; P.ldb = 64; P.kstepA = (size_t)MT * 128; P.kstepB = (size_t)NGU * 128; P.nM = MT / 256; P.nN = NGU / 256; P.ntk = DM / 64; P.nseg = 1; P.a_seg = 0; P.b_seg = 0; P.G = F.G; { const int b_ = opaque_s(F.bid); P.c = XCD_CONTIG ? ((b_ & 31) * 8 + (b_ >> 5)) : b_; }
                EpiSwiGLU E{H}; for (int rep = 0; rep < NREP(4); ++rep) { pg8::gemm_phase(L, P, E); SEAM(pid + 1); } }
#endif
        } else {
#if SITE_MASK & 8
            if (RUN(pid + 2)) {
                pg8::Prob P; P.A = (const char*)XN; P.Bt = (const char*)(F.ws + WS_WIN + (size_t)l * SZ_WIN); P.lda = 64; P.ldb = 64; P.kstepA = (size_t)MT * 128; P.kstepB = (size_t)NY * 128; P.nM = MT / 256; P.nN = NY / 256; P.ntk = DM / 64; P.nseg = 1; P.a_seg = 0; P.b_seg = 0; P.G = F.G; { const int b_ = opaque_s(F.bid); P.c = XCD_CONTIG ? ((b_ & 31) * 8 + (b_ >> 5)) : b_; }
                EpiY E{Y, (float*)(F.ws + WS_YS)}; for (int rep = 0; rep < NREP(8); ++rep) { pg8::gemm_phase(L, P, E); SEAM(pid + 2); } }
#endif
#if SITE_MASK & 16
            if (RUN(pid + 3)) { for (int rep = 0; rep < NREP(16); ++rep) { prep_phase(F, l); SEAM(pid + 3); } }
#endif
#if SITE_MASK & 32
            if (RUN(pid + 4)) { for (int rep = 0; rep < NREP(32); ++rep) { mixer_phase(F, lds, l + 2 * rep); SEAM(pid + 4); } }
#endif
#if SITE_MASK & 64
            if (RUN(pid + 5)) { for (int rep = 0; rep < NREP(64); ++rep) { combine_phase(F, l); SEAM(pid + 5); } }
#endif
#if SITE_MASK & 128
            if (RUN(pid + 6)) {
                pg8::Prob P; P.A = (const char*)OC; P.Bt = (const char*)(F.ws + WS_WBR + (size_t)l * 3 * SZ_WBR); P.lda = 64; P.ldb = 64; P.kstepA = (size_t)MT * 128; P.kstepB = (size_t)DM * 128; P.nM = MT / 256; P.nN = DM / 256; P.ntk = 1024 / 64; P.nseg = 3; P.a_seg = (size_t)16 * MT * 128; P.b_seg = SZ_WBR; P.G = F.G; { const int b_ = opaque_s(F.bid); P.c = XCD_CONTIG ? ((b_ & 31) * 8 + (b_ >> 5)) : b_; }
                EpiBranch E{Y, (bf16_t*)(F.ws + WS_ODG)}; for (int rep = 0; rep < NREP(128); ++rep) { pg8::gemm_phase(L, P, E); SEAM(pid + 6); } }
            if (RUN(pid + 7)) { msum_phase(F); SEAM(pid + 7); }
#endif
        }
#if SITE_MASK & 256
        if (RUN(pid + 8)) {
            pg8::ProbSK P; P.G = F.G; { const int b_ = opaque_s(F.bid); P.vc = (F.G & 7) ? b_ : (b_ & 7) * (F.G >> 3) + (b_ >> 3); }
            if (ffn) { P.A = (const char*)H; P.Bt = (const char*)(F.ws + WS_WD + (size_t)(l * 2 + f) * SZ_WD); P.q4 = FF / 64 / 4; }
            else { P.A = (const char*)Mb; P.Bt = (const char*)(F.ws + WS_WOUT + (size_t)l * SZ_WOUT); P.q4 = DM / 64 / 4; }
            P.lda = 64; P.ldb = 64; P.kstepA = (size_t)MT * 128; P.kstepB = (size_t)DM * 128;
            P.slab = (const float*)(F.ws + WS_SLAB);
            for (int rep = 0; rep < NREP(256); ++rep) {
                P.flags = (unsigned*)(F.ws + WS_CTL) + CW_SK + (step + 6 * rep) * 256 * 64;
                if (step == 0 && rep == 0) { EpiSK<EpiResid<true>> E{EpiResid<true>{X, modl + 2 * DM, 0.5f, F.in[0], F.in[1] - (size_t)M_CTX * DM}, (float*)(F.ws + WS_SLAB), P.flags}; pg8::gemm_phase(L, P, E); }
                else { EpiSK<EpiResid<false>> E{EpiResid<false>{X, modl + 2 * DM, rep ? 0.0f : (ffn ? 0.5f : 1.0f), nullptr, nullptr}, (float*)(F.ws + WS_SLAB), P.flags}; pg8::gemm_phase(L, P, E); }
                SEAM(pid + 8); } }
#endif
    }
#if SITE_MASK & 512
    if (RUN(55)) final_norm_phase(F, X, F.out, F.in[34]);
#endif
#undef RUN
#undef SEAM
}

#ifndef MK_PER_PHASE
#define MK_PER_PHASE 0
#endif
extern "C" void kernel_launch(void* const* d_in, const int* in_sizes, int n_in, void* d_out, int out_size, void* d_ws, size_t ws_size, hipStream_t stream) {
    static int grid = 0;
    if (grid == 0) {
        if (n_in != 35 || out_size != (int)OUT_TOTAL || ws_size < WS_END) { fprintf(stderr, "kernel_launch: unexpected shapes: n_in %d out %d ws %zu (need %zu)\n", n_in, out_size, ws_size, (size_t)WS_END); grid = -1; return; }
        int dev = 0, cus = 0, per_cu = 0;
        if (hipGetDevice(&dev) != hipSuccess || hipDeviceGetAttribute(&cus, hipDeviceAttributeMultiprocessorCount, dev) != hipSuccess) { grid = -1; return; }
        if (hipFuncSetAttribute((const void*)trunk_fwd, hipFuncAttributeMaxDynamicSharedMemorySize, LDS_BYTES) != hipSuccess) { fprintf(stderr, "kernel_launch: hipFuncSetAttribute failed\n"); grid = -1; return; }
        if (hipOccupancyMaxActiveBlocksPerMultiprocessor(&per_cu, (const void*)trunk_fwd, NWAVES * 64, LDS_BYTES) != hipSuccess || per_cu < 1) { fprintf(stderr, "kernel_launch: occupancy query says %d blocks per CU\n", per_cu); }
        (void)hipGetLastError();
        grid = cus;
    }
    if (grid < 0) return;
    (void)hipMemsetAsync((char*)d_ws + WS_CTL, 0, CTL_ZERO_BYTES, stream);
    Args a{};
    for (int i = 0; i < 35; ++i) a.in[i] = (const float*)d_in[i];
    a.out = (float*)d_out; a.ws = (unsigned char*)d_ws;
#if MK_PER_PHASE
    for (int p = 0; p < N_PH; ++p) {
        if (p >= 1 && p <= 54) { const int step = (p - 1) / 9, site = (p - 1) % 9; const bool ffn = (step % 3) != 1;
            if (site == 1 && !ffn) continue; if (site >= 2 && site <= 7 && ffn) continue; }
        a.ph_lo = p; a.ph_hi = p + 1;
        hipLaunchKernelGGL(trunk_fwd, dim3(grid), dim3(NWAVES * 64), LDS_BYTES, stream, a);
    }
#else
    a.ph_lo = 0; a.ph_hi = N_PH;
    hipLaunchKernelGGL(trunk_fwd, dim3(grid), dim3(NWAVES * 64), LDS_BYTES, stream, a);
#endif
    const hipError_t le = hipPeekAtLastError();
    if (le != hipSuccess) fprintf(stderr, "kernel_launch: launch failed: %s\n", hipGetErrorName(le));
}
```

```cpp
#include <hip/hip_runtime.h>
#include <cstdio>
#include <cstdint>

#ifndef MIX_MASK
#define MIX_MASK 7
#endif
#ifndef PG8_ALIGN
#define PG8_ALIGN 1
#endif
#ifndef XCD_CONTIG
#define XCD_CONTIG 0
#endif
#ifdef PROBE_DUP_OVERRIDE
#define PROBE_DUP PROBE_DUP_OVERRIDE
#endif
#ifndef PROBE_DUP
#define PROBE_DUP 0
#endif
#define NREP(bit) ((PROBE_DUP & (bit)) ? 2 : 1)
#define GAS __attribute__((address_space(1)))
#define LAS __attribute__((address_space(3)))
#define DI __device__ __forceinline__
typedef unsigned short bf16_t;
typedef short bf16x8 __attribute__((ext_vector_type(8)));
typedef short s16x4 __attribute__((ext_vector_type(4)));
typedef float f32x4 __attribute__((ext_vector_type(4)));
typedef float f32x2 __attribute__((ext_vector_type(2)));
typedef float f32x8 __attribute__((ext_vector_type(8)));
typedef float f32x16 __attribute__((ext_vector_type(16)));
typedef unsigned u32x4 __attribute__((ext_vector_type(4)));
typedef unsigned u32x2 __attribute__((ext_vector_type(2)));
typedef __bf16 bf16x2_t __attribute__((ext_vector_type(2)));
typedef GAS unsigned gu32;

constexpr int DM = 2048, FF = 5632, NMOD = 9 * DM;
constexpr int M_CTX = 8192, M_LAT = 2048, MT = 10240;
constexpr int NGU = 2 * FF;
constexpr int D_IN = 13888, NY = 14080;
constexpr int YC_GQ = 0, YC_GK = 512, YC_GV = 1024, YC_GR = 2048, YC_SZ = 3072, YC_XBC = 4096, YC_AQ = 6144, YC_AK = 7168, YC_AV = 7424, YC_BR = 7680, YC_GD = 13824, YC_DT = 13856;
constexpr float RMS_EPS = 1e-6f;

constexpr size_t OUT_YP = 0, OUT_YS = 16777216, OUT_CK = 20971520, OUT_CV = 25165824, OUT_GLA = 29360128, OUT_SSM = 46137344, OUT_TOTAL = 62914560;

constexpr size_t MiB = 1u << 20;
constexpr size_t WS_CTL = 0, CTL_ZERO_BYTES = 2 * MiB;
constexpr size_t WS_MOD = 2 * MiB;
constexpr size_t WS_DT = 3 * MiB;
constexpr size_t WS_DTA = WS_DT + (size_t)MT * 32 * 4;
constexpr size_t WS_YS = 6 * MiB;
constexpr size_t WS_CKB = 9 * MiB;
constexpr size_t WS_CVB = 10 * MiB;
constexpr size_t WS_KR = 11 * MiB;
constexpr size_t WS_WGU = 12 * MiB;
constexpr size_t SZ_WGU = (size_t)NGU * DM * 2;
constexpr size_t WS_WD = WS_WGU + 4 * SZ_WGU;
constexpr size_t SZ_WD = (size_t)DM * FF * 2;
constexpr size_t WS_WIN = WS_WD + 4 * SZ_WD;
constexpr size_t SZ_WIN = (size_t)NY * DM * 2;
constexpr size_t WS_WBR = WS_WIN + 2 * SZ_WIN;
constexpr size_t SZ_WBR = (size_t)DM * 1024 * 2;
constexpr size_t WS_WOUT = WS_WBR + 6 * SZ_WBR;
constexpr size_t SZ_WOUT = (size_t)DM * DM * 2;
constexpr size_t WS_XN = WS_WOUT + 2 * SZ_WOUT;
constexpr size_t WS_BIG = WS_XN + (size_t)MT * DM * 2;
constexpr size_t WS_XBC = WS_BIG + (size_t)MT * NY * 2;
constexpr size_t WS_LA = WS_XBC + (size_t)MT * 2048 * 2;
constexpr size_t WS_ODG = WS_LA + (size_t)MT * 1024 * 4;
constexpr size_t WS_ODS = WS_ODG + (size_t)2 * MT * 1024 * 4;
constexpr size_t WS_XB = WS_ODS + (size_t)2 * MT * 1024 * 2;
constexpr size_t WS_OCAT = WS_ODS + (size_t)2 * MT * 1024 * 4;
constexpr size_t WS_QR = WS_OCAT + (size_t)MT * 3072 * 2;
constexpr size_t WS_SLAB = WS_QR + (size_t)M_LAT * 1024 * 2;
constexpr size_t WS_END = WS_SLAB + (size_t)256 * 65536 * 4;
static_assert(WS_WGU % 256 == 0 && WS_XN % 256 == 0 && WS_BIG % 256 == 0 && WS_OCAT % 256 == 0, "ws alignment");
constexpr int CW_BAR = 4096;
constexpr int CW_Q = 16384;
constexpr int CW_SK = 32768;

constexpr int RING_BYTES = 131072;
constexpr int MISC_OFF = RING_BYTES + 320;
constexpr int LDS_BYTES = 147456;
constexpr int NWAVES = 8;

DI unsigned pk2(float lo, float hi) { f32x2 v = {lo, hi}; bf16x2_t b = __builtin_convertvector(v, bf16x2_t); return __builtin_bit_cast(unsigned, b); }
DI float bflo(unsigned u) { return __uint_as_float(u << 16); }
DI float bfhi(unsigned u) { return __uint_as_float(u & 0xffff0000u); }
DI float bf2f(unsigned short s) { return __uint_as_float(((unsigned)s) << 16); }
DI float bf2f_s(short s) { return __uint_as_float(((unsigned)(unsigned short)s) << 16); }
DI unsigned short f2bf(float f) { return (unsigned short)(pk2(f, 0.f) & 0xffffu); }
DI float wave_sum(float v) {
#pragma unroll
    for (int o = 1; o < 64; o <<= 1) v += __shfl_xor(v, o);
    return v;
}
DI float fast_exp(float x) { return __builtin_amdgcn_exp2f(x * 1.4426950408889634f); }
DI float fast_sigmoid(float x) { return __builtin_amdgcn_rcpf(1.0f + fast_exp(-x)); }
DI float fast_silu(float x) { return x * fast_sigmoid(x); }
DI float softplusf(float x) { return fmaxf(x, 0.f) + __logf(1.0f + __expf(-fabsf(x))); }
DI size_t kb64(int rows, int row, int k) { return ((size_t)(k >> 6) * rows + row) * 64 + (k & 63); }
constexpr int YLD = 256;
DI size_t yaddr(int row, int col) { return ((size_t)(col >> 8) * MT + row) * YLD + (col & 255); }
DI int opaque_s(int x) { asm volatile("" : "+s"(x)); return x; }
DI int crow(int r, int hi) { return (r & 3) + 8 * (r >> 2) + 4 * hi; }
#define LDS_WAIT() asm volatile("s_waitcnt lgkmcnt(0)" ::: "memory")
#define VM_WAIT() asm volatile("s_waitcnt vmcnt(0)" ::: "memory")
#define RLX_AGENT __ATOMIC_RELAXED, __HIP_MEMORY_SCOPE_AGENT

namespace pg8 {
constexpr int BM = 256, BK = 64, HALF = 128, HTB = HALF * BK * 2, STAGE_BYTES = 8 * HTB, NXCD = 8, WGM = 8;
__host__ __device__ __forceinline__ int lds_byte(int r, int c) { const int st = (r >> 4) * 2 + (c >> 5), rr = r & 15, cc = c & 31, ob = rr * 64 + cc * 2; return st * 1024 + (ob ^ (((ob >> 9) & 1) << 5)); }
__host__ __device__ __forceinline__ void stage_rc(int b, int& R, int& C) { const int st = b / 1024, sb = b % 1024, swz = sb ^ (((sb >> 9) & 1) << 5); R = (st >> 1) * 16 + swz / 64; C = (st & 1) * 32 + (swz % 64) / 2; }
__host__ __device__ __forceinline__ int perm32(int rho) { const int n = rho >> 4, i = rho & 15; return 8 * (i >> 2) + 4 * n + (i & 3); }

struct Unit { int pm, pn, seg, k0, nt, role; };
struct Prob {
    const char* A; const char* Bt; int lda, ldb;
    size_t kstepA, kstepB;
    int nM, nN, ntk, nseg; size_t a_seg, b_seg;
    int G, c;
    DI bool next(int i, Unit& u) const {
        const int nwg = nM * nN; long L = (long)i * G + c; if (L >= (long)nwg * nseg) return false;
        u.seg = (int)(L / nwg); L -= (long)u.seg * nwg; u.k0 = 0; u.nt = ntk; u.role = 0;
        int wgid = (int)L; { const int q = nwg / NXCD, r = nwg % NXCD, xcd = wgid % NXCD, off = wgid / NXCD; wgid = (xcd < r ? xcd * (q + 1) : r * (q + 1) + (xcd - r) * q) + off; }
        const int nig = WGM * nN, gid = wgid / nig, fm = gid * WGM, gsz = (nM - fm) < WGM ? (nM - fm) : WGM;
        u.pm = fm + ((wgid % nig) % gsz); u.pn = (wgid % nig) / gsz; return true;
    }
    DI const char* aptr(const Unit& u) const { return A + (size_t)u.pm * BM * lda * 2 + (size_t)u.seg * a_seg; }
    DI const char* bptr(const Unit& u) const { return Bt + (size_t)u.pn * BM * ldb * 2 + (size_t)u.seg * b_seg; }
    DI void acc_init(const Unit&, f32x4 (&acc)[2][2][4][2], int) const {
#pragma unroll
        for (int a = 0; a < 2; ++a)
#pragma unroll
            for (int b = 0; b < 2; ++b)
#pragma unroll
                for (int m = 0; m < 4; ++m)
#pragma unroll
                    for (int n = 0; n < 2; ++n) acc[a][b][m][n] = (f32x4){0.f, 0.f, 0.f, 0.f};
    }
};
struct ProbSK {
    const char* A; const char* Bt; int lda, ldb, q4, vc, G;
    size_t kstepA, kstepB;
    DI bool next(int i, Unit& u) const {
        const int v = (i >> 1) * G + vc; if (v >= 256) return false;
        const int r = v & 3, gq = v >> 2; const bool quarter = (r < 3) == ((i & 1) == 0); int t;
        if (quarter) { t = 256 + gq; u.k0 = r * q4; u.nt = q4; u.role = r < 3 ? 1 : 2; }
        else { t = r == 3 ? gq : 64 + gq * 3 + r; u.k0 = 0; u.nt = 4 * q4; u.role = 0; }
        u.pm = t >> 3; u.pn = t & 7; u.seg = v; return true;
    }
    DI const char* aptr(const Unit& u) const { return A + (size_t)u.pm * BM * lda * 2 + (size_t)u.k0 * kstepA; }
    DI const char* bptr(const Unit& u) const { return Bt + (size_t)u.pn * BM * ldb * 2 + (size_t)u.k0 * kstepB; }
    const float* slab; unsigned* flags;
    DI void acc_init(const Unit& u, f32x4 (&acc)[2][2][4][2], int tid) const {
        if (u.role == 2) {
            if (tid < 64) {
                unsigned sp = 0;
                for (int j = 1; j <= 3; ++j)
                    while ((unsigned)__builtin_amdgcn_readfirstlane(__hip_atomic_load(flags + (u.seg - j) * 64, RLX_AGENT)) < 8u) { __builtin_amdgcn_s_sleep(2); if (++sp > (1u << 22)) break; }
                __builtin_amdgcn_fence(__ATOMIC_ACQUIRE, "agent");
                asm volatile("s_waitcnt vmcnt(0)" ::: "memory");
            }
            asm volatile("" ::: "memory"); __builtin_amdgcn_s_barrier(); asm volatile("" ::: "memory");
            const char* base = (const char*)(slab + (size_t)(u.seg - 3) * 65536); unsigned voff = (unsigned)tid * 16u; asm volatile("" : "+v"(voff));
#pragma unroll
            for (int a = 0; a < 2; ++a)
#pragma unroll
                for (int b = 0; b < 2; ++b)
#pragma unroll
                    for (int m = 0; m < 4; ++m) { const char* p = base + (size_t)(((a * 2 + b) * 4 + m) * 8192) + voff;
                        const u32x4 x = *(const u32x4*)p, y = *(const u32x4*)(p + 262144), z = *(const u32x4*)(p + 524288);
                        acc[a][b][m][0] = (f32x4){bflo(x.x) + bflo(y.x) + bflo(z.x), bfhi(x.x) + bfhi(y.x) + bfhi(z.x), bflo(x.y) + bflo(y.y) + bflo(z.y), bfhi(x.y) + bfhi(y.y) + bfhi(z.y)};
                        acc[a][b][m][1] = (f32x4){bflo(x.z) + bflo(y.z) + bflo(z.z), bfhi(x.z) + bfhi(y.z) + bfhi(z.z), bflo(x.w) + bflo(y.w) + bflo(z.w), bfhi(x.w) + bfhi(y.w) + bfhi(z.w)}; }
            asm volatile("s_waitcnt vmcnt(0)" ::: "memory");
        } else {
#pragma unroll
            for (int a = 0; a < 2; ++a)
#pragma unroll
                for (int b = 0; b < 2; ++b)
#pragma unroll
                    for (int m = 0; m < 4; ++m)
#pragma unroll
                        for (int n = 0; n < 2; ++n) acc[a][b][m][n] = (f32x4){0.f, 0.f, 0.f, 0.f};
        }
    }
};

template <class Epi, class PB>
DI void gemm_phase(LAS unsigned char* lds, const PB& S, const Epi& E) {
    int tid_ = threadIdx.x; asm volatile("" : "+v"(tid_));
    const int tid = tid_, wid = __builtin_amdgcn_readfirstlane(tid >> 6), lane = tid & 63, wr = wid >> 2, wc = wid & 3, fr = lane & 15, fq = lane >> 4;
    unsigned voffA[2], voffB[2];
#pragma unroll
    for (int i = 0; i < 2; ++i) { int R, C; stage_rc(tid * 16 + i * 8192, R, C); const int Rb = Epi::PERM ? ((R & ~31) + perm32(R & 31)) : R;
        voffA[i] = (unsigned)(R * S.lda + C) * 2u; voffB[i] = (unsigned)(Rb * S.ldb + C) * 2u; }
    const size_t kstepA = S.kstepA, kstepB = S.kstepB;
    const size_t hstepA = (size_t)HALF * S.lda * 2, hstepB = (size_t)HALF * S.ldb * 2;
    const unsigned ldsw = (unsigned)wid * 1024u;
    const int aoff = lds_byte(wr * 64 + fr, fq * 8), boff = lds_byte(wc * 32 + fr, fq * 8);
#define PG8_SA(b, h) (((b) * 2 + (h)) * HTB)
#define PG8_SB(b, h) ((4 + (b) * 2 + (h)) * HTB)
#define PG8_STAGE(bufoff, gbase, voff) do { _Pragma("unroll") for (int _i = 0; _i < 2; ++_i) \
        __builtin_amdgcn_global_load_lds((const unsigned*)((const char*)(gbase) + (voff)[_i]), (LAS unsigned*)(lds + (bufoff) + ldsw + _i * 8192), 16, 0, 0); } while (0)
#define PG8_LDA(dst, b, h) do { _Pragma("unroll") for (int m = 0; m < 4; ++m) _Pragma("unroll") for (int k = 0; k < 2; ++k) dst[m][k] = *(const LAS bf16x8*)(lds + PG8_SA(b, h) + aoff + m * 2048 + k * 1024); } while (0)
#define PG8_LDB(dst, b, h) do { _Pragma("unroll") for (int n = 0; n < 2; ++n) _Pragma("unroll") for (int k = 0; k < 2; ++k) dst[n][k] = *(const LAS bf16x8*)(lds + PG8_SB(b, h) + boff + n * 2048 + k * 1024); } while (0)
#define PG8_MMA(ai, bj, At, Bt) do { __builtin_amdgcn_s_setprio(1); _Pragma("unroll") for (int m = 0; m < 4; ++m) _Pragma("unroll") for (int n = 0; n < 2; ++n) _Pragma("unroll") for (int k = 0; k < 2; ++k) \
        acc[ai][bj][m][n] = __builtin_amdgcn_mfma_f32_16x16x32_bf16(Bt[n][k], At[m][k], acc[ai][bj][m][n], 0, 0, 0); __builtin_amdgcn_s_setprio(0); } while (0)
#define PG8_WAIT_V(n) asm volatile("s_waitcnt vmcnt(" #n ")" ::: "memory")
#define PG8_WAIT_L(n) asm volatile("s_waitcnt lgkmcnt(" #n ")" ::: "memory")
#define PG8_BAR __builtin_amdgcn_s_barrier()
#define PG8_SCHED __builtin_amdgcn_sched_barrier(0)
    Unit cur, nxt; int ui = 0;
    if (!S.next(0, cur)) return;
    f32x4 acc[2][2][4][2];
#pragma unroll
    for (int a = 0; a < 2; ++a)
#pragma unroll
        for (int b = 0; b < 2; ++b)
#pragma unroll
            for (int m = 0; m < 4; ++m)
#pragma unroll
                for (int n = 0; n < 2; ++n) acc[a][b][m][n] = (f32x4){0.f, 0.f, 0.f, 0.f};
    bf16x8 At[4][2], B0[2][2], B1[2][2];
    const char* cA = S.aptr(cur); const char* cB = S.bptr(cur);
    PG8_STAGE(PG8_SB(0, 0), cB, voffB); PG8_STAGE(PG8_SB(0, 1), cB + hstepB, voffB); PG8_STAGE(PG8_SA(0, 0), cA, voffA); PG8_STAGE(PG8_SA(0, 1), cA + hstepA, voffA);
    if (wr == 1) PG8_BAR;
    PG8_WAIT_V(2); PG8_BAR;
    PG8_STAGE(PG8_SB(1, 0), cB + kstepB, voffB); PG8_STAGE(PG8_SA(1, 0), cA + kstepA, voffA); PG8_STAGE(PG8_SB(1, 1), cB + hstepB + kstepB, voffB);
    PG8_WAIT_V(6); PG8_BAR;
    for (;;) {
        const bool has_next = S.next(ui + 1, nxt);
        const char* nA = has_next ? S.aptr(nxt) : cA; const char* nB = has_next ? S.bptr(nxt) : cB;
        const int nt = cur.nt;
        for (int t = 0; t < nt; t += 2) {
            const bool last = (t == nt - 2);
            const char* a1 = cA + (size_t)(t + 1) * kstepA;
            const char* a2 = last ? nA : cA + (size_t)(t + 2) * kstepA; const char* b2 = last ? nB : cB + (size_t)(t + 2) * kstepB;
            const char* a3 = a2 + kstepA; const char* b3 = b2 + kstepB;
            PG8_LDB(B0, 0, 0); PG8_LDB(B1, 0, 1); PG8_SCHED; PG8_LDA(At, 0, 0); PG8_STAGE(PG8_SA(1, 1), a1 + hstepA, voffA);
            PG8_WAIT_V(8); PG8_WAIT_L(0); PG8_BAR; PG8_MMA(0, 0, At, B0); PG8_MMA(0, 1, At, B1); PG8_BAR; PG8_SCHED;
            PG8_LDA(At, 0, 1); PG8_STAGE(PG8_SB(0, 0), b2, voffB); PG8_STAGE(PG8_SB(0, 1), b2 + hstepB, voffB); PG8_STAGE(PG8_SA(0, 0), a2, voffA);
            PG8_WAIT_V(8); PG8_WAIT_L(0); PG8_BAR; PG8_MMA(1, 0, At, B0); PG8_MMA(1, 1, At, B1); PG8_BAR; PG8_SCHED;
            PG8_LDB(B0, 1, 0); PG8_LDB(B1, 1, 1); PG8_SCHED; PG8_LDA(At, 1, 0); PG8_STAGE(PG8_SA(0, 1), a2 + hstepA, voffA);
            PG8_WAIT_V(8); PG8_WAIT_L(0); PG8_BAR; PG8_MMA(0, 0, At, B0); PG8_MMA(0, 1, At, B1); PG8_BAR; PG8_SCHED;
            PG8_LDA(At, 1, 1); PG8_STAGE(PG8_SB(1, 0), b3, voffB); PG8_STAGE(PG8_SB(1, 1), b3 + hstepB, voffB); PG8_STAGE(PG8_SA(1, 0), a3, voffA);
            PG8_WAIT_V(8); PG8_WAIT_L(0); PG8_BAR; PG8_MMA(1, 0, At, B0); PG8_MMA(1, 1, At, B1); PG8_BAR; PG8_SCHED;
        }
#if PG8_ALIGN
        if (wr == 0) PG8_BAR;
#endif
        E(acc, cur, wr, wc, fr, fq);
        if (!has_next) break;
        S.acc_init(nxt, acc, tid);
        cur = nxt; cA = nA; cB = nB; ++ui;
#if PG8_ALIGN
        if (wr == 1) PG8_BAR;
#endif
    }
    PG8_WAIT_V(0);
#if !PG8_ALIGN
    if (wr == 0) PG8_BAR;
#endif
    PG8_BAR;
#undef PG8_SA
#undef PG8_SB
#undef PG8_STAGE
#undef PG8_LDA
#undef PG8_LDB
#undef PG8_MMA
#undef PG8_WAIT_V
#undef PG8_WAIT_L
#undef PG8_BAR
#undef PG8_SCHED
}
}

DI int mod_index(int pm) { return pm < 32 ? 0 : 1 + ((pm - 32) >> 2); }
struct EpiSwiGLU {
    static constexpr bool PERM = true;
    bf16_t* H;
    DI void operator()(f32x4 (&acc)[2][2][4][2], const pg8::Unit& u, int wr, int wc, int fr, int fq) const {
        const int row0 = u.pm * 256 + wr * 64 + fr, col0 = u.pn * 128 + wc * 32 + 8 * fq;
#pragma unroll
        for (int ai = 0; ai < 2; ++ai)
#pragma unroll
            for (int m = 0; m < 4; ++m) {
                bf16_t* rowp = H + kb64(MT, row0 + ai * 128 + m * 16, col0);
                const f32x4 g0 = acc[ai][0][m][0], g1 = acc[ai][0][m][1], u0 = acc[ai][1][m][0], u1 = acc[ai][1][m][1];
                u32x4 w;
                w.x = pk2(fast_silu(g0[0]) * u0[0], fast_silu(g0[1]) * u0[1]); w.y = pk2(fast_silu(g0[2]) * u0[2], fast_silu(g0[3]) * u0[3]);
                w.z = pk2(fast_silu(g1[0]) * u1[0], fast_silu(g1[1]) * u1[1]); w.w = pk2(fast_silu(g1[2]) * u1[2], fast_silu(g1[3]) * u1[3]);
                *(u32x4*)rowp = w;
            }
    }
};
template <bool F32IN> struct EpiResid {
    static constexpr bool PERM = true; static constexpr int MB = F32IN ? 2 : 4;
    bf16_t* X; const float* gvec; float coef;
    const float* Xa; const float* Xb;
    DI void operator()(f32x4 (&acc)[2][2][4][2], const pg8::Unit& u, int wr, int wc, int fr, int fq) const {
        const int row0 = u.pm * 256 + wr * 64 + fr, col0 = u.pn * 256 + wc * 32 + 8 * fq;
        const float* Xi = u.pm < 32 ? Xa : Xb;
        const float* gv = gvec + (size_t)mod_index(u.pm) * NMOD + col0;
        f32x4 g[2][2];
#pragma unroll
        for (int bj = 0; bj < 2; ++bj)
#pragma unroll
            for (int n = 0; n < 2; ++n) g[bj][n] = *(const f32x4*)(gv + bj * 128 + n * 4) * coef;
        if (F32IN) {
#pragma unroll
            for (int ai = 0; ai < 2; ++ai)
#pragma unroll
                for (int mb = 0; mb < 4; mb += 2) {
                    f32x4 tv[2][2][2];
#pragma unroll
                    for (int mm = 0; mm < 2; ++mm) { const size_t ro = (size_t)(row0 + ai * 128 + (mb + mm) * 16) * DM + col0;
#pragma unroll
                        for (int bj = 0; bj < 2; ++bj) { tv[mm][bj][0] = *(const f32x4*)(Xi + ro + bj * 128); tv[mm][bj][1] = *(const f32x4*)(Xi + ro + bj * 128 + 4); } }
#pragma unroll
                    for (int mm = 0; mm < 2; ++mm) { const int m = mb + mm; bf16_t* rowp = X + ((size_t)u.pn * MT + row0 + ai * 128 + m * 16) * YLD + wc * 32 + 8 * fq;
#pragma unroll
                        for (int bj = 0; bj < 2; ++bj) { const f32x4 r0 = tv[mm][bj][0] + g[bj][0] * acc[ai][bj][m][0], r1 = tv[mm][bj][1] + g[bj][1] * acc[ai][bj][m][1];
                            u32x4 w; w.x = pk2(r0[0], r0[1]); w.y = pk2(r0[2], r0[3]); w.z = pk2(r1[0], r1[1]); w.w = pk2(r1[2], r1[3]); *(u32x4*)(rowp + bj * 128) = w; } }
                }
        } else {
            u32x4 tv[2][4][2];
            bf16_t* Xw = X + ((size_t)u.pn * MT + u.pm * 256 + wr * 64) * YLD + wc * 32;
            const unsigned lo = (unsigned)(fr * YLD + 8 * fq);
#define ER_LOAD(i) tv[(i) >> 3][((i) >> 1) & 3][(i) & 1] = *(const u32x4*)(Xw + (size_t)((((i) >> 3) * 128 + (((i) >> 1) & 3) * 16) * YLD + ((i) & 1) * 128) + lo)
#define ER_DONE(i) do { const int ai = (i) >> 3, m = ((i) >> 1) & 3, bj = (i) & 1; const u32x4 t = tv[ai][m][bj]; \
                const f32x4 r0 = (f32x4){bflo(t.x), bfhi(t.x), bflo(t.y), bfhi(t.y)} + g[bj][0] * acc[ai][bj][m][0], r1 = (f32x4){bflo(t.z), bfhi(t.z), bflo(t.w), bfhi(t.w)} + g[bj][1] * acc[ai][bj][m][1]; \
                u32x4 w; w.x = pk2(r0[0], r0[1]); w.y = pk2(r0[2], r0[3]); w.z = pk2(r1[0], r1[1]); w.w = pk2(r1[2], r1[3]); \
                *(u32x4*)(Xw + (size_t)((ai * 128 + m * 16) * YLD + bj * 128) + lo) = w; } while (0)
#pragma unroll
            for (int i = 0; i < 12; ++i) ER_LOAD(i);
            asm volatile("" ::: "memory");
#pragma unroll
            for (int i = 0; i < 4; ++i) ER_DONE(i);
            asm volatile("" ::: "memory");
#pragma unroll
            for (int i = 12; i < 16; ++i) ER_LOAD(i);
            asm volatile("" ::: "memory");
#pragma unroll
            for (int i = 4; i < 16; ++i) ER_DONE(i);
#undef ER_LOAD
#undef ER_DONE
        }
    }
};
template <class Epi> struct EpiSK {
    static constexpr bool PERM = Epi::PERM;
    Epi E; float* slab; unsigned* flags;
    DI void operator()(f32x4 (&acc)[2][2][4][2], const pg8::Unit& u, int wr, int wc, int fr, int fq) const {
        const int tid = threadIdx.x;
        const unsigned voff = (unsigned)tid * 16u;
        if (u.role == 1) {
            const char* base = (const char*)(slab + (size_t)u.seg * 65536);
#pragma unroll
            for (int ai = 0; ai < 2; ++ai)
#pragma unroll
                for (int bj = 0; bj < 2; ++bj)
#pragma unroll
                    for (int m = 0; m < 4; ++m) { const f32x4 a0 = acc[ai][bj][m][0], a1 = acc[ai][bj][m][1];
                        u32x4 w; w.x = pk2(a0[0], a0[1]); w.y = pk2(a0[2], a0[3]); w.z = pk2(a1[0], a1[1]); w.w = pk2(a1[2], a1[3]);
                        asm volatile("global_store_dwordx4 %0, %1, %2 sc1" :: "v"(voff), "v"(w), "s"(base) : "memory"); base += 8192; asm volatile("" : "+s"(base)); }
            asm volatile("s_waitcnt vmcnt(0)" ::: "memory");
            if ((tid & 63) == 0) __hip_atomic_fetch_add(flags + u.seg * 64, 1u, RLX_AGENT);
            return;
        }
        if (PROBE_DUP != 0 && E.coef == 0.f) return;
        E(acc, u, wr, wc, fr, fq);
    }
};
struct EpiY {
    static constexpr bool PERM = true;
    bf16_t* Y; float* YS;
    DI void operator()(f32x4 (&acc)[2][2][4][2], const pg8::Unit& u, int wr, int wc, int fr, int fq) const {
        const int row0 = u.pm * 256 + wr * 64 + fr, col0 = u.pn * 256 + wc * 32 + 8 * fq;
#pragma unroll
        for (int ai = 0; ai < 2; ++ai)
#pragma unroll
            for (int m = 0; m < 4; ++m) {
                bf16_t* rowp = Y + ((size_t)u.pn * MT + row0 + ai * 128 + m * 16) * YLD + wc * 32 + 8 * fq;
#pragma unroll
                for (int bj = 0; bj < 2; ++bj) { const f32x4 v0 = acc[ai][bj][m][0], v1 = acc[ai][bj][m][1];
                    u32x4 w; w.x = pk2(v0[0], v0[1]); w.y = pk2(v0[2], v0[3]); w.z = pk2(v1[0], v1[1]); w.w = pk2(v1[2], v1[3]);
                    *(u32x4*)(rowp + bj * 128) = w; }
            }
        if (u.pn == 54 && wc < 2) {
#pragma unroll
            for (int ai = 0; ai < 2; ++ai)
#pragma unroll
                for (int m = 0; m < 4; ++m) { float* p = YS + (size_t)(row0 + ai * 128 + m * 16) * 64 + wc * 32 + 8 * fq;
                    *(f32x4*)p = acc[ai][0][m][0]; *(f32x4*)(p + 4) = acc[ai][0][m][1]; }
        }
    }
};
struct EpiBranch {
    static constexpr bool PERM = true;
    const bf16_t* Y; bf16_t* PB;
    DI void operator()(f32x4 (&acc)[2][2][4][2], const pg8::Unit& u, int wr, int wc, int fr, int fq) const {
        const int row0 = u.pm * 256 + wr * 64 + fr, col0 = u.pn * 256 + wc * 32 + 8 * fq;
        bf16_t* P = PB + (size_t)u.seg * MT * DM;
#pragma unroll
        for (int ai = 0; ai < 2; ++ai) {
            u32x4 gb[4][2];
#pragma unroll
            for (int m = 0; m < 4; ++m)
#pragma unroll
                for (int bj = 0; bj < 2; ++bj) gb[m][bj] = *(const u32x4*)(Y + ((size_t)(YC_BR / 256 + u.seg * 8 + u.pn) * MT + row0 + ai * 128 + m * 16) * YLD + wc * 32 + 8 * fq + bj * 128);
#pragma unroll
            for (int m = 0; m < 4; ++m) {
                const size_t row = (size_t)(row0 + ai * 128 + m * 16);
#pragma unroll
                for (int bj = 0; bj < 2; ++bj) {
                    const u32x4 g = gb[m][bj]; const f32x4 v0 = acc[ai][bj][m][0], v1 = acc[ai][bj][m][1];
                    u32x4 w;
                    w.x = pk2(fast_sigmoid(bflo(g.x)) * v0[0], fast_sigmoid(bfhi(g.x)) * v0[1]); w.y = pk2(fast_sigmoid(bflo(g.y)) * v0[2], fast_sigmoid(bfhi(g.y)) * v0[3]);
                    w.z = pk2(fast_sigmoid(bflo(g.z)) * v1[0], fast_sigmoid(bfhi(g.z)) * v1[1]); w.w = pk2(fast_sigmoid(bflo(g.w)) * v1[2], fast_sigmoid(bfhi(g.w)) * v1[3]);
                    *(u32x4*)(P + ((size_t)u.pn * MT + row) * YLD + wc * 32 + 8 * fq + bj * 128) = w;
                }
            }
        }
    }
};

#define XB_TMO      128
#define XB_XCNT(j)  (256  + 64 * (j))
#define XB_XSUB(j)  (1280 + 64 * (j))
#define XB_XGEN(j)  (2304 + 64 * (j))
#define XB_TOP      3328
#define XB_TOPGEN   3392
#define XCD_BAR_WORDS 3456
#define XB_SPIN_CAP (1u << 18)
DI unsigned xb_ld(GAS unsigned* p)              { return __hip_atomic_load(p, __ATOMIC_RELAXED, __HIP_MEMORY_SCOPE_AGENT); }
DI unsigned xb_add(GAS unsigned* p, unsigned v) { return __hip_atomic_fetch_add(p, v, __ATOMIC_RELAXED, __HIP_MEMORY_SCOPE_AGENT); }
DI unsigned xb_xcc_id() { return (unsigned)__builtin_amdgcn_s_getreg((3 << 11) | 20) & 0xFu; }
#define XB_SPIN(cond, bar) do { unsigned _sp = 0; while (cond) { __builtin_amdgcn_s_sleep(1); \
    if ((++_sp & 255u) == 0u) { if (xb_ld(&(bar)[XB_TMO])) break; if (_sp > XB_SPIN_CAP) { xb_add(&(bar)[XB_TMO], 1u); break; } } } } while (0)
struct XcdBarrier { unsigned* bar; unsigned x; volatile LAS unsigned* st; };
DI XcdBarrier xcd_barrier_post(unsigned* bar, volatile LAS unsigned* st) {
    XcdBarrier b; b.bar = bar; b.x = xb_xcc_id(); b.st = st;
    if (threadIdx.x == 0) (void)xb_add(&((GAS unsigned*)bar)[XB_XCNT(b.x)], 1u);
    return b;
}
DI void xcd_barrier_complete(GAS unsigned* bar, unsigned x, unsigned& nloc, unsigned& nx) {
    const unsigned G = gridDim.x * gridDim.y * gridDim.z;
    unsigned sum, cnt, mine, sp = 0u;
    for (;;) {
        sum = 0u; cnt = 0u; mine = 0u;
#pragma unroll
        for (unsigned j = 0; j < 16; ++j) { const unsigned c = xb_ld(&bar[XB_XCNT(j)]); sum += c; cnt += (c > 0u) ? 1u : 0u; mine = (j == x) ? c : mine; }
        if (sum == G) break;
        __builtin_amdgcn_s_sleep(1);
        if ((++sp & 255u) == 0u) { if (xb_ld(&bar[XB_TMO])) break; if (sp > XB_SPIN_CAP) { xb_add(&bar[XB_TMO], 1u); break; } }
    }
    nloc = mine > 0u ? mine : 1u; nx = cnt > 0u ? cnt : 1u;
}
DI void xcd_barrier(const XcdBarrier& b) {
    asm volatile("s_waitcnt vmcnt(0)" ::: "memory");
    __syncthreads();
    if (threadIdx.x == 0) {
        GAS unsigned* bar = (GAS unsigned*)b.bar; asm volatile("" : "+s"(bar));
        __builtin_amdgcn_s_waitcnt(0);
        unsigned nloc = b.st[0], nx = b.st[1];
        if (nloc == 0u) { xcd_barrier_complete(bar, b.x, nloc, nx); b.st[0] = nloc; b.st[1] = nx; }
        const unsigned old = xb_add(&bar[XB_XSUB(b.x)], 1u);
        const unsigned gen = old / nloc;
        if (old + 1u == (gen + 1u) * nloc) {
            __builtin_amdgcn_fence(__ATOMIC_RELEASE, "agent");
            asm volatile("s_waitcnt vmcnt(0)" ::: "memory");
            const unsigned og = xb_add(&bar[XB_TOP], 1u);
            const unsigned tg = og / nx;
            if (og + 1u == (tg + 1u) * nx) xb_add(&bar[XB_TOPGEN], 1u);
            else XB_SPIN(xb_ld(&bar[XB_TOPGEN]) == tg, bar);
            __builtin_amdgcn_fence(__ATOMIC_ACQUIRE, "agent");
            xb_add(&bar[XB_XGEN(b.x)], 1u);
            asm volatile("s_waitcnt vmcnt(0)" ::: "memory");
        } else {
            XB_SPIN(xb_ld(&bar[XB_XGEN(b.x)]) == gen, bar);
            __builtin_amdgcn_fence(__ATOMIC_ACQUIRE, "agent");
            asm volatile("s_waitcnt vmcnt(0)" ::: "memory");
        }
    }
    __syncthreads();
}

namespace att {
constexpr int D = 128, NW = 8, QBLK = 32, KVBLK = 64;
constexpr float SCALE = 0.088388347648318440f;
constexpr float THR = 8.f;
constexpr size_t SHM_V = KVBLK * D * 2, SHM_K = KVBLK * D * 2;
#define KSWZ(row, colB) ((row) * 256 + ((colB) ^ (((row) & 7) << 4)))
#define SBAR() __builtin_amdgcn_sched_barrier(0)
DI unsigned cvtpk(float lo, float hi) { return pk2(lo, hi); }
struct Tile { const bf16_t* k; const bf16_t* v; int ldk, ldv, dpos, masked; };

DI void partialSM(f32x16& p0, f32x16& p1, float& m_reg, float& mn, float& alpha) {
  constexpr float C = SCALE * 1.4426950408889634f;
  float pmax = p0[0];
#pragma unroll
  for (int r = 1; r < 16; ++r) pmax = fmaxf(pmax, p0[r]);
#pragma unroll
  for (int r = 0; r < 16; ++r) pmax = fmaxf(pmax, p1[r]);
  { auto rr = __builtin_amdgcn_permlane32_swap(__float_as_uint(pmax), __float_as_uint(pmax), false, false);
    pmax = fmaxf(__uint_as_float(rr[0]), __uint_as_float(rr[1])); }
  if (__builtin_expect(__all(pmax - m_reg <= THR / SCALE), 1)) { mn = m_reg; alpha = 1.f; }
  else { mn = fmaxf(m_reg, pmax); alpha = __builtin_amdgcn_exp2f((m_reg - mn) * C); m_reg = mn; }
  float mnC = -mn * C;
#pragma unroll
  for (int r = 0; r < 16; ++r) p0[r] = fmaf(p0[r], C, mnC);
#pragma unroll
  for (int r = 0; r < 16; ++r) p1[r] = fmaf(p1[r], C, mnC);
#pragma unroll
  for (int r = 0; r < 16; ++r) p0[r] = __builtin_amdgcn_exp2f(p0[r]);
}
DI void finishSM(f32x16& p0, f32x16& p1, float alpha, float& l_reg, bf16x8& pa0, bf16x8& pa1, bf16x8& pa2, bf16x8& pa3) {
#pragma unroll
  for (int r = 0; r < 16; ++r) p1[r] = __builtin_amdgcn_exp2f(p1[r]);
  float ps = 0;
#pragma unroll
  for (int r = 0; r < 16; ++r) ps += p0[r];
#pragma unroll
  for (int r = 0; r < 16; ++r) ps += p1[r];
  { auto rr = __builtin_amdgcn_permlane32_swap(__float_as_uint(ps), __float_as_uint(ps), false, false);
    ps = __uint_as_float(rr[0]) + __uint_as_float(rr[1]); }
  l_reg = l_reg * alpha + ps;
#define PK4(P, BASE, OUT) do { unsigned a0 = cvtpk(P[BASE + 0], P[BASE + 1]), a1 = cvtpk(P[BASE + 2], P[BASE + 3]);   \
    unsigned b0 = cvtpk(P[BASE + 4], P[BASE + 5]), b1 = cvtpk(P[BASE + 6], P[BASE + 7]);                              \
    auto r0 = __builtin_amdgcn_permlane32_swap(a0, b0, false, false); auto r1 = __builtin_amdgcn_permlane32_swap(a1, b1, false, false); \
    u32x4 w = {r0[0], r1[0], r0[1], r1[1]}; OUT = __builtin_bit_cast(bf16x8, w); } while (0)
  PK4(p0, 0, pa0); PK4(p0, 8, pa1); PK4(p1, 0, pa2); PK4(p1, 8, pa3);
#undef PK4
}
DI void qkt(f32x16& p0, f32x16& p1, const char* Ks, const bf16x8* qr, int r32, int hi) {
#pragma unroll
  for (int i = 0; i < 16; ++i) { p0[i] = 0.f; p1[i] = 0.f; }
#pragma unroll
  for (int d0 = 0; d0 < 8; ++d0) { int cb = (d0 * 16 + hi * 8) * 2;
    bf16x8 b0 = *reinterpret_cast<const bf16x8*>(Ks + KSWZ(r32, cb));
    bf16x8 b1 = *reinterpret_cast<const bf16x8*>(Ks + KSWZ(32 + r32, cb));
    p0 = __builtin_amdgcn_mfma_f32_32x32x16_bf16(b0, qr[d0], p0, 0, 0, 0);
    p1 = __builtin_amdgcn_mfma_f32_32x32x16_bf16(b1, qr[d0], p1, 0, 0, 0); }
}
DI void amask(f32x16& p0, f32x16& p1, int dl, int hi) {
#pragma unroll
  for (int r = 0; r < 16; ++r) { const int kk = crow(r, hi);
    if ((unsigned)(dl + kk + 128) > 256u) p0[r] = -1e30f;
    if ((unsigned)(dl + kk + 32 + 128) > 256u) p1[r] = -1e30f; }
}
DI int v_st(int k, int c) { const int kk = (k & ~0xC) | ((k & 4) << 1) | ((k & 8) >> 1); return ((kk >> 3) * 4 + (c >> 5)) * 512 + ((kk & 7) * 32 + (c & 31)) * 2; }
DI int v_rd_base(int lane) { return ((lane & 3) << 3) | (((lane >> 2) & 3) << 6) | (((lane >> 4) & 1) << 5) | (((lane >> 5) & 1) << 8); }
constexpr int v_rd_off(int d0, int ks, int half) { return d0 * 512 + ks * 4096 + half * 2048; }
template <int OFF> DI s16x4 tr_read(int vb) {
  s16x4 r; asm volatile("ds_read_b64_tr_b16 %0, %1 offset:%2" : "=&v"(r) : "v"(vb), "i"(OFF) : "memory"); return r;
}
template <int D0> DI void pv_one(f32x16& od, int vb, bf16x8 pa0, bf16x8 pa1, bf16x8 pa2, bf16x8 pa3) {
  const s16x4 l0 = tr_read<v_rd_off(D0, 0, 0)>(vb), h0 = tr_read<v_rd_off(D0, 0, 1)>(vb), l1 = tr_read<v_rd_off(D0, 1, 0)>(vb), h1 = tr_read<v_rd_off(D0, 1, 1)>(vb);
  const s16x4 l2 = tr_read<v_rd_off(D0, 2, 0)>(vb), h2 = tr_read<v_rd_off(D0, 2, 1)>(vb), l3 = tr_read<v_rd_off(D0, 3, 0)>(vb), h3 = tr_read<v_rd_off(D0, 3, 1)>(vb);
  asm volatile("s_waitcnt lgkmcnt(0)" ::: "memory"); SBAR();
#define PK(L, H) (bf16x8){L[0], L[1], L[2], L[3], H[0], H[1], H[2], H[3]}
  od = __builtin_amdgcn_mfma_f32_32x32x16_bf16(pa0, PK(l0, h0), od, 0, 0, 0);
  od = __builtin_amdgcn_mfma_f32_32x32x16_bf16(pa1, PK(l1, h1), od, 0, 0, 0);
  od = __builtin_amdgcn_mfma_f32_32x32x16_bf16(pa2, PK(l2, h2), od, 0, 0, 0);
  od = __builtin_amdgcn_mfma_f32_32x32x16_bf16(pa3, PK(l3, h3), od, 0, 0, 0);
#undef PK
}
DI void pv_d0(f32x16* o, int vb, bf16x8 pa0, bf16x8 pa1, bf16x8 pa2, bf16x8 pa3) {
  pv_one<0>(o[0], vb, pa0, pa1, pa2, pa3); pv_one<1>(o[1], vb, pa0, pa1, pa2, pa3); pv_one<2>(o[2], vb, pa0, pa1, pa2, pa3); pv_one<3>(o[3], vb, pa0, pa1, pa2, pa3);
}
DI bf16x8 ld8(const bf16_t* p) { return *reinterpret_cast<const bf16x8*>(p); }

template <class TS>
DI void attn_unit(const bf16_t* __restrict__ Qb, int ldq, const TS& ts, int NT, float sink, bf16_t* __restrict__ Ob, int ldo, char* lds) {
  int tid_ = threadIdx.x; asm volatile("" : "+v"(tid_));
  const int tid = tid_, wid = tid >> 6, lane = tid & 63, r32 = lane & 31, hi = lane >> 5;
  char* V_lds = lds; char* K_lds = lds + 2 * SHM_V;
  float* ws = (float*)(lds + 2 * SHM_V + 2 * SHM_K) + wid * 64; float* li_l = ws; float* al_l = ws + 32;
  float m_reg = sink * (1.0f / SCALE), l_reg = 1.0f; f32x16 o[4]; bf16x8 qr[8];
#pragma unroll
  for (int d = 0; d < 4; ++d)
#pragma unroll
    for (int r = 0; r < 16; ++r) o[d][r] = 0.f;
  const bf16_t* Qw = Qb + (long)(wid * QBLK + r32) * ldq + hi * 8;
#pragma unroll
  for (int d0 = 0; d0 < 8; ++d0) qr[d0] = ld8(Qw + d0 * 16);
  const int sr = tid >> 4, sc = (tid & 15) * 8, vst0 = v_st(sr, sc), vst1 = v_st(32 + sr, sc);
  const int vb0 = (int)(uintptr_t)V_lds + v_rd_base(lane);
  const int dlane = -(wid * QBLK + r32);
  struct { bf16x8 vs0, vs1, ks0, ks1; } sr_[2];
#define SLOAD(i, J) do { const Tile T_ = ts(J); sr_[i].vs0 = ld8(T_.v + (long)sr * T_.ldv + sc); sr_[i].vs1 = ld8(T_.v + (long)(32 + sr) * T_.ldv + sc); \
    sr_[i].ks0 = ld8(T_.k + (long)sr * T_.ldk + sc); sr_[i].ks1 = ld8(T_.k + (long)(32 + sr) * T_.ldk + sc); } while (0)
#define SWRITE(b, i) do { *(bf16x8*)(V_lds + (b) * SHM_V + vst0) = sr_[i].vs0;          \
    *(bf16x8*)(V_lds + (b) * SHM_V + vst1) = sr_[i].vs1; int kc = sc * 2;               \
    *(bf16x8*)(K_lds + (b) * SHM_K + KSWZ(sr, kc)) = sr_[i].ks0;                       \
    *(bf16x8*)(K_lds + (b) * SHM_K + KSWZ(32 + sr, kc)) = sr_[i].ks1; } while (0)
#define SWAIT() asm volatile("s_waitcnt vmcnt(4)" ::: "memory")
#define RESC(a) do { if (__any((a) < 1.f)) { if (hi == 0) al_l[r32] = (a); asm volatile("s_waitcnt lgkmcnt(0)" ::: "memory"); \
    _Pragma("unroll") for (int d = 0; d < 4; ++d) _Pragma("unroll") for (int r = 0; r < 16; ++r) o[d][r] *= al_l[crow(r, hi)]; } } while (0)
#define MASK(P0, P1, J) do { const Tile T_ = ts(J); if (T_.masked) amask(P0, P1, T_.dpos + dlane, hi); } while (0)
  f32x16 pA0, pA1, pB0, pB1; float mnA, mnB, alA, alB; bf16x8 pa0, pa1, pa2, pa3;
  constexpr int SE = 0, SO = 1;
  SLOAD(SE, 0); asm volatile("s_waitcnt vmcnt(0)" ::: "memory"); SWRITE(0, SE); __syncthreads();
  qkt(pA0, pA1, K_lds, qr, r32, hi); MASK(pA0, pA1, 0); partialSM(pA0, pA1, m_reg, mnA, alA);
  SLOAD(SO, 1); if (2 < NT) SLOAD(SE, 2);
  SWAIT(); SWRITE(1, SO); __syncthreads();
  for (int j = 1; j + 1 < NT; j += 2) {
    SBAR(); qkt(pB0, pB1, K_lds + SHM_K, qr, r32, hi); MASK(pB0, pB1, j);
    finishSM(pA0, pA1, alA, l_reg, pa0, pa1, pa2, pa3); SBAR();
    SLOAD(SO, j + 2); SBAR();
    pv_d0(o, vb0, pa0, pa1, pa2, pa3); partialSM(pB0, pB1, m_reg, mnB, alB);
    __syncthreads(); SWAIT(); SWRITE(0, SE);
    RESC(alB); __syncthreads();
    SBAR(); qkt(pA0, pA1, K_lds, qr, r32, hi); MASK(pA0, pA1, j + 1);
    finishSM(pB0, pB1, alB, l_reg, pa0, pa1, pa2, pa3); SBAR();
    if (j + 3 < NT) SLOAD(SE, j + 3); SBAR();
    pv_d0(o, vb0 + (int)SHM_V, pa0, pa1, pa2, pa3); partialSM(pA0, pA1, m_reg, mnA, alA);
    __syncthreads(); SWAIT(); SWRITE(1, SO);
    RESC(alA); __syncthreads();
  }
  SBAR(); qkt(pB0, pB1, K_lds + SHM_K, qr, r32, hi); MASK(pB0, pB1, NT - 1);
  finishSM(pA0, pA1, alA, l_reg, pa0, pa1, pa2, pa3); SBAR();
  pv_d0(o, vb0, pa0, pa1, pa2, pa3); partialSM(pB0, pB1, m_reg, mnB, alB);
  __syncthreads(); RESC(alB);
  finishSM(pB0, pB1, alB, l_reg, pa0, pa1, pa2, pa3); SBAR();
  pv_d0(o, vb0 + (int)SHM_V, pa0, pa1, pa2, pa3);
  if (hi == 0) li_l[r32] = l_reg; asm volatile("s_waitcnt lgkmcnt(0)" ::: "memory");
  float rli[16];
#pragma unroll
  for (int r = 0; r < 16; ++r) rli[r] = __builtin_amdgcn_rcpf(li_l[crow(r, hi)]);
  bf16_t* Ow = Ob + (long)(wid * QBLK) * ldo;
#pragma unroll
  for (int r = 0; r < 16; ++r) { int orow = crow(r, hi);
#pragma unroll
    for (int d0 = 0; d0 < 4; ++d0) Ow[(long)orow * ldo + (long)(d0 >> 1) * ((long)MT * 64) + (d0 & 1) * 32 + r32] = f2bf(o[d0][r] * rli[r]); }
  __syncthreads();
#undef SLOAD
#undef SWRITE
#undef SWAIT
#undef RESC
#undef MASK
}
}

struct Frame {
    unsigned char* ws; float* out; const float* const* in;
    int G, bid;
};
#define MFMA32(a, b, c) __builtin_amdgcn_mfma_f32_32x32x16_bf16((a), (b), (c), 0, 0, 0)
DI bf16x8 pack_step(const f32x16& x, int s) {
    u32x4 p; p.x = pk2(x[8 * s + 0], x[8 * s + 1]); p.y = pk2(x[8 * s + 2], x[8 * s + 3]); p.z = pk2(x[8 * s + 4], x[8 * s + 5]); p.w = pk2(x[8 * s + 6], x[8 * s + 7]);
    return __builtin_bit_cast(bf16x8, p);
}
DI bf16x8 cat4(s16x4 lo, s16x4 hi) { return (bf16x8){lo[0], lo[1], lo[2], lo[3], hi[0], hi[1], hi[2], hi[3]}; }

constexpr int GL_QS = 0, GL_KS = 17408, GL_KT = 34816, GL_VT = 53248, GL_AS = 90112, GL_DS = 99328, GL_PART = 99840;
DI void gla_chain(const Frame& F, LAS unsigned char* lds, int item, int layer) {
    unsigned char* const ws_ = F.ws;
    int tid_ = threadIdx.x; asm volatile("" : "+v"(tid_));
    const int tid = tid_, lane = tid & 63, w = __builtin_amdgcn_readfirstlane(tid >> 6), r = lane & 31, hh = lane >> 5;
    const int dir = item & 1, h = (item >> 1) & 3, sq = item >> 3;
    const bool lat = sq < 2; const int b = lat ? sq : sq - 2;
    const int L = lat ? 1024 : 256, row0 = lat ? M_CTX + b * 1024 : b * 256, NC = L / 64;
    const bf16_t* Y = (const bf16_t*)(ws_ + WS_BIG); const bf16_t* LA = (const bf16_t*)(ws_ + WS_LA);
    bf16_t* OD = (bf16_t*)(ws_ + WS_ODG) + (size_t)dir * MT * 1024;
    LAS bf16_t* Qs = (LAS bf16_t*)(lds + GL_QS); LAS bf16_t* Ks = (LAS bf16_t*)(lds + GL_KS); LAS bf16_t* KT = (LAS bf16_t*)(lds + GL_KT);
    LAS bf16_t* VT = (LAS bf16_t*)(lds + GL_VT); LAS bf16_t* As = (LAS bf16_t*)(lds + GL_AS); LAS float* dS = (LAS float*)(lds + GL_DS); LAS float* partS = (LAS float*)(lds + GL_PART);
    f32x16 S[4];
    if (lat) { const float* st = F.in[5] + ((((size_t)b * 2 + layer) * 2 + dir) * 4 + h) * 128 * 256;
#pragma unroll
        for (int kt = 0; kt < 4; ++kt)
#pragma unroll
            for (int i = 0; i < 16; ++i) S[kt][i] = st[(size_t)(32 * kt + crow(i, hh)) * 256 + 32 * w + r];
    } else {
#pragma unroll
        for (int kt = 0; kt < 4; ++kt)
#pragma unroll
            for (int i = 0; i < 16; ++i) S[kt][i] = 0.f;
    }
    const int kp = tid & 63, sg = tid >> 6, vcc = tid >> 4, vsb = tid & 15;
#define WG_BAR() do { asm volatile("s_waitcnt lgkmcnt(0)" ::: "memory"); __builtin_amdgcn_s_barrier(); asm volatile("" ::: "memory"); } while (0)
#define GLA_LOAD(PROW, LAr, QVr, KVr, VVr) do { \
        _Pragma("unroll") for (int i = 0; i < 8; ++i) LAr[i] = *(const unsigned*)(LA + ((size_t)(dir * 4 + h) * MT + (PROW) + 8 * sg + i) * 128 + 2 * kp); \
        _Pragma("unroll") for (int i = 0; i < 4; ++i) VVr[i] = *(const bf16x8*)(Y + yaddr((PROW) + 4 * vsb + i, YC_GV + h * 256 + 8 * vcc)); \
        _Pragma("unroll") for (int i = 0; i < 8; ++i) { const size_t ro = yaddr((PROW) + 8 * sg + i, h * 128 + 2 * kp); QVr[i] = *(const unsigned*)(Y + ro + yaddr(0, YC_GQ)); KVr[i] = *(const unsigned*)(Y + ro + yaddr(0, YC_GK)); } } while (0)
    unsigned la[8], qv[8], kv[8]; bf16x8 vv[4];
    GLA_LOAD(row0 + 64 * (dir ? NC - 1 : 0), la, qv, kv, vv);
    for (int c = 0; c < NC; ++c) {
        const int pb = dir ? NC - 1 - c : c, prow = row0 + 64 * pb;
        { f32x2 part = {0.f, 0.f};
#pragma unroll
          for (int i = 0; i < 8; ++i) part += (f32x2){bflo(la[i]), bfhi(la[i])};
          *(LAS f32x2*)(partS + sg * 128 + 2 * kp) = part; }
        WG_BAR();
        f32x2 run = {0.f, 0.f}, total = {0.f, 0.f};
#pragma unroll
        for (int j = 0; j < 8; ++j) { const f32x2 p = *(const LAS f32x2*)(partS + j * 128 + 2 * kp); total += p; if (dir == 0 ? (j < sg) : (j > sg)) run += p; }
        const float eta = __expf(total[0]), etb = __expf(total[1]);
        float kha[8], khb[8];
#pragma unroll
        for (int ii = 0; ii < 8; ++ii) { const int i = dir == 0 ? ii : 7 - ii; run += (f32x2){bflo(la[i]), bfhi(la[i])}; const int t = 8 * sg + i;
            const float xa = run[0] * 1.4426950408889634f, xb = run[1] * 1.4426950408889634f;
            const float ka = bflo(kv[i]) * __builtin_amdgcn_exp2f(-xa), kb = bfhi(kv[i]) * __builtin_amdgcn_exp2f(-xb);
            *(LAS unsigned*)(Qs + t * 136 + 2 * kp) = pk2(bflo(qv[i]) * 0.088388347648318440f * __builtin_amdgcn_exp2f(xa), bfhi(qv[i]) * 0.088388347648318440f * __builtin_amdgcn_exp2f(xb));
            *(LAS unsigned*)(Ks + t * 136 + 2 * kp) = pk2(ka, kb); kha[i] = ka * eta; khb[i] = kb * etb; }
        { u32x4 w0, w1; w0.x = pk2(kha[0], kha[1]); w0.y = pk2(kha[2], kha[3]); w0.z = pk2(kha[4], kha[5]); w0.w = pk2(kha[6], kha[7]);
          w1.x = pk2(khb[0], khb[1]); w1.y = pk2(khb[2], khb[3]); w1.z = pk2(khb[4], khb[5]); w1.w = pk2(khb[6], khb[7]);
          *(LAS u32x4*)(KT + (2 * kp) * 72 + 8 * sg) = w0; *(LAS u32x4*)(KT + (2 * kp + 1) * 72 + 8 * sg) = w1; }
        if (sg == 0) *(LAS f32x2*)(dS + 2 * kp) = (f32x2){eta, etb};
#pragma unroll
        for (int e = 0; e < 8; ++e) { s16x4 q4 = {vv[0][e], vv[1][e], vv[2][e], vv[3][e]}; *(LAS s16x4*)(VT + (8 * vcc + e) * 72 + 4 * vsb) = q4; }
        WG_BAR();
        if (c + 1 < NC) GLA_LOAD(row0 + 64 * (dir ? NC - 2 - c : c + 1), la, qv, kv, vv);
        if (w < 4) {
            const int ti = w >> 1, si = w & 1;
            const bool need = dir == 0 ? (si <= ti) : (si >= ti);
            f32x16 a;
#pragma unroll
            for (int i = 0; i < 16; ++i) a[i] = 0.f;
            if (need) {
#pragma unroll
                for (int kk = 0; kk < 8; ++kk) { const bf16x8 fa = *(const LAS bf16x8*)(Qs + (32 * ti + r) * 136 + 16 * kk + 8 * hh), fb = *(const LAS bf16x8*)(Ks + (32 * si + r) * 136 + 16 * kk + 8 * hh);
                    a = MFMA32(fa, fb, a); }
            }
            const int s = 32 * si + r;
#pragma unroll
            for (int i = 0; i < 16; ++i) { const int t = 32 * ti + crow(i, hh); const bool ok = dir == 0 ? (s <= t) : (s >= t); As[t * 72 + s] = f2bf(ok ? a[i] : 0.f); }
        }
        WG_BAR();
        bf16x8 bv[4];
#pragma unroll
        for (int kk = 0; kk < 4; ++kk) bv[kk] = *(const LAS bf16x8*)(VT + (32 * w + r) * 72 + 16 * kk + 8 * hh);
#pragma unroll
        for (int ti = 0; ti < 2; ++ti) {
            f32x16 o;
#pragma unroll
            for (int i = 0; i < 16; ++i) o[i] = 0.f;
#pragma unroll
            for (int kk = 0; kk < 4; ++kk) { const bf16x8 fa = *(const LAS bf16x8*)(As + (32 * ti + r) * 72 + 16 * kk + 8 * hh); o = MFMA32(fa, bv[kk], o); }
#pragma unroll
            for (int kt = 0; kt < 4; ++kt)
#pragma unroll
                for (int s2 = 0; s2 < 2; ++s2) { const bf16x8 fb = pack_step(S[kt], s2);
                    const LAS bf16_t* qp = Qs + (32 * ti + r) * 136 + 32 * kt + 16 * s2 + 4 * hh;
                    const bf16x8 fa = cat4(*(const LAS s16x4*)qp, *(const LAS s16x4*)(qp + 8)); o = MFMA32(fa, fb, o); }
#pragma unroll
            for (int i = 0; i < 16; ++i) (OD + ((size_t)h * MT + prow + 32 * ti + (i & 3) + 8 * (i >> 2)) * YLD + 32 * w)[(unsigned)(4 * hh * YLD + r)] = f2bf(o[i]);
        }
#pragma unroll
        for (int kt = 0; kt < 4; ++kt) {
#pragma unroll
            for (int g = 0; g < 4; ++g) { const f32x4 dv = *(const LAS f32x4*)(dS + 32 * kt + 8 * g + 4 * hh);
                S[kt][4 * g + 0] *= dv[0]; S[kt][4 * g + 1] *= dv[1]; S[kt][4 * g + 2] *= dv[2]; S[kt][4 * g + 3] *= dv[3]; }
#pragma unroll
            for (int kk = 0; kk < 4; ++kk) { const bf16x8 fa = *(const LAS bf16x8*)(KT + (32 * kt + r) * 72 + 16 * kk + 8 * hh); S[kt] = MFMA32(fa, bv[kk], S[kt]); }
        }
    }
    if (!lat) { float* so = F.out + OUT_GLA + ((((size_t)b * 2 + layer) * 2 + dir) * 4 + h) * 128 * 256;
#pragma unroll
        for (int kt = 0; kt < 4; ++kt)
#pragma unroll
            for (int i = 0; i < 16; ++i) so[(size_t)(32 * kt + crow(i, hh)) * 256 + 32 * w + r] = S[kt][i];
    }
    WG_BAR();
#undef GLA_LOAD
}

constexpr int SD_BS = 0, SD_CS = 17408, SD_BT = 34816, SD_XT = 53248, SD_GS = 90112, SD_CUM = 107520, SD_DT = 108544, SD_F = 109568, SD_E = 110592, SD_TOT = 111616;
DI void ssd_chain(const Frame& F, LAS unsigned char* lds, int item, int layer, int hp) {
    unsigned char* const ws_ = F.ws;
    int tid_ = threadIdx.x; asm volatile("" : "+v"(tid_));
    const int tid = tid_, lane = tid & 63, w = __builtin_amdgcn_readfirstlane(tid >> 6), r = lane & 31, hh = lane >> 5;
    const int dir = item & 1, g = (item >> 1) & 3, sq = item >> 3;
    const bool lat = sq < 2; const int b = lat ? sq : sq - 2;
    const int L = lat ? 1024 : 256, row0 = lat ? M_CTX + b * 1024 : b * 256, NC = L / 64;
    const int hg = hp < 0 ? (w >> 1) : (2 * hp + (w >> 2)), ph = hp < 0 ? (w & 1) : ((w >> 1) & 1), head = g * 4 + hg;
    const int ti0 = hp < 0 ? 0 : (w & 1), ti1 = hp < 0 ? 2 : ti0 + 1;
    const bf16_t* XBC = (const bf16_t*)(ws_ + WS_XBC); const float* DT = (const float*)(ws_ + WS_DT); const float* DTA = (const float*)(ws_ + WS_DTA);
    bf16_t* YD = (bf16_t*)(ws_ + WS_ODS) + (size_t)dir * MT * 1024;
    LAS bf16_t* Bs = (LAS bf16_t*)(lds + SD_BS); LAS bf16_t* Cs = (LAS bf16_t*)(lds + SD_CS); LAS bf16_t* BT = (LAS bf16_t*)(lds + SD_BT); LAS bf16_t* XT = (LAS bf16_t*)(lds + SD_XT);
    LAS float* Gs = (LAS float*)(lds + SD_GS); LAS float* cumS = (LAS float*)(lds + SD_CUM); LAS float* dtS = (LAS float*)(lds + SD_DT); LAS float* fS = (LAS float*)(lds + SD_F);
    LAS float* eS = (LAS float*)(lds + SD_E); LAS float* totS = (LAS float*)(lds + SD_TOT);
    f32x16 ST[4];
    if (lat) { const float* st = F.in[6] + ((((size_t)b * 2 + layer) * 2 + dir) * 16 + head) * 64 * 128 + (size_t)(32 * ph + r) * 128;
#pragma unroll
        for (int nt = 0; nt < 4; ++nt)
#pragma unroll
            for (int q = 0; q < 4; ++q) { const f32x4 v = *(const f32x4*)(st + 32 * nt + 8 * q + 4 * hh); ST[nt][4 * q] = v[0]; ST[nt][4 * q + 1] = v[1]; ST[nt][4 * q + 2] = v[2]; ST[nt][4 * q + 3] = v[3]; }
    } else {
#pragma unroll
        for (int nt = 0; nt < 4; ++nt)
#pragma unroll
            for (int i = 0; i < 16; ++i) ST[nt][i] = 0.f;
    }
    const int ssb = tid & 15, sch = (tid >> 4) & 15, xch = tid >> 4; const bool isC = tid >= 256;
#define SSD_LOAD(PROW, BCr, XVr, DTr, DAr) do { \
        _Pragma("unroll") for (int i = 0; i < 4; ++i) BCr[i] = *(const bf16x8*)(XBC + yaddr((PROW) + 4 * ssb + i, (isC ? 1536 : 1024) + g * 128 + 8 * sch)); \
        _Pragma("unroll") for (int i = 0; i < 4; ++i) XVr[i] = *(const bf16x8*)(XBC + yaddr((PROW) + 4 * ssb + i, g * 256 + 8 * xch)); \
        if (w < 4) { const size_t di = (size_t)((PROW) + lane) * 32 + dir * 16 + g * 4 + w; DTr = DT[di]; DAr = DTA[di]; } } while (0)
    bf16x8 bc[4], xv[4], bcn[4], xvn[4]; float dtv = 0.f, dta = 0.f, dtvn = 0.f, dtan = 0.f;
    SSD_LOAD(row0 + 64 * (dir ? NC - 1 : 0), bc, xv, dtv, dta);
    for (int c = 0; c < NC; ++c) {
        const int pb = dir ? NC - 1 - c : c, prow = row0 + 64 * pb;
        if (c + 1 < NC) SSD_LOAD(row0 + 64 * (dir ? NC - 2 - c : c + 1), bcn, xvn, dtvn, dtan);
        { LAS bf16_t* dstR = isC ? Cs : Bs;
#pragma unroll
          for (int i = 0; i < 4; ++i) *(LAS bf16x8*)(dstR + (4 * ssb + i) * 136 + 8 * sch) = bc[i];
          if (!isC) {
#pragma unroll
              for (int e = 0; e < 8; ++e) { s16x4 q4 = {bc[0][e], bc[1][e], bc[2][e], bc[3][e]}; *(LAS s16x4*)(BT + (8 * sch + e) * 72 + 4 * ssb) = q4; } }
#pragma unroll
          for (int e = 0; e < 8; ++e) { s16x4 q4 = {xv[0][e], xv[1][e], xv[2][e], xv[3][e]}; *(LAS s16x4*)(XT + (8 * xch + e) * 72 + 4 * ssb) = q4; }
        }
        if (w < 4) {
            float cs = dta;
#pragma unroll
            for (int o = 1; o < 64; o <<= 1) { const float t = __shfl_up(cs, o); if (lane >= o) cs += t; }
            const float total = __shfl(cs, 63);
            const float cum = dir == 0 ? cs : total - cs + dta;
            cumS[w * 64 + lane] = cum; dtS[w * 64 + lane] = dtv; fS[w * 64 + lane] = dtv * __expf(total - cum); eS[w * 64 + lane] = __expf(cum);
            if (lane == 0) totS[w] = __expf(total);
        }
        WG_BAR();
        if (w < 4) {
            const int ti = w >> 1, si = w & 1;
            const bool need = dir == 0 ? (si <= ti) : (si >= ti);
            f32x16 a;
#pragma unroll
            for (int i = 0; i < 16; ++i) a[i] = 0.f;
            if (need) {
#pragma unroll
                for (int kk = 0; kk < 8; ++kk) { const bf16x8 fa = *(const LAS bf16x8*)(Cs + (32 * ti + r) * 136 + 16 * kk + 8 * hh), fb = *(const LAS bf16x8*)(Bs + (32 * si + r) * 136 + 16 * kk + 8 * hh);
                    a = MFMA32(fa, fb, a); }
            }
#pragma unroll
            for (int i = 0; i < 16; ++i) Gs[(32 * ti + crow(i, hh)) * 68 + 32 * si + r] = a[i];
        }
        WG_BAR();
        const LAS bf16_t* xrow = XT + (hg * 64 + 32 * ph + r) * 72 + 8 * hh;
#pragma unroll 1
        for (int ti = ti0; ti < ti1; ++ti) {
            f32x16 y;
#pragma unroll
            for (int i = 0; i < 16; ++i) y[i] = 0.f;
            const int t = 32 * ti + r; const float ct = cumS[hg * 64 + t];
#pragma unroll
            for (int nt = 0; nt < 4; ++nt)
#pragma unroll
                for (int s2 = 0; s2 < 2; ++s2) { const bf16x8 fb = pack_step(ST[nt], s2);
                    const LAS bf16_t* cp = Cs + t * 136 + 32 * nt + 16 * s2 + 4 * hh;
                    const bf16x8 fa = cat4(*(const LAS s16x4*)cp, *(const LAS s16x4*)(cp + 8)); y = MFMA32(fa, fb, y); }
#pragma unroll
            for (int q = 0; q < 4; ++q) { const f32x4 ev = *(const LAS f32x4*)(eS + hg * 64 + 32 * ti + 8 * q + 4 * hh);
                y[4 * q] *= ev[0]; y[4 * q + 1] *= ev[1]; y[4 * q + 2] *= ev[2]; y[4 * q + 3] *= ev[3]; }
#pragma unroll
            for (int kk = 0; kk < 4; ++kk) {
                const bool blk = dir == 0 ? (16 * kk <= 32 * ti + 31) : (16 * kk + 15 >= 32 * ti);
                if (blk) {
                    const int s0 = 16 * kk + 8 * hh;
                    const f32x4 g0 = *(const LAS f32x4*)(Gs + t * 68 + s0), g1 = *(const LAS f32x4*)(Gs + t * 68 + s0 + 4);
                    const f32x4 c0 = *(const LAS f32x4*)(cumS + hg * 64 + s0), c1 = *(const LAS f32x4*)(cumS + hg * 64 + s0 + 4);
                    const f32x4 d0 = *(const LAS f32x4*)(dtS + hg * 64 + s0), d1 = *(const LAS f32x4*)(dtS + hg * 64 + s0 + 4);
                    float wv[8];
#pragma unroll
                    for (int j = 0; j < 4; ++j) { const int s = s0 + j; const bool ok = dir == 0 ? (s <= t) : (s >= t);
                        wv[j] = ok ? g0[j] * __expf(fminf(ct - c0[j], 0.f)) * d0[j] : 0.f; }
#pragma unroll
                    for (int j = 0; j < 4; ++j) { const int s = s0 + 4 + j; const bool ok = dir == 0 ? (s <= t) : (s >= t);
                        wv[4 + j] = ok ? g1[j] * __expf(fminf(ct - c1[j], 0.f)) * d1[j] : 0.f; }
                    u32x4 p; p.x = pk2(wv[0], wv[1]); p.y = pk2(wv[2], wv[3]); p.z = pk2(wv[4], wv[5]); p.w = pk2(wv[6], wv[7]);
                    y = MFMA32(__builtin_bit_cast(bf16x8, p), *(const LAS bf16x8*)(xrow + 16 * kk), y);
                }
            }
#pragma unroll
            for (int i = 0; i < 16; ++i) (YD + ((size_t)(head >> 2) * MT + prow + 32 * ti + (i & 3) + 8 * (i >> 2)) * YLD + (head & 3) * 64 + 32 * ph)[(unsigned)(4 * hh * YLD + r)] = f2bf(y[i]);
        }
        const float dec = totS[hg];
#pragma unroll
        for (int nt = 0; nt < 4; ++nt)
#pragma unroll
            for (int i = 0; i < 16; ++i) ST[nt][i] *= dec;
#pragma unroll
        for (int kk = 0; kk < 4; ++kk) { const int s0 = 16 * kk + 8 * hh;
            const f32x4 f0 = *(const LAS f32x4*)(fS + hg * 64 + s0), f1 = *(const LAS f32x4*)(fS + hg * 64 + s0 + 4);
            const bf16x8 xk = *(const LAS bf16x8*)(xrow + 16 * kk);
            u32x4 p; p.x = pk2(bf2f_s(xk[0]) * f0[0], bf2f_s(xk[1]) * f0[1]); p.y = pk2(bf2f_s(xk[2]) * f0[2], bf2f_s(xk[3]) * f0[3]);
            p.z = pk2(bf2f_s(xk[4]) * f1[0], bf2f_s(xk[5]) * f1[1]); p.w = pk2(bf2f_s(xk[6]) * f1[2], bf2f_s(xk[7]) * f1[3]);
            const bf16x8 xh = __builtin_bit_cast(bf16x8, p);
#pragma unroll
            for (int nt = 0; nt < 4; ++nt) { const bf16x8 fa = *(const LAS bf16x8*)(BT + (32 * nt + r) * 72 + 16 * kk + 8 * hh); ST[nt] = MFMA32(fa, xh, ST[nt]); }
        }
        WG_BAR();
#pragma unroll
        for (int i = 0; i < 4; ++i) { bc[i] = bcn[i]; xv[i] = xvn[i]; }
        dtv = dtvn; dta = dtan;
    }
    if (!lat) { float* so = F.out + OUT_SSM + ((((size_t)b * 2 + layer) * 2 + dir) * 16 + head) * 64 * 128 + (size_t)(32 * ph + r) * 128;
#pragma unroll
        for (int nt = 0; nt < 4; ++nt)
#pragma unroll
            for (int q = 0; q < 4; ++q) { f32x4 v = {ST[nt][4 * q], ST[nt][4 * q + 1], ST[nt][4 * q + 2], ST[nt][4 * q + 3]}; *(f32x4*)(so + 32 * nt + 8 * q + 4 * hh) = v; }
    }
}

DI void norm_phase(const Frame& F, const float* Xa, const float* Xb, const float* nw, const float* mod  , bf16_t* XN) {
    int tid_ = threadIdx.x; asm volatile("" : "+v"(tid_));
    const int lane = tid_ & 63, gw = F.bid * NWAVES + __builtin_amdgcn_readfirstlane(tid_ >> 6), NGW = F.G * NWAVES;
    f32x4 wf[8], sf[8]; int cur_mi = -1;
    for (int row = gw; row < MT; row += NGW) {
        const f32x4* xr = (const f32x4*)((row < M_CTX ? Xa : Xb) + (size_t)row * DM) + lane;
        f32x4 v[8]; float s = 0.f;
#pragma unroll
        for (int j = 0; j < 8; ++j) { v[j] = xr[64 * j]; s += (v[j][0] * v[j][0] + v[j][1] * v[j][1]) + (v[j][2] * v[j][2] + v[j][3] * v[j][3]); }
        const int mi = row < M_CTX ? 0 : 1 + ((row - M_CTX) >> 10);
        if (mi != cur_mi) { cur_mi = mi;
            const f32x4* sh = (const f32x4*)(mod + (size_t)mi * NMOD) + lane; const f32x4* sc = (const f32x4*)(mod + (size_t)mi * NMOD + DM) + lane; const f32x4* wv = (const f32x4*)nw + lane;
#pragma unroll
            for (int j = 0; j < 8; ++j) { wf[j] = wv[64 * j] * (sc[64 * j] + 1.0f); sf[j] = sh[64 * j]; } }
        const float rstd = 1.0f / sqrtf(wave_sum(s) * (1.0f / DM) + RMS_EPS);
#pragma unroll
        for (int j = 0; j < 8; ++j) { const f32x4 a = v[j] * rstd * wf[j] + sf[j]; u32x2 w; w.x = pk2(a[0], a[1]); w.y = pk2(a[2], a[3]); *(u32x2*)(XN + kb64(MT, row, 256 * j + 4 * lane)) = w; }
    }
}
DI void norm_phase_b(const Frame& F, const bf16_t* XB, const float* nw, const float* mod, bf16_t* XN) {
    int tid_ = threadIdx.x; asm volatile("" : "+v"(tid_));
    const int lane = tid_ & 63, gw = F.bid * NWAVES + __builtin_amdgcn_readfirstlane(tid_ >> 6), NGW = F.G * NWAVES;
    f32x4 wf[8], sf[8]; int cur_mi = -1;
    for (int row = gw; row < MT; row += NGW) {
        const bf16_t* xr = XB + ((size_t)(lane >> 5) * MT + row) * YLD + 8 * (lane & 31);
        u32x4 t[4];
#pragma unroll
        for (int j = 0; j < 4; ++j) t[j] = *(const u32x4*)(xr + (size_t)(2 * j) * MT * YLD);
        f32x4 v[8]; float s = 0.f;
#pragma unroll
        for (int j = 0; j < 4; ++j) { v[2 * j] = (f32x4){bflo(t[j].x), bfhi(t[j].x), bflo(t[j].y), bfhi(t[j].y)}; v[2 * j + 1] = (f32x4){bflo(t[j].z), bfhi(t[j].z), bflo(t[j].w), bfhi(t[j].w)}; }
#pragma unroll
        for (int j = 0; j < 8; ++j) s += (v[j][0] * v[j][0] + v[j][1] * v[j][1]) + (v[j][2] * v[j][2] + v[j][3] * v[j][3]);
        const int mi = row < M_CTX ? 0 : 1 + ((row - M_CTX) >> 10);
        if (mi != cur_mi) { cur_mi = mi;
            const f32x4* sh = (const f32x4*)(mod + (size_t)mi * NMOD) + 2 * lane; const f32x4* sc = (const f32x4*)(mod + (size_t)mi * NMOD + DM) + 2 * lane; const f32x4* wv = (const f32x4*)nw + 2 * lane;
#pragma unroll
            for (int j = 0; j < 8; ++j) { const int o = 128 * (j >> 1) + (j & 1); wf[j] = wv[o] * (sc[o] + 1.0f); sf[j] = sh[o]; } }
        const float rstd = 1.0f / sqrtf(wave_sum(s) * (1.0f / DM) + RMS_EPS);
#pragma unroll
        for (int j = 0; j < 4; ++j) { const f32x4 a = v[2 * j] * rstd * wf[2 * j] + sf[2 * j], b = v[2 * j + 1] * rstd * wf[2 * j + 1] + sf[2 * j + 1];
            u32x4 w; w.x = pk2(a[0], a[1]); w.y = pk2(a[2], a[3]); w.z = pk2(b[0], b[1]); w.w = pk2(b[2], b[3]); *(u32x4*)(XN + kb64(MT, row, 512 * j + 8 * lane)) = w; }
    }
}
DI void final_norm_phase(const Frame& F, const bf16_t* XB, float* Xo, const float* nw) {
    int tid_ = threadIdx.x; asm volatile("" : "+v"(tid_));
    const int lane = tid_ & 63, gw = F.bid * NWAVES + __builtin_amdgcn_readfirstlane(tid_ >> 6), NGW = F.G * NWAVES;
    for (int row = gw; row < MT; row += NGW) {
        const bf16_t* xr = XB + ((size_t)(lane >> 5) * MT + row) * YLD + 8 * (lane & 31);
        u32x4 t[4];
#pragma unroll
        for (int j = 0; j < 4; ++j) t[j] = *(const u32x4*)(xr + (size_t)(2 * j) * MT * YLD);
        f32x4 v[8]; float s = 0.f;
#pragma unroll
        for (int j = 0; j < 4; ++j) { v[2 * j] = (f32x4){bflo(t[j].x), bfhi(t[j].x), bflo(t[j].y), bfhi(t[j].y)}; v[2 * j + 1] = (f32x4){bflo(t[j].z), bfhi(t[j].z), bflo(t[j].w), bfhi(t[j].w)}; }
#pragma unroll
        for (int j = 0; j < 8; ++j) s += (v[j][0] * v[j][0] + v[j][1] * v[j][1]) + (v[j][2] * v[j][2] + v[j][3] * v[j][3]);
        const float rstd = 1.0f / sqrtf(wave_sum(s) * (1.0f / DM) + RMS_EPS);
        const f32x4* wv = (const f32x4*)nw + 2 * lane; f32x4* yo = (f32x4*)(Xo + (size_t)row * DM) + 2 * lane;
#pragma unroll
        for (int j = 0; j < 8; ++j) { const int o = 128 * (j >> 1) + (j & 1); yo[o] = v[j] * rstd * wv[o]; }
    }
}
DI void seq_of_row(int row, int& t, int& L) { if (row < M_CTX) { t = row & 255; L = 256; } else { t = (row - M_CTX) & 1023; L = 1024; } }
DI void prep_phase(const Frame& F, int layer) {
    unsigned char* const ws_ = F.ws;
    const bf16_t* Y = (const bf16_t*)(ws_ + WS_BIG); const float* YS = (const float*)(ws_ + WS_YS);
    bf16_t* XBC = (bf16_t*)(ws_ + WS_XBC); float* DT = (float*)(ws_ + WS_DT); float* DTA = (float*)(ws_ + WS_DTA); bf16_t* LA = (bf16_t*)(ws_ + WS_LA); bf16_t* KR = (bf16_t*)(ws_ + WS_KR);
    int tid_ = threadIdx.x; asm volatile("" : "+v"(tid_));
    const int gt = F.bid * 512 + tid_, NT = F.G * 512;
    const float* cw = F.in[19] + (size_t)layer * 5 * 2048; const float* cb = F.in[20] + (size_t)layer * 2048;
    for (int it = gt; it < (MT / 8) * 256; it += NT) {
        const int r0 = (it >> 8) * 8, ch = (it & 255) * 8; int t0, L; seq_of_row(r0, t0, L);
        u32x4 xr[12];
#pragma unroll
        for (int j = 0; j < 12; ++j) { const int tt = t0 + j - 2; xr[j] = (u32x4){0u, 0u, 0u, 0u}; if (tt >= 0 && tt < L) xr[j] = *(const u32x4*)(Y + yaddr(r0 + j - 2, YC_XBC + ch)); }
        f32x4 w0[5], w1[5];
#pragma unroll
        for (int j = 0; j < 5; ++j) { w0[j] = *(const f32x4*)(cw + j * 2048 + ch); w1[j] = *(const f32x4*)(cw + j * 2048 + ch + 4); }
        const f32x4 b0 = *(const f32x4*)(cb + ch), b1 = *(const f32x4*)(cb + ch + 4);
#pragma unroll
        for (int i = 0; i < 8; ++i) {
            f32x4 a0 = b0, a1 = b1;
#pragma unroll
            for (int j = 0; j < 5; ++j) { const u32x4 xv = xr[i + j];
                a0 = a0 + w0[j] * (f32x4){bflo(xv.x), bfhi(xv.x), bflo(xv.y), bfhi(xv.y)}; a1 = a1 + w1[j] * (f32x4){bflo(xv.z), bfhi(xv.z), bflo(xv.w), bfhi(xv.w)}; }
            u32x4 o; o.x = pk2(fast_silu(a0[0]), fast_silu(a0[1])); o.y = pk2(fast_silu(a0[2]), fast_silu(a0[3])); o.z = pk2(fast_silu(a1[0]), fast_silu(a1[1])); o.w = pk2(fast_silu(a1[2]), fast_silu(a1[3]));
            *(u32x4*)(XBC + yaddr(r0 + i, ch)) = o;
        }
    }
    const float* dtb = F.in[21] + layer * 32; const float* alog = F.in[22] + layer * 32;
    for (int it = gt; it < MT * 32; it += NT) { const int i = it & 31; const float d = softplusf(YS[(size_t)(it >> 5) * 64 + 32 + i] + dtb[i]); DT[it] = d; DTA[it] = -__expf(alog[i]) * d; }
    const float* wup = F.in[16] + (size_t)layer * 2 * 16 * 512; const float* bup = F.in[17] + (size_t)layer * 2 * 512;
    for (int it = gt; it < (MT / 8) * 256; it += NT) {
        const int r0 = (it >> 8) * 8, dir = (it >> 7) & 1, j4 = (it & 127) * 4;
        f32x4 wu[16];
#pragma unroll
        for (int rr = 0; rr < 16; ++rr) wu[rr] = *(const f32x4*)(wup + (size_t)(dir * 16 + rr) * 512 + j4);
        const f32x4 bz = *(const f32x4*)(bup + dir * 512 + j4);
#pragma unroll
        for (int i = 0; i < 8; ++i) {
            const float* gd = YS + (size_t)(r0 + i) * 64 + dir * 16;
            const f32x4 g0 = *(const f32x4*)gd, g1 = *(const f32x4*)(gd + 4), g2 = *(const f32x4*)(gd + 8), g3 = *(const f32x4*)(gd + 12);
            f32x4 z = bz;
            z = z + g0[0] * wu[0] + g0[1] * wu[1] + g0[2] * wu[2] + g0[3] * wu[3]; z = z + g1[0] * wu[4] + g1[1] * wu[5] + g1[2] * wu[6] + g1[3] * wu[7];
            z = z + g2[0] * wu[8] + g2[1] * wu[9] + g2[2] * wu[10] + g2[3] * wu[11]; z = z + g3[0] * wu[12] + g3[1] * wu[13] + g3[2] * wu[14] + g3[3] * wu[15];
            u32x2 ow; ow.x = pk2(-softplusf(-z[0]) * (1.0f / 16.0f), -softplusf(-z[1]) * (1.0f / 16.0f)); ow.y = pk2(-softplusf(-z[2]) * (1.0f / 16.0f), -softplusf(-z[3]) * (1.0f / 16.0f));
            *(u32x2*)(LA + ((size_t)(dir * 4 + (j4 >> 7)) * MT + r0 + i) * 128 + (j4 & 127)) = ow;
        }
    }
    bf16_t* QR = (bf16_t*)(ws_ + WS_QR);
    for (int it = gt; it < M_LAT * 80; it += NT) {
        const int tl = it / 80, rem = it - tl * 80, hd = rem >> 3, half = (rem >> 2) & 1, i0 = (rem & 3) * 8;
        const int t = tl & 1023; const float pos = (float)(half ? (t & 63) : (t >> 6));
        const size_t src = yaddr(M_CTX + tl, (hd < 2 ? YC_AK + hd * 128 : YC_AQ + (hd - 2) * 128) + half * 64 + i0);
        const u32x4 xa = *(const u32x4*)(Y + src), xb = *(const u32x4*)(Y + src + 32);
        const unsigned a4[4] = {xa.x, xa.y, xa.z, xa.w}, b4[4] = {xb.x, xb.y, xb.z, xb.w}; unsigned oa[4], ob[4];
#pragma unroll
        for (int q = 0; q < 4; ++q) { float y1[2], y2[2];
#pragma unroll
            for (int e = 0; e < 2; ++e) { const int i = i0 + 2 * q + e; const float ang = pos * __builtin_amdgcn_exp2f(-(float)i * 0.41524101186092029f), cs = __cosf(ang), sn = __sinf(ang);
                const float x1 = e ? bfhi(a4[q]) : bflo(a4[q]), x2 = e ? bfhi(b4[q]) : bflo(b4[q]); y1[e] = x1 * cs - x2 * sn; y2[e] = x2 * cs + x1 * sn; }
            oa[q] = pk2(y1[0], y1[1]); ob[q] = pk2(y2[0], y2[1]); }
        bf16_t* dst = (hd < 2 ? KR + (size_t)tl * 256 + hd * 128 : QR + (size_t)tl * 1024 + (hd - 2) * 128) + half * 64 + i0;
        *(u32x4*)dst = (u32x4){oa[0], oa[1], oa[2], oa[3]}; *(u32x4*)(dst + 32) = (u32x4){ob[0], ob[1], ob[2], ob[3]};
    }
    for (int it = gt; it < M_CTX * 64; it += NT) { const int row = it >> 6, c8 = (it & 63) * 8, b = row >> 8, t = row & 255;
        const u32x4 xv = *(const u32x4*)(Y + yaddr(row, YC_AK + c8));
        float* o = F.out + (c8 < 256 ? OUT_CK : OUT_CV) + ((size_t)(b * 2 + layer) * 256 + t) * 256 + (c8 & 255);
        *(f32x4*)o = (f32x4){bflo(xv.x), bfhi(xv.x), bflo(xv.y), bfhi(xv.y)}; *(f32x4*)(o + 4) = (f32x4){bflo(xv.z), bfhi(xv.z), bflo(xv.w), bfhi(xv.w)}; }
}
DI void combine_phase(const Frame& F, int layer) {
    unsigned char* const ws_ = F.ws;
    const bf16_t* Y = (const bf16_t*)(ws_ + WS_BIG); const bf16_t* XBC = (const bf16_t*)(ws_ + WS_XBC);
    const bf16_t* OG = (const bf16_t*)(ws_ + WS_ODG); const bf16_t* OS = (const bf16_t*)(ws_ + WS_ODS); bf16_t* OC = (bf16_t*)(ws_ + WS_OCAT);
    const float* gnw = F.in[18] + layer * 256; const float* snw = F.in[24] + layer * 1024; const float* dsk = F.in[23] + layer * 16;
    int tid_ = threadIdx.x; asm volatile("" : "+v"(tid_));
    const int lane = tid_ & 63, gw = F.bid * NWAVES + __builtin_amdgcn_readfirstlane(tid_ >> 6), NGW = F.G * NWAVES, c0 = lane * 16;
    for (int row = gw; row < MT; row += NGW) {
        float o[16]; float ss = 0.f;
        { const u32x4 a0 = *(const u32x4*)(OG + yaddr(row, c0)), a1 = *(const u32x4*)(OG + yaddr(row, c0 + 8)), b0 = *(const u32x4*)(OG + (size_t)MT * 1024 + yaddr(row, c0)), b1 = *(const u32x4*)(OG + (size_t)MT * 1024 + yaddr(row, c0 + 8));
          const unsigned aa[8] = {a0.x, a0.y, a0.z, a0.w, a1.x, a1.y, a1.z, a1.w}, bb[8] = {b0.x, b0.y, b0.z, b0.w, b1.x, b1.y, b1.z, b1.w};
#pragma unroll
          for (int q = 0; q < 8; ++q) { o[2 * q] = bflo(aa[q]) + bflo(bb[q]); o[2 * q + 1] = bfhi(aa[q]) + bfhi(bb[q]); ss += o[2 * q] * o[2 * q] + o[2 * q + 1] * o[2 * q + 1]; } }
        ss += __shfl_xor(ss, 1); ss += __shfl_xor(ss, 2); ss += __shfl_xor(ss, 4); ss += __shfl_xor(ss, 8);
        float rstd = 1.0f / sqrtf(ss * (1.0f / 256.0f) + RMS_EPS);
        { const u32x4 g0 = *(const u32x4*)(Y + yaddr(row, YC_GR + c0)), g1 = *(const u32x4*)(Y + yaddr(row, YC_GR + c0 + 8));
          const unsigned gg[8] = {g0.x, g0.y, g0.z, g0.w, g1.x, g1.y, g1.z, g1.w}; unsigned ow[8];
          const f32x4* gw4 = (const f32x4*)(gnw + (c0 & 255)); const f32x4 n0 = gw4[0], n1 = gw4[1], n2 = gw4[2], n3 = gw4[3]; const float gn[16] = {n0[0], n0[1], n0[2], n0[3], n1[0], n1[1], n1[2], n1[3], n2[0], n2[1], n2[2], n2[3], n3[0], n3[1], n3[2], n3[3]};
#pragma unroll
          for (int q = 0; q < 8; ++q) ow[q] = pk2(o[2 * q] * rstd * gn[2 * q] * fast_silu(bflo(gg[q])), o[2 * q + 1] * rstd * gn[2 * q + 1] * fast_silu(bfhi(gg[q])));
          *(u32x4*)(OC + kb64(MT, row, c0)) = (u32x4){ow[0], ow[1], ow[2], ow[3]}; *(u32x4*)(OC + kb64(MT, row, c0 + 8)) = (u32x4){ow[4], ow[5], ow[6], ow[7]}; }
        ss = 0.f; const float dk = dsk[lane >> 2];
        { const u32x4 x0 = *(const u32x4*)(XBC + yaddr(row, c0)), x1 = *(const u32x4*)(XBC + yaddr(row, c0 + 8));
          const u32x4 z0 = *(const u32x4*)(Y + yaddr(row, YC_SZ + c0)), z1 = *(const u32x4*)(Y + yaddr(row, YC_SZ + c0 + 8));
          const unsigned xx[8] = {x0.x, x0.y, x0.z, x0.w, x1.x, x1.y, x1.z, x1.w}, zz[8] = {z0.x, z0.y, z0.z, z0.w, z1.x, z1.y, z1.z, z1.w};
          const u32x4 a0 = *(const u32x4*)(OS + yaddr(row, c0)), a1 = *(const u32x4*)(OS + yaddr(row, c0 + 8)), b0 = *(const u32x4*)(OS + (size_t)MT * 1024 + yaddr(row, c0)), b1 = *(const u32x4*)(OS + (size_t)MT * 1024 + yaddr(row, c0 + 8));
          const unsigned aa[8] = {a0.x, a0.y, a0.z, a0.w, a1.x, a1.y, a1.z, a1.w}, bb[8] = {b0.x, b0.y, b0.z, b0.w, b1.x, b1.y, b1.z, b1.w};
#pragma unroll
          for (int e = 0; e < 16; ++e) { const unsigned xw = xx[e >> 1], zw = zz[e >> 1], aw = aa[e >> 1], bw = bb[e >> 1];
              const float xf = (e & 1) ? bfhi(xw) : bflo(xw), zf = (e & 1) ? bfhi(zw) : bflo(zw), af = (e & 1) ? bfhi(aw) : bflo(aw), bf = (e & 1) ? bfhi(bw) : bflo(bw);
              const float y = (af + bf + dk * xf) * fast_silu(zf); o[e] = y; ss += y * y; } }
        rstd = 1.0f / sqrtf(wave_sum(ss) * (1.0f / 1024.0f) + RMS_EPS);
        { unsigned ow[8];
          const f32x4* sw4 = (const f32x4*)(snw + c0); const f32x4 n0 = sw4[0], n1 = sw4[1], n2 = sw4[2], n3 = sw4[3]; const float sn[16] = {n0[0], n0[1], n0[2], n0[3], n1[0], n1[1], n1[2], n1[3], n2[0], n2[1], n2[2], n2[3], n3[0], n3[1], n3[2], n3[3]};
#pragma unroll
          for (int q = 0; q < 8; ++q) ow[q] = pk2(o[2 * q] * rstd * sn[2 * q], o[2 * q + 1] * rstd * sn[2 * q + 1]);
          *(u32x4*)(OC + kb64(MT, row, 1024 + c0)) = (u32x4){ow[0], ow[1], ow[2], ow[3]}; *(u32x4*)(OC + kb64(MT, row, 1024 + c0 + 8)) = (u32x4){ow[4], ow[5], ow[6], ow[7]}; }
    }
}

DI void msum_phase(const Frame& F) {
    unsigned char* const ws_ = F.ws;
    int tid_ = threadIdx.x; asm volatile("" : "+v"(tid_));
    const bf16_t* PB = (const bf16_t*)(ws_ + WS_ODG); bf16_t* Mb = (bf16_t*)(ws_ + WS_XBC);
    const int gt = F.bid * 512 + tid_, NT = F.G * 512;
    for (int it0 = gt; it0 < MT * DM / 8; it0 += 4 * NT) {
        u32x4 a[4], b[4], c[4];
#pragma unroll
        for (int q = 0; q < 4; ++q) { const int it = it0 + q * NT; if (it < MT * DM / 8) { a[q] = *(const u32x4*)(PB + (size_t)it * 8); b[q] = *(const u32x4*)(PB + (size_t)MT * DM + (size_t)it * 8); c[q] = *(const u32x4*)(PB + (size_t)2 * MT * DM + (size_t)it * 8); } }
#pragma unroll
        for (int q = 0; q < 4; ++q) { const int it = it0 + q * NT; if (it < MT * DM / 8) {
            u32x4 o;
            o.x = pk2(bflo(a[q].x) + bflo(b[q].x) + bflo(c[q].x), bfhi(a[q].x) + bfhi(b[q].x) + bfhi(c[q].x)); o.y = pk2(bflo(a[q].y) + bflo(b[q].y) + bflo(c[q].y), bfhi(a[q].y) + bfhi(b[q].y) + bfhi(c[q].y));
            o.z = pk2(bflo(a[q].z) + bflo(b[q].z) + bflo(c[q].z), bfhi(a[q].z) + bfhi(b[q].z) + bfhi(c[q].z)); o.w = pk2(bflo(a[q].w) + bflo(b[q].w) + bflo(c[q].w), bfhi(a[q].w) + bfhi(b[q].w) + bfhi(c[q].w));
            *(u32x4*)(Mb + kb64(MT, (it >> 5) % MT, (it / (32 * MT)) * 256 + (it & 31) * 8)) = o; } }
    }
}

DI void transpose_item(const float* W, int K, int N, bf16_t* WT, int NR, int k0, int n0, int dst0, LAS float* scr, int lane) {
#pragma unroll 8
    for (int i = 0; i < 32; ++i) { const int kk = 2 * i + (lane >> 5); scr[kk * 33 + (lane & 31)] = W[(size_t)(k0 + kk) * N + n0 + (lane & 31)]; }
    LDS_WAIT(); asm volatile("" ::: "memory");
    const int c = lane & 7;
#pragma unroll
    for (int j = 0; j < 4; ++j) { const int n = (lane >> 3) + 8 * j; const LAS float* s = scr + (8 * c) * 33 + n;
        u32x4 o; o.x = pk2(s[0 * 33], s[1 * 33]); o.y = pk2(s[2 * 33], s[3 * 33]); o.z = pk2(s[4 * 33], s[5 * 33]); o.w = pk2(s[6 * 33], s[7 * 33]);
        *(u32x4*)(WT + ((size_t)(k0 >> 6) * NR + dst0 + n) * 64 + 8 * c) = o; }
    LDS_WAIT(); asm volatile("" ::: "memory");
}
DI int win_dst(int n) { return n < 3072 ? n : (n < 3104 ? YC_GD + (n - 3072) : (n < 6176 ? n - 32 : (n < 6208 ? YC_DT + (n - 6176) : n - 64))); }
DI void prologue_phase(const Frame& F, LAS unsigned char* lds) {
    unsigned char* const ws_ = F.ws;
    int tid_ = threadIdx.x; asm volatile("" : "+v"(tid_));
    const int tid = tid_, lane = tid & 63, wave = __builtin_amdgcn_readfirstlane(tid >> 6);
    {
        LAS float* sv = (LAS float*)lds;
        LAS float* red = (LAS float*)(lds + 24576);
        for (int i = tid; i < 3 * 2048; i += 512) { const int mi = i >> 11, k = i & 2047; const float x = mi == 0 ? F.in[7][k] : F.in[2][(mi - 1) * 2048 + k]; sv[i] = x / (1.0f + __expf(-x)); }
        __syncthreads();
        float* MOD = (float*)(ws_ + WS_MOD);
        const int tx = tid & 15, ty = tid >> 4;
        for (int it = F.bid; it < 2 * 288; it += F.G) {
            const int l = it / 288, cb = it % 288;
            const float* wp = F.in[8] + ((size_t)l * 2048 + 64 * ty) * NMOD + 64 * cb + 4 * tx;
            f32x4 a0 = {0.f, 0.f, 0.f, 0.f}, a1 = a0, a2 = a0;
#pragma unroll 8
            for (int k = 0; k < 64; ++k) { const f32x4 wv = *(const f32x4*)(wp + (size_t)k * NMOD); const int kk = 64 * ty + k;
                a0 = a0 + sv[kk] * wv; a1 = a1 + sv[2048 + kk] * wv; a2 = a2 + sv[4096 + kk] * wv; }
            *(LAS f32x4*)(red + (ty * 3 + 0) * 64 + 4 * tx) = a0; *(LAS f32x4*)(red + (ty * 3 + 1) * 64 + 4 * tx) = a1; *(LAS f32x4*)(red + (ty * 3 + 2) * 64 + 4 * tx) = a2;
            __syncthreads();
            if (tid < 192) { const int mi = tid >> 6, col = tid & 63; float s = 0.f;
#pragma unroll 8
                for (int y = 0; y < 32; ++y) s += red[(y * 3 + mi) * 64 + col];
                MOD[((size_t)l * 3 + mi) * NMOD + 64 * cb + col] = s + F.in[9][(size_t)l * NMOD + 64 * cb + col]; }
            __syncthreads();
        }
    }
    {
        LAS float* scr = (LAS float*)(lds + wave * 8448);
        const int gw = F.bid * NWAVES + wave, NGW = F.G * NWAVES;
        constexpr int PER_L = 52800;
        for (int it = gw; it < 2 * PER_L; it += NGW) {
            const int l = it / PER_L; int r = it - l * PER_L;
            if (r < 33792) { const int mi = r / 5632, rr = r - mi * 5632;
                if (mi < 4) { const int f = mi >> 1, up = mi & 1; const float* W = F.in[f ? (up ? 32 : 31) : (up ? 12 : 11)] + (size_t)l * DM * FF;
                    const int kb = rr / 176, nb = rr - kb * 176, n0 = 32 * nb;
                    transpose_item(W, DM, FF, (bf16_t*)(ws_ + WS_WGU + (size_t)(l * 2 + f) * SZ_WGU), NGU, 64 * kb, n0, 256 * (n0 >> 7) + 128 * up + (n0 & 127), scr, lane); }
                else { const int f = mi - 4; const float* W = F.in[f ? 33 : 13] + (size_t)l * FF * DM; const int kb = rr >> 6, nb = rr & 63;
                    transpose_item(W, FF, DM, (bf16_t*)(ws_ + WS_WD + (size_t)(l * 2 + f) * SZ_WD), DM, 64 * kb, 32 * nb, 32 * nb, scr, lane); }
                continue; }
            r -= 33792;
            if (r < 13888) { const int kb = r / 434, nb = r - kb * 434; transpose_item(F.in[15] + (size_t)l * DM * D_IN, DM, D_IN, (bf16_t*)(ws_ + WS_WIN + (size_t)l * SZ_WIN), NY, 64 * kb, 32 * nb, win_dst(32 * nb), scr, lane); continue; }
            r -= 13888;
            if (r < 3072) { const int i = r >> 10, rr = r & 1023, kb = rr >> 6, nb = rr & 63;
                transpose_item(F.in[26 + i] + (size_t)l * 1024 * DM, 1024, DM, (bf16_t*)(ws_ + WS_WBR + (size_t)(l * 3 + i) * SZ_WBR), DM, 64 * kb, 32 * nb, 32 * nb, scr, lane); continue; }
            r -= 3072;
            { const int kb = r >> 6, nb = r & 63; transpose_item(F.in[29] + (size_t)l * DM * DM, DM, DM, (bf16_t*)(ws_ + WS_WOUT + (size_t)l * SZ_WOUT), DM, 64 * kb, 32 * nb, 32 * nb, scr, lane); }
        }
    }
    const int gt = F.bid * 512 + tid, NTT = F.G * 512;
    for (int it = gt; it < 2 * 192 * 256; it += NTT) { const int l = it / (192 * 256), r = it - l * (192 * 256);
        *(u32x4*)(ws_ + WS_WIN + (size_t)l * SZ_WIN + kb64(NY, D_IN + (r >> 8), (r & 255) * 8) * 2) = (u32x4){0u, 0u, 0u, 0u}; }
    for (int it = gt; it < 2 * 65536; it += NTT) { const int which = it >> 16, r = it & 65535, l = r >> 15, b = (r >> 14) & 1, e = (r & 16383) * 8;
        const float* src = F.in[3 + which] + ((size_t)(b * 2 + l) * 512 * 256) + e;
        const f32x4 v0 = *(const f32x4*)src, v1 = *(const f32x4*)(src + 4);
        u32x4 o; o.x = pk2(v0[0], v0[1]); o.y = pk2(v0[2], v0[3]); o.z = pk2(v1[0], v1[1]); o.w = pk2(v1[2], v1[3]);
        *(u32x4*)(ws_ + (which ? WS_CVB : WS_CKB) + ((size_t)(l * 2 + b) * 512 * 256 + e) * 2) = o; }
}

struct UTiles { const bf16_t* k1; const bf16_t* v1; int ld1, n1; const bf16_t* k2; const bf16_t* v2; int dpos2;
    DI att::Tile operator()(int j) const { att::Tile t;
        if (j < n1) { t.k = k1 + (size_t)j * 64 * ld1; t.v = v1 + (size_t)j * 64 * ld1; t.ldk = ld1; t.ldv = ld1; t.dpos = 0; t.masked = 0; }
        else { const int s = 64 * (j - n1); t.k = k2 + (size_t)s * 256; t.v = v2 + (size_t)s * YLD; t.ldk = 256; t.ldv = YLD; t.dpos = dpos2 + s; t.masked = 1; }
        return t; } };
DI int q_next(unsigned* ctr, volatile LAS int* slot) {
    __syncthreads();
    if (threadIdx.x == 0) *slot = (int)__hip_atomic_fetch_add(ctr, 1u, RLX_AGENT);
    __syncthreads();
    return *slot;
}
DI void mixer_phase(const Frame& F, unsigned char* lds_g, int layer_q) {
    unsigned char* const ws_ = F.ws;
    const int layer = layer_q & 1;
    LAS unsigned char* lds = (LAS unsigned char*)lds_g;
    volatile LAS int* slot = (volatile LAS int*)(lds + MISC_OFF + 64);
    unsigned* qc = (unsigned*)(ws_ + WS_CTL) + CW_Q + layer_q * 3 * 64;
    const bf16_t* Y = (const bf16_t*)(ws_ + WS_BIG); bf16_t* OC = (bf16_t*)(ws_ + WS_OCAT);
    const float* sinkp = F.in[25] + layer * 8;
    for (;;) {
        const int qi = q_next(qc, slot); if (qi >= 880) break;
        if (qi < 16 || (qi >= 112 && qi < 368)) gla_chain(F, lds, qi < 16 ? qi : qi - 112 + 16, layer);
        else if (qi < 48) ssd_chain(F, lds, (qi - 16) >> 1, layer, (qi - 16) & 1);
        else if (qi >= 368 && qi < 624) ssd_chain(F, lds, qi - 368 + 16, layer, -1);
        else {
            const int it = qi < 112 ? qi - 48 : qi - 624 + 64;
            UTiles ts; int row0, hq, NT, ldq; const bf16_t* Qp;
            if (it < 64) { const int b = it >> 5, qb = it & 3; hq = (it >> 2) & 7; const int kvh = hq >> 2;
                row0 = M_CTX + b * 1024 + qb * 256; const int s0 = qb == 0 ? 0 : 256 * qb - 128, s1 = qb == 3 ? 1024 : 256 * qb + 384;
                ts.k1 = (const bf16_t*)(ws_ + WS_CKB) + (size_t)(layer * 2 + b) * 512 * 256 + kvh * 128; ts.v1 = (const bf16_t*)(ws_ + WS_CVB) + (size_t)(layer * 2 + b) * 512 * 256 + kvh * 128; ts.ld1 = 256; ts.n1 = 8;
                ts.k2 = (const bf16_t*)(ws_ + WS_KR) + (size_t)(b * 1024 + s0) * 256 + kvh * 128; ts.v2 = Y + yaddr(M_CTX + b * 1024 + s0, YC_AV + kvh * 128); ts.dpos2 = s0 - qb * 256;
                NT = 8 + (s1 - s0) / 64; Qp = (const bf16_t*)(ws_ + WS_QR) + (size_t)(b * 1024 + qb * 256) * 1024 + hq * 128; ldq = 1024;
            } else { const int u = it - 64, b = u >> 3; hq = u & 7; const int kvh = hq >> 2; row0 = b * 256;
                ts.k1 = Y + yaddr(row0, YC_AK + kvh * 128); ts.v1 = Y + yaddr(row0, YC_AV + kvh * 128); ts.ld1 = YLD; ts.n1 = 4; ts.k2 = ts.k1; ts.v2 = ts.v1; ts.dpos2 = 0;
                NT = 4; Qp = Y + yaddr(row0, YC_AQ + hq * 128); ldq = YLD; }
            att::attn_unit(Qp, ldq, ts, NT, sinkp[hq], OC + kb64(MT, row0, 2048 + hq * 128), 64, (char*)lds_g);
        }
    }

}

#ifndef SITE_MASK
#define SITE_MASK 1023
#endif

constexpr int N_PH = 56;
struct Args { const float* in[35]; float* out; unsigned char* ws; int ph_lo, ph_hi; };
static_assert(sizeof(Args) == 37 * 8 + 8, "Args has no padding");
__global__ void __launch_bounds__(NWAVES * 64, 2) trunk_fwd(Args args) {
    extern __shared__ __attribute__((aligned(16))) unsigned char lds[];
    LAS unsigned char* L = (LAS unsigned char*)lds;
    Frame F; F.ws = args.ws; F.out = args.out; F.in = args.in;
    F.G = gridDim.x; F.bid = blockIdx.x;
    const int lo = args.ph_lo, hi = args.ph_hi;
    for (int u = threadIdx.x; u < (LDS_BYTES - RING_BYTES) / 4; u += NWAVES * 64) ((LAS unsigned*)(L + RING_BYTES))[u] = 0u;
    __syncthreads();
    XcdBarrier bar; bar.bar = (unsigned*)(F.ws + WS_CTL) + CW_BAR; bar.x = 0; bar.st = nullptr;
    if (hi - lo > 1) bar = xcd_barrier_post((unsigned*)(F.ws + WS_CTL) + CW_BAR, (volatile LAS unsigned*)(L + MISC_OFF) + 8);
#define RUN(p) (lo <= (p) && (p) < hi)
#define SEAM(p) do { if ((p) + 1 < hi) xcd_barrier(bar); } while (0)
    bf16_t* X = (bf16_t*)(F.ws + WS_XB);
    float* MOD = (float*)(F.ws + WS_MOD);
    bf16_t* XN = (bf16_t*)(F.ws + WS_XN); bf16_t* Y = (bf16_t*)(F.ws + WS_BIG); bf16_t* H = (bf16_t*)(F.ws + WS_BIG);
    bf16_t* Mb = (bf16_t*)(F.ws + WS_XBC); bf16_t* OC = (bf16_t*)(F.ws + WS_OCAT);

    #if SITE_MASK & 1
    if (RUN(0)) { for (int rep = 0; rep < NREP(1); ++rep) { prologue_phase(F, L); SEAM(0); } }
#endif
    for (int step = 0; step < 6; ++step) {
        const int l = step / 3, sb = step - 3 * l, pid = 1 + 9 * step;
        const bool ffn = sb != 1; const int f = sb >> 1;
        const float* modl = MOD + (size_t)l * 3 * NMOD + (size_t)sb * 3 * DM;
#if SITE_MASK & 2
        if (RUN(pid + 0)) { const float* nw = F.in[sb == 0 ? 10 : (sb == 1 ? 14 : 30)] + (size_t)l * DM; for (int rep = 0; rep < NREP(2); ++rep) { if (step == 0) norm_phase(F, F.in[0], F.in[1] - (size_t)M_CTX * DM, nw, modl, XN); else norm_phase_b(F, X, nw, modl, XN); SEAM(pid + 0); } }
#endif
        if (ffn) {
#if SITE_MASK & 4
            if (RUN(pid + 1)) {
                pg8::Prob P; P.A = (const char*)XN; P.Bt = (const char*)(F.ws + WS_WGU + (size_t)(l * 2 + f) * SZ_WGU); P.lda = 64; P.ldb = 64; P.kstepA = (size_t)MT * 128; P.kstepB = (size_t)NGU * 128; P.nM = MT / 256; P.nN = NGU / 256; P.ntk = DM / 64; P.nseg = 1; P.a_seg = 0; P.b_seg = 0; P.G = F.G; { const int b_ = opaque_s(F.bid); P.c = XCD_CONTIG ? ((b_ & 31) * 8 + (b_ >> 5)) : b_; }
                EpiSwiGLU E{H}; for (int rep = 0; rep < NREP(4); ++rep) { pg8::gemm_phase(L, P, E); SEAM(pid + 1); } }
#endif
        } else {
#if SITE_MASK & 8
            if (RUN(pid + 2)) {
                pg8::Prob P; P.A = (const char*)XN; P.Bt = (const char*)(F.ws + WS_WIN + (size_t)l * SZ_WIN); P.lda = 64; P.ldb = 64; P.kstepA = (size_t)MT * 128; P.kstepB = (size_t)NY * 128; P.nM = MT / 256; P.nN = NY / 256; P.ntk = DM / 64; P.nseg = 1; P.a_seg = 0; P.b_seg = 0; P.G = F.G; { const int b_ = opaque_s(F.bid); P.c = XCD_CONTIG ? ((b_ & 31) * 8 + (b_ >> 5)) : b_; }
                EpiY E{Y, (float*)(F.ws + WS_YS)}; for (int rep = 0; rep < NREP(8); ++rep) { pg8::gemm_phase(L, P, E); SEAM(pid + 2); } }
#endif
#if SITE_MASK & 16
            if (RUN(pid + 3)) { for (int rep = 0; rep < NREP(16); ++rep) { prep_phase(F, l); SEAM(pid + 3); } }
#endif
#if SITE_MASK & 32
            if (RUN(pid + 4)) { for (int rep = 0; rep < NREP(32); ++rep) { mixer_phase(F, lds, l + 2 * rep); SEAM(pid + 4); } }
#endif
#if SITE_MASK & 64
            if (RUN(pid + 5)) { for (int rep = 0; rep < NREP(64); ++rep) { combine_phase(F, l); SEAM(pid + 5); } }
#endif
#if SITE_MASK & 128
            if (RUN(pid + 6)) {
                pg8::Prob P; P.A = (const char*)OC; P.Bt = (const char*)(F.ws + WS_WBR + (size_t)l * 3 * SZ_WBR); P.lda = 64; P.ldb = 64; P.kstepA = (size_t)MT * 128; P.kstepB = (size_t)DM * 128; P.nM = MT / 256; P.nN = DM / 256; P.ntk = 1024 / 64; P.nseg = 3; P.a_seg = (size_t)16 * MT * 128; P.b_seg = SZ_WBR; P.G = F.G; { const int b_ = opaque_s(F.bid); P.c = XCD_CONTIG ? ((b_ & 31) * 8 + (b_ >> 5)) : b_; }
                EpiBranch E{Y, (bf16_t*)(F.ws + WS_ODG)}; for (int rep = 0; rep < NREP(128); ++rep) { pg8::gemm_phase(L, P, E); SEAM(pid + 6); } }
            if (RUN(pid + 7)) { msum_phase(F); SEAM(pid + 7); }
#endif
        }
#if SITE_MASK & 256
        if (RUN(pid + 8)) {
            pg8::ProbSK P; P.G = F.G; { const int b_ = opaque_s(F.bid); P.vc = (F.G & 7) ? b_ : (b_ & 7) * (F.G >> 3) + (b_ >> 3); }
            if (ffn) { P.A = (const char*)H; P.Bt = (const char*)(F.ws + WS_WD + (size_t)(l * 2 + f) * SZ_WD); P.q4 = FF / 64 / 4; }
            else { P.A = (const char*)Mb; P.Bt = (const char*)(F.ws + WS_WOUT + (size_t)l * SZ_WOUT); P.q4 = DM / 64 / 4; }
            P.lda = 64; P.ldb = 64; P.kstepA = (size_t)MT * 128; P.kstepB = (size_t)DM * 128;
            P.slab = (const float*)(F.ws + WS_SLAB);
            for (int rep = 0; rep < NREP(256); ++rep) {
                P.flags = (unsigned*)(F.ws + WS_CTL) + CW_SK + (step + 6 * rep) * 256 * 64;
                if (step == 0 && rep == 0) { EpiSK<EpiResid<true>> E{EpiResid<true>{X, modl + 2 * DM, 0.5f, F.in[0], F.in[1] - (size_t)M_CTX * DM}, (float*)(F.ws + WS_SLAB), P.flags}; pg8::gemm_phase(L, P, E); }
                else { EpiSK<EpiResid<false>> E{EpiResid<false>{X, modl + 2 * DM, rep ? 0.0f : (ffn ? 0.5f : 1.0f), nullptr, nullptr}, (float*)(F.ws + WS_SLAB), P.flags}; pg8::gemm_phase(L, P, E); }
                SEAM(pid + 8); } }
#endif
    }
#if SITE_MASK & 512
    if (RUN(55)) final_norm_phase(F, X, F.out, F.in[34]);
#endif
#undef RUN
#undef SEAM
}

#ifndef MK_PER_PHASE
#define MK_PER_PHASE 0
#endif
extern "C" void kernel_launch(void* const* d_in, const int* in_sizes, int n_in, void* d_out, int out_size, void* d_ws, size_t ws_size, hipStream_t stream) {
    static int grid = 0;
    if (grid == 0) {
        if (n_in != 35 || out_size != (int)OUT_TOTAL || ws_size < WS_END) { fprintf(stderr, "kernel_launch: unexpected shapes: n_in %d out %d ws %zu (need %zu)\n", n_in, out_size, ws_size, (size_t)WS_END); grid = -1; return; }
        int dev = 0, cus = 0, per_cu = 0;
        if (hipGetDevice(&dev) != hipSuccess || hipDeviceGetAttribute(&cus, hipDeviceAttributeMultiprocessorCount, dev) != hipSuccess) { grid = -1; return; }
        if (hipFuncSetAttribute((const void*)trunk_fwd, hipFuncAttributeMaxDynamicSharedMemorySize, LDS_BYTES) != hipSuccess) { fprintf(stderr, "kernel_launch: hipFuncSetAttribute failed\n"); grid = -1; return; }
        if (hipOccupancyMaxActiveBlocksPerMultiprocessor(&per_cu, (const void*)trunk_fwd, NWAVES * 64, LDS_BYTES) != hipSuccess || per_cu < 1) { fprintf(stderr, "kernel_launch: occupancy query says %d blocks per CU\n", per_cu); }
        (void)hipGetLastError();
        grid = cus;
    }
    if (grid < 0) return;
    (void)hipMemsetAsync((char*)d_ws + WS_CTL, 0, CTL_ZERO_BYTES, stream);
    Args a{};
    for (int i = 0; i < 35; ++i) a.in[i] = (const float*)d_in[i];
    a.out = (float*)d_out; a.ws = (unsigned char*)d_ws;
#if MK_PER_PHASE
    for (int p = 0; p < N_PH; ++p) {
        if (p >= 1 && p <= 54) { const int step = (p - 1) / 9, site = (p - 1) % 9; const bool ffn = (step % 3) != 1;
            if (site == 1 && !ffn) continue; if (site >= 2 && site <= 7 && ffn) continue; }
        a.ph_lo = p; a.ph_hi = p + 1;
        hipLaunchKernelGGL(trunk_fwd, dim3(grid), dim3(NWAVES * 64), LDS_BYTES, stream, a);
    }
#else
    a.ph_lo = 0; a.ph_hi = N_PH;
    hipLaunchKernelGGL(trunk_fwd, dim3(grid), dim3(NWAVES * 64), LDS_BYTES, stream, a);
#endif
    const hipError_t le = hipPeekAtLastError();
    if (le != hipSuccess) fprintf(stderr, "kernel_launch: launch failed: %s\n", hipGetErrorName(le));
}
```

```cpp
#include <hip/hip_runtime.h>
#include <cstdio>
#include <cstdint>

#ifndef MIX_MASK
#define MIX_MASK 7
#endif
#ifndef PG8_ALIGN
#define PG8_ALIGN 1
#endif
#ifndef XCD_CONTIG
#define XCD_CONTIG 0
#endif
#ifdef PROBE_DUP_OVERRIDE
#define PROBE_DUP PROBE_DUP_OVERRIDE
#endif
#ifndef PROBE_DUP
#define PROBE_DUP 0
#endif
#define NREP(bit) ((PROBE_DUP & (bit)) ? 2 : 1)
#define GAS __attribute__((address_space(1)))
#define LAS __attribute__((address_space(3)))
#define DI __device__ __forceinline__
typedef unsigned short bf16_t;
typedef short bf16x8 __attribute__((ext_vector_type(8)));
typedef short s16x4 __attribute__((ext_vector_type(4)));
typedef float f32x4 __attribute__((ext_vector_type(4)));
typedef float f32x2 __attribute__((ext_vector_type(2)));
typedef float f32x8 __attribute__((ext_vector_type(8)));
typedef float f32x16 __attribute__((ext_vector_type(16)));
typedef unsigned u32x4 __attribute__((ext_vector_type(4)));
typedef unsigned u32x2 __attribute__((ext_vector_type(2)));
typedef __bf16 bf16x2_t __attribute__((ext_vector_type(2)));
typedef GAS unsigned gu32;

constexpr int DM = 2048, FF = 5632, NMOD = 9 * DM;
constexpr int M_CTX = 8192, M_LAT = 2048, MT = 10240;
constexpr int NGU = 2 * FF;
constexpr int D_IN = 13888, NY = 14080;
constexpr int YC_GQ = 0, YC_GK = 512, YC_GV = 1024, YC_GR = 2048, YC_SZ = 3072, YC_XBC = 4096, YC_AQ = 6144, YC_AK = 7168, YC_AV = 7424, YC_BR = 7680, YC_GD = 13824, YC_DT = 13856;
constexpr float RMS_EPS = 1e-6f;

constexpr size_t OUT_YP = 0, OUT_YS = 16777216, OUT_CK = 20971520, OUT_CV = 25165824, OUT_GLA = 29360128, OUT_SSM = 46137344, OUT_TOTAL = 62914560;

constexpr size_t MiB = 1u << 20;
constexpr size_t WS_CTL = 0, CTL_ZERO_BYTES = 2 * MiB;
constexpr size_t WS_MOD = 2 * MiB;
constexpr size_t WS_DT = 3 * MiB;
constexpr size_t WS_DTA = WS_DT + (size_t)MT * 32 * 4;
constexpr size_t WS_YS = 6 * MiB;
constexpr size_t WS_CKB = 9 * MiB;
constexpr size_t WS_CVB = 10 * MiB;
constexpr size_t WS_KR = 11 * MiB;
constexpr size_t WS_WGU = 12 * MiB;
constexpr size_t SZ_WGU = (size_t)NGU * DM * 2;
constexpr size_t WS_WD = WS_WGU + 4 * SZ_WGU;
constexpr size_t SZ_WD = (size_t)DM * FF * 2;
constexpr size_t WS_WIN = WS_WD + 4 * SZ_WD;
constexpr size_t SZ_WIN = (size_t)NY * DM * 2;
constexpr size_t WS_WBR = WS_WIN + 2 * SZ_WIN;
constexpr size_t SZ_WBR = (size_t)DM * 1024 * 2;
constexpr size_t WS_WOUT = WS_WBR + 6 * SZ_WBR;
constexpr size_t SZ_WOUT = (size_t)DM * DM * 2;
constexpr size_t WS_XN = WS_WOUT + 2 * SZ_WOUT;
constexpr size_t WS_BIG = WS_XN + (size_t)MT * DM * 2;
constexpr size_t WS_XBC = WS_BIG + (size_t)MT * NY * 2;
constexpr size_t WS_LA = WS_XBC + (size_t)MT * 2048 * 2;
constexpr size_t WS_ODG = WS_LA + (size_t)MT * 1024 * 4;
constexpr size_t WS_ODS = WS_ODG + (size_t)2 * MT * 1024 * 4;
constexpr size_t WS_XB = WS_ODS + (size_t)2 * MT * 1024 * 2;
constexpr size_t WS_OCAT = WS_ODS + (size_t)2 * MT * 1024 * 4;
constexpr size_t WS_QR = WS_OCAT + (size_t)MT * 3072 * 2;
constexpr size_t WS_SLAB = WS_QR + (size_t)M_LAT * 1024 * 2;
constexpr size_t WS_END = WS_SLAB + (size_t)256 * 65536 * 4;
static_assert(WS_WGU % 256 == 0 && WS_XN % 256 == 0 && WS_BIG % 256 == 0 && WS_OCAT % 256 == 0, "ws alignment");
constexpr int CW_BAR = 4096;
constexpr int CW_Q = 16384;
constexpr int CW_SK = 32768;

constexpr int RING_BYTES = 131072;
constexpr int MISC_OFF = RING_BYTES + 320;
constexpr int LDS_BYTES = 147456;
constexpr int NWAVES = 8;

DI unsigned pk2(float lo, float hi) { f32x2 v = {lo, hi}; bf16x2_t b = __builtin_convertvector(v, bf16x2_t); return __builtin_bit_cast(unsigned, b); }
DI float bflo(unsigned u) { return __uint_as_float(u << 16); }
DI float bfhi(unsigned u) { return __uint_as_float(u & 0xffff0000u); }
DI float bf2f(unsigned short s) { return __uint_as_float(((unsigned)s) << 16); }
DI float bf2f_s(short s) { return __uint_as_float(((unsigned)(unsigned short)s) << 16); }
DI unsigned short f2bf(float f) { return (unsigned short)(pk2(f, 0.f) & 0xffffu); }
DI float wave_sum(float v) {
#pragma unroll
    for (int o = 1; o < 64; o <<= 1) v += __shfl_xor(v, o);
    return v;
}
DI float fast_exp(float x) { return __builtin_amdgcn_exp2f(x * 1.4426950408889634f); }
DI float fast_sigmoid(float x) { return __builtin_amdgcn_rcpf(1.0f + fast_exp(-x)); }
DI float fast_silu(float x) { return x * fast_sigmoid(x); }
DI float softplusf(float x) { return fmaxf(x, 0.f) + __logf(1.0f + __expf(-fabsf(x))); }
DI size_t kb64(int rows, int row, int k) { return ((size_t)(k >> 6) * rows + row) * 64 + (k & 63); }
constexpr int YLD = 256;
DI size_t yaddr(int row, int col) { return ((size_t)(col >> 8) * MT + row) * YLD + (col & 255); }
DI int opaque_s(int x) { asm volatile("" : "+s"(x)); return x; }
DI int crow(int r, int hi) { return (r & 3) + 8 * (r >> 2) + 4 * hi; }
#define LDS_WAIT() asm volatile("s_waitcnt lgkmcnt(0)" ::: "memory")
#define VM_WAIT() asm volatile("s_waitcnt vmcnt(0)" ::: "memory")
#define RLX_AGENT __ATOMIC_RELAXED, __HIP_MEMORY_SCOPE_AGENT

namespace pg8 {
constexpr int BM = 256, BK = 64, HALF = 128, HTB = HALF * BK * 2, STAGE_BYTES = 8 * HTB, NXCD = 8, WGM = 8;
__host__ __device__ __forceinline__ int lds_byte(int r, int c) { const int st = (r >> 4) * 2 + (c >> 5), rr = r & 15, cc = c & 31, ob = rr * 64 + cc * 2; return st * 1024 + (ob ^ (((ob >> 9) & 1) << 5)); }
__host__ __device__ __forceinline__ void stage_rc(int b, int& R, int& C) { const int st = b / 1024, sb = b % 1024, swz = sb ^ (((sb >> 9) & 1) << 5); R = (st >> 1) * 16 + swz / 64; C = (st & 1) * 32 + (swz % 64) / 2; }
__host__ __device__ __forceinline__ int perm32(int rho) { const int n = rho >> 4, i = rho & 15; return 8 * (i >> 2) + 4 * n + (i & 3); }

struct Unit { int pm, pn, seg, k0, nt, role; };
struct Prob {
    const char* A; const char* Bt; int lda, ldb;
    size_t kstepA, kstepB;
    int nM, nN, ntk, nseg; size_t a_seg, b_seg;
    int G, c;
    DI bool next(int i, Unit& u) const {
        const int nwg = nM * nN; long L = (long)i * G + c; if (L >= (long)nwg * nseg) return false;
        u.seg = (int)(L / nwg); L -= (long)u.seg * nwg; u.k0 = 0; u.nt = ntk; u.role = 0;
        int wgid = (int)L; { const int q = nwg / NXCD, r = nwg % NXCD, xcd = wgid % NXCD, off = wgid / NXCD; wgid = (xcd < r ? xcd * (q + 1) : r * (q + 1) + (xcd - r) * q) + off; }
        const int nig = WGM * nN, gid = wgid / nig, fm = gid * WGM, gsz = (nM - fm) < WGM ? (nM - fm) : WGM;
        u.pm = fm + ((wgid % nig) % gsz); u.pn = (wgid % nig) / gsz; return true;
    }
    DI const char* aptr(const Unit& u) const { return A + (size_t)u.pm * BM * lda * 2 + (size_t)u.seg * a_seg; }
    DI const char* bptr(const Unit& u) const { return Bt + (size_t)u.pn * BM * ldb * 2 + (size_t)u.seg * b_seg; }
    DI void acc_init(const Unit&, f32x4 (&acc)[2][2][4][2], int) const {
#pragma unroll
        for (int a = 0; a < 2; ++a)
#pragma unroll
            for (int b = 0; b < 2; ++b)
#pragma unroll
                for (int m = 0; m < 4; ++m)
#pragma unroll
                    for (int n = 0; n < 2; ++n) acc[a][b][m][n] = (f32x4){0.f, 0.f, 0.f, 0.f};
    }
};
struct ProbSK {
    const char* A; const char* Bt; int lda, ldb, q4, vc, G;
    size_t kstepA, kstepB;
    DI bool next(int i, Unit& u) const {
        const int v = (i >> 1) * G + vc; if (v >= 256) return false;
        const int r = v & 3, gq = v >> 2; const bool quarter = (r < 3) == ((i & 1) == 0); int t;
        if (quarter) { t = 256 + gq; u.k0 = r * q4; u.nt = q4; u.role = r < 3 ? 1 : 2; }
        else { t = r == 3 ? gq : 64 + gq * 3 + r; u.k0 = 0; u.nt = 4 * q4; u.role = 0; }
        u.pm = t >> 3; u.pn = t & 7; u.seg = v; return true;
    }
    DI const char* aptr(const Unit& u) const { return A + (size_t)u.pm * BM * lda * 2 + (size_t)u.k0 * kstepA; }
    DI const char* bptr(const Unit& u) const { return Bt + (size_t)u.pn * BM * ldb * 2 + (size_t)u.k0 * kstepB; }
    const float* slab; unsigned* flags;
    DI void acc_init(const Unit& u, f32x4 (&acc)[2][2][4][2], int tid) const {
        if (u.role == 2) {
            if (tid < 64) {
                unsigned sp = 0;
                for (int j = 1; j <= 3; ++j)
                    while ((unsigned)__builtin_amdgcn_readfirstlane(__hip_atomic_load(flags + (u.seg - j) * 64, RLX_AGENT)) < 8u) { __builtin_amdgcn_s_sleep(2); if (++sp > (1u << 22)) break; }
                __builtin_amdgcn_fence(__ATOMIC_ACQUIRE, "agent");
                asm volatile("s_waitcnt vmcnt(0)" ::: "memory");
            }
            asm volatile("" ::: "memory"); __builtin_amdgcn_s_barrier(); asm volatile("" ::: "memory");
            const char* base = (const char*)(slab + (size_t)(u.seg - 3) * 65536); unsigned voff = (unsigned)tid * 16u; asm volatile("" : "+v"(voff));
#pragma unroll
            for (int a = 0; a < 2; ++a)
#pragma unroll
                for (int b = 0; b < 2; ++b)
#pragma unroll
                    for (int m = 0; m < 4; ++m) { const char* p = base + (size_t)(((a * 2 + b) * 4 + m) * 8192) + voff;
                        const u32x4 x = *(const u32x4*)p, y = *(const u32x4*)(p + 262144), z = *(const u32x4*)(p + 524288);
                        acc[a][b][m][0] = (f32x4){bflo(x.x) + bflo(y.x) + bflo(z.x), bfhi(x.x) + bfhi(y.x) + bfhi(z.x), bflo(x.y) + bflo(y.y) + bflo(z.y), bfhi(x.y) + bfhi(y.y) + bfhi(z.y)};
                        acc[a][b][m][1] = (f32x4){bflo(x.z) + bflo(y.z) + bflo(z.z), bfhi(x.z) + bfhi(y.z) + bfhi(z.z), bflo(x.w) + bflo(y.w) + bflo(z.w), bfhi(x.w) + bfhi(y.w) + bfhi(z.w)}; }
            asm volatile("s_waitcnt vmcnt(0)" ::: "memory");
        } else {
#pragma unroll
            for (int a = 0; a < 2; ++a)
#pragma unroll
                for (int b = 0; b < 2; ++b)
#pragma unroll
                    for (int m = 0; m < 4; ++m)
#pragma unroll
                        for (int n = 0; n < 2; ++n) acc[a][b][m][n] = (f32x4){0.f, 0.f, 0.f, 0.f};
        }
    }
};

#ifndef KPAD_GU
#define KPAD_GU 0
#define KPAD_WIN 0
#define KPAD_BR 1
#define KPAD_R0 0
#define KPAD_R1 0
#endif
template <int N> DI void kloop_align() { asm volatile(".p2align 6\n\t.rept %c0\n\ts_nop 0\n\t.endr" :: "i"(N) : "memory"); }
template <class Epi, class PB>
DI void gemm_phase(LAS unsigned char* lds, const PB& S, const Epi& E) {
    int tid_ = threadIdx.x; asm volatile("" : "+v"(tid_));
    const int tid = tid_, wid = __builtin_amdgcn_readfirstlane(tid >> 6), lane = tid & 63, wr = wid >> 2, wc = wid & 3, fr = lane & 15, fq = lane >> 4;
    unsigned voffA[2], voffB[2];
#pragma unroll
    for (int i = 0; i < 2; ++i) { int R, C; stage_rc(tid * 16 + i * 8192, R, C); const int Rb = Epi::PERM ? ((R & ~31) + perm32(R & 31)) : R;
        voffA[i] = (unsigned)(R * S.lda + C) * 2u; voffB[i] = (unsigned)(Rb * S.ldb + C) * 2u; }
    const size_t kstepA = S.kstepA, kstepB = S.kstepB;
    const size_t hstepA = (size_t)HALF * S.lda * 2, hstepB = (size_t)HALF * S.ldb * 2;
    const unsigned ldsw = (unsigned)wid * 1024u;
    const int aoff = lds_byte(wr * 64 + fr, fq * 8), boff = lds_byte(wc * 32 + fr, fq * 8);
#define PG8_SA(b, h) (((b) * 2 + (h)) * HTB)
#define PG8_SB(b, h) ((4 + (b) * 2 + (h)) * HTB)
#define PG8_STAGE(bufoff, gbase, voff) do { _Pragma("unroll") for (int _i = 0; _i < 2; ++_i) \
        __builtin_amdgcn_global_load_lds((const unsigned*)((const char*)(gbase) + (voff)[_i]), (LAS unsigned*)(lds + (bufoff) + ldsw + _i * 8192), 16, 0, 0); } while (0)
#define PG8_LDA(dst, b, h) do { _Pragma("unroll") for (int m = 0; m < 4; ++m) _Pragma("unroll") for (int k = 0; k < 2; ++k) dst[m][k] = *(const LAS bf16x8*)(lds + PG8_SA(b, h) + aoff + m * 2048 + k * 1024); } while (0)
#define PG8_LDB(dst, b, h) do { _Pragma("unroll") for (int n = 0; n < 2; ++n) _Pragma("unroll") for (int k = 0; k < 2; ++k) dst[n][k] = *(const LAS bf16x8*)(lds + PG8_SB(b, h) + boff + n * 2048 + k * 1024); } while (0)
#define PG8_MMA(ai, bj, At, Bt) do { __builtin_amdgcn_s_setprio(1); _Pragma("unroll") for (int m = 0; m < 4; ++m) _Pragma("unroll") for (int n = 0; n < 2; ++n) _Pragma("unroll") for (int k = 0; k < 2; ++k) \
        acc[ai][bj][m][n] = __builtin_amdgcn_mfma_f32_16x16x32_bf16(Bt[n][k], At[m][k], acc[ai][bj][m][n], 0, 0, 0); __builtin_amdgcn_s_setprio(0); } while (0)
#define PG8_WAIT_V(n) asm volatile("s_waitcnt vmcnt(" #n ")" ::: "memory")
#define PG8_WAIT_L(n) asm volatile("s_waitcnt lgkmcnt(" #n ")" ::: "memory")
#define PG8_BAR __builtin_amdgcn_s_barrier()
#define PG8_SCHED __builtin_amdgcn_sched_barrier(0)
    Unit cur, nxt; int ui = 0;
    if (!S.next(0, cur)) return;
    f32x4 acc[2][2][4][2];
#pragma unroll
    for (int a = 0; a < 2; ++a)
#pragma unroll
        for (int b = 0; b < 2; ++b)
#pragma unroll
            for (int m = 0; m < 4; ++m)
#pragma unroll
                for (int n = 0; n < 2; ++n) acc[a][b][m][n] = (f32x4){0.f, 0.f, 0.f, 0.f};
    bf16x8 At[4][2], B0[2][2], B1[2][2];
    const char* cA = S.aptr(cur); const char* cB = S.bptr(cur);
    PG8_STAGE(PG8_SB(0, 0), cB, voffB); PG8_STAGE(PG8_SB(0, 1), cB + hstepB, voffB); PG8_STAGE(PG8_SA(0, 0), cA, voffA); PG8_STAGE(PG8_SA(0, 1), cA + hstepA, voffA);
    if (wr == 1) PG8_BAR;
    PG8_WAIT_V(2); PG8_BAR;
    PG8_STAGE(PG8_SB(1, 0), cB + kstepB, voffB); PG8_STAGE(PG8_SA(1, 0), cA + kstepA, voffA); PG8_STAGE(PG8_SB(1, 1), cB + hstepB + kstepB, voffB);
    PG8_WAIT_V(6); PG8_BAR;
    for (;;) {
        const bool has_next = S.next(ui + 1, nxt);
        const char* nA = has_next ? S.aptr(nxt) : cA; const char* nB = has_next ? S.bptr(nxt) : cB;
        const int nt = cur.nt;
        kloop_align<Epi::KPAD>();
        for (int t = 0; t < nt; t += 2) {
            const bool last = (t == nt - 2);
            const char* a1 = cA + (size_t)(t + 1) * kstepA;
            const char* a2 = last ? nA : cA + (size_t)(t + 2) * kstepA; const char* b2 = last ? nB : cB + (size_t)(t + 2) * kstepB;
            const char* a3 = a2 + kstepA; const char* b3 = b2 + kstepB;
            PG8_LDB(B0, 0, 0); PG8_LDB(B1, 0, 1); PG8_SCHED; PG8_LDA(At, 0, 0); PG8_STAGE(PG8_SA(1, 1), a1 + hstepA, voffA);
            PG8_WAIT_V(8); PG8_WAIT_L(0); PG8_BAR; PG8_MMA(0, 0, At, B0); PG8_MMA(0, 1, At, B1); PG8_BAR; PG8_SCHED;
            PG8_LDA(At, 0, 1); PG8_STAGE(PG8_SB(0, 0), b2, voffB); PG8_STAGE(PG8_SB(0, 1), b2 + hstepB, voffB); PG8_STAGE(PG8_SA(0, 0), a2, voffA);
            PG8_WAIT_V(8); PG8_WAIT_L(0); PG8_BAR; PG8_MMA(1, 0, At, B0); PG8_MMA(1, 1, At, B1); PG8_BAR; PG8_SCHED;
            PG8_LDB(B0, 1, 0); PG8_LDB(B1, 1, 1); PG8_SCHED; PG8_LDA(At, 1, 0); PG8_STAGE(PG8_SA(0, 1), a2 + hstepA, voffA);
            PG8_WAIT_V(8); PG8_WAIT_L(0); PG8_BAR; PG8_MMA(0, 0, At, B0); PG8_MMA(0, 1, At, B1); PG8_BAR; PG8_SCHED;
            PG8_LDA(At, 1, 1); PG8_STAGE(PG8_SB(1, 0), b3, voffB); PG8_STAGE(PG8_SB(1, 1), b3 + hstepB, voffB); PG8_STAGE(PG8_SA(1, 0), a3, voffA);
            PG8_WAIT_V(8); PG8_WAIT_L(0); PG8_BAR; PG8_MMA(1, 0, At, B0); PG8_MMA(1, 1, At, B1); PG8_BAR; PG8_SCHED;
        }
#if PG8_ALIGN
        if (wr == 0) PG8_BAR;
#endif
        E(acc, cur, wr, wc, fr, fq);
        if (!has_next) break;
        S.acc_init(nxt, acc, tid);
        cur = nxt; cA = nA; cB = nB; ++ui;
#if PG8_ALIGN
        if (wr == 1) PG8_BAR;
#endif
    }
    PG8_WAIT_V(0);
#if !PG8_ALIGN
    if (wr == 0) PG8_BAR;
#endif
    PG8_BAR;
#undef PG8_SA
#undef PG8_SB
#undef PG8_STAGE
#undef PG8_LDA
#undef PG8_LDB
#undef PG8_MMA
#undef PG8_WAIT_V
#undef PG8_WAIT_L
#undef PG8_BAR
#undef PG8_SCHED
}
}

DI int mod_index(int pm) { return pm < 32 ? 0 : 1 + ((pm - 32) >> 2); }
struct EpiSwiGLU {
    static constexpr int KPAD = KPAD_GU;
    static constexpr bool PERM = true;
    bf16_t* H;
    DI void operator()(f32x4 (&acc)[2][2][4][2], const pg8::Unit& u, int wr, int wc, int fr, int fq) const {
        const int row0 = u.pm * 256 + wr * 64 + fr, col0 = u.pn * 128 + wc * 32 + 8 * fq;
#pragma unroll
        for (int ai = 0; ai < 2; ++ai)
#pragma unroll
            for (int m = 0; m < 4; ++m) {
                bf16_t* rowp = H + kb64(MT, row0 + ai * 128 + m * 16, col0);
                const f32x4 g0 = acc[ai][0][m][0], g1 = acc[ai][0][m][1], u0 = acc[ai][1][m][0], u1 = acc[ai][1][m][1];
                u32x4 w;
                w.x = pk2(fast_silu(g0[0]) * u0[0], fast_silu(g0[1]) * u0[1]); w.y = pk2(fast_silu(g0[2]) * u0[2], fast_silu(g0[3]) * u0[3]);
                w.z = pk2(fast_silu(g1[0]) * u1[0], fast_silu(g1[1]) * u1[1]); w.w = pk2(fast_silu(g1[2]) * u1[2], fast_silu(g1[3]) * u1[3]);
                *(u32x4*)rowp = w;
            }
    }
};
template <bool F32IN> struct EpiResid {
    static constexpr int KPAD = F32IN ? KPAD_R0 : KPAD_R1;
    static constexpr bool PERM = true; static constexpr int MB = F32IN ? 2 : 4;
    bf16_t* X; const float* gvec; float coef;
    const float* Xa; const float* Xb;
    DI void operator()(f32x4 (&acc)[2][2][4][2], const pg8::Unit& u, int wr, int wc, int fr, int fq) const {
        const int row0 = u.pm * 256 + wr * 64 + fr, col0 = u.pn * 256 + wc * 32 + 8 * fq;
        const float* Xi = u.pm < 32 ? Xa : Xb;
        const float* gv = gvec + (size_t)mod_index(u.pm) * NMOD + col0;
        f32x4 g[2][2];
#pragma unroll
        for (int bj = 0; bj < 2; ++bj)
#pragma unroll
            for (int n = 0; n < 2; ++n) g[bj][n] = *(const f32x4*)(gv + bj * 128 + n * 4) * coef;
        if (F32IN) {
#pragma unroll
            for (int ai = 0; ai < 2; ++ai)
#pragma unroll
                for (int mb = 0; mb < 4; mb += 2) {
                    f32x4 tv[2][2][2];
#pragma unroll
                    for (int mm = 0; mm < 2; ++mm) { const size_t ro = (size_t)(row0 + ai * 128 + (mb + mm) * 16) * DM + col0;
#pragma unroll
                        for (int bj = 0; bj < 2; ++bj) { tv[mm][bj][0] = *(const f32x4*)(Xi + ro + bj * 128); tv[mm][bj][1] = *(const f32x4*)(Xi + ro + bj * 128 + 4); } }
#pragma unroll
                    for (int mm = 0; mm < 2; ++mm) { const int m = mb + mm; bf16_t* rowp = X + ((size_t)u.pn * MT + row0 + ai * 128 + m * 16) * YLD + wc * 32 + 8 * fq;
#pragma unroll
                        for (int bj = 0; bj < 2; ++bj) { const f32x4 r0 = tv[mm][bj][0] + g[bj][0] * acc[ai][bj][m][0], r1 = tv[mm][bj][1] + g[bj][1] * acc[ai][bj][m][1];
                            u32x4 w; w.x = pk2(r0[0], r0[1]); w.y = pk2(r0[2], r0[3]); w.z = pk2(r1[0], r1[1]); w.w = pk2(r1[2], r1[3]); *(u32x4*)(rowp + bj * 128) = w; } }
                }
        } else {
            u32x4 tv[2][4][2];
            bf16_t* Xw = X + ((size_t)u.pn * MT + u.pm * 256 + wr * 64) * YLD + wc * 32;
            const unsigned lo = (unsigned)(fr * YLD + 8 * fq);
#define ER_LOAD(i) tv[(i) >> 3][((i) >> 1) & 3][(i) & 1] = *(const u32x4*)(Xw + (size_t)((((i) >> 3) * 128 + (((i) >> 1) & 3) * 16) * YLD + ((i) & 1) * 128) + lo)
#define ER_DONE(i) do { const int ai = (i) >> 3, m = ((i) >> 1) & 3, bj = (i) & 1; const u32x4 t = tv[ai][m][bj]; \
                const f32x4 r0 = (f32x4){bflo(t.x), bfhi(t.x), bflo(t.y), bfhi(t.y)} + g[bj][0] * acc[ai][bj][m][0], r1 = (f32x4){bflo(t.z), bfhi(t.z), bflo(t.w), bfhi(t.w)} + g[bj][1] * acc[ai][bj][m][1]; \
                u32x4 w; w.x = pk2(r0[0], r0[1]); w.y = pk2(r0[2], r0[3]); w.z = pk2(r1[0], r1[1]); w.w = pk2(r1[2], r1[3]); \
                *(u32x4*)(Xw + (size_t)((ai * 128 + m * 16) * YLD + bj * 128) + lo) = w; } while (0)
#pragma unroll
            for (int i = 0; i < 12; ++i) ER_LOAD(i);
            asm volatile("" ::: "memory");
#pragma unroll
            for (int i = 0; i < 4; ++i) ER_DONE(i);
            asm volatile("" ::: "memory");
#pragma unroll
            for (int i = 12; i < 16; ++i) ER_LOAD(i);
            asm volatile("" ::: "memory");
#pragma unroll
            for (int i = 4; i < 16; ++i) ER_DONE(i);
#undef ER_LOAD
#undef ER_DONE
        }
    }
};
template <class Epi> struct EpiSK {
    static constexpr int KPAD = Epi::KPAD;
    static constexpr bool PERM = Epi::PERM;
    Epi E; float* slab; unsigned* flags;
    DI void operator()(f32x4 (&acc)[2][2][4][2], const pg8::Unit& u, int wr, int wc, int fr, int fq) const {
        const int tid = threadIdx.x;
        const unsigned voff = (unsigned)tid * 16u;
        if (u.role == 1) {
            const char* base = (const char*)(slab + (size_t)u.seg * 65536);
#pragma unroll
            for (int ai = 0; ai < 2; ++ai)
#pragma unroll
                for (int bj = 0; bj < 2; ++bj)
#pragma unroll
                    for (int m = 0; m < 4; ++m) { const f32x4 a0 = acc[ai][bj][m][0], a1 = acc[ai][bj][m][1];
                        u32x4 w; w.x = pk2(a0[0], a0[1]); w.y = pk2(a0[2], a0[3]); w.z = pk2(a1[0], a1[1]); w.w = pk2(a1[2], a1[3]);
                        asm volatile("global_store_dwordx4 %0, %1, %2 sc1" :: "v"(voff), "v"(w), "s"(base) : "memory"); base += 8192; asm volatile("" : "+s"(base)); }
            asm volatile("s_waitcnt vmcnt(0)" ::: "memory");
            if ((tid & 63) == 0) __hip_atomic_fetch_add(flags + u.seg * 64, 1u, RLX_AGENT);
            return;
        }
        if (PROBE_DUP != 0 && E.coef == 0.f) return;
        E(acc, u, wr, wc, fr, fq);
    }
};
struct EpiY {
    static constexpr int KPAD = KPAD_WIN;
    static constexpr bool PERM = true;
    bf16_t* Y; float* YS;
    DI void operator()(f32x4 (&acc)[2][2][4][2], const pg8::Unit& u, int wr, int wc, int fr, int fq) const {
        const int row0 = u.pm * 256 + wr * 64 + fr, col0 = u.pn * 256 + wc * 32 + 8 * fq;
#pragma unroll
        for (int ai = 0; ai < 2; ++ai)
#pragma unroll
            for (int m = 0; m < 4; ++m) {
                bf16_t* rowp = Y + ((size_t)u.pn * MT + row0 + ai * 128 + m * 16) * YLD + wc * 32 + 8 * fq;
#pragma unroll
                for (int bj = 0; bj < 2; ++bj) { const f32x4 v0 = acc[ai][bj][m][0], v1 = acc[ai][bj][m][1];
                    u32x4 w; w.x = pk2(v0[0], v0[1]); w.y = pk2(v0[2], v0[3]); w.z = pk2(v1[0], v1[1]); w.w = pk2(v1[2], v1[3]);
                    *(u32x4*)(rowp + bj * 128) = w; }
            }
        if (u.pn == 54 && wc < 2) {
#pragma unroll
            for (int ai = 0; ai < 2; ++ai)
#pragma unroll
                for (int m = 0; m < 4; ++m) { float* p = YS + (size_t)(row0 + ai * 128 + m * 16) * 64 + wc * 32 + 8 * fq;
                    *(f32x4*)p = acc[ai][0][m][0]; *(f32x4*)(p + 4) = acc[ai][0][m][1]; }
        }
    }
};
struct EpiBranch {
    static constexpr int KPAD = KPAD_BR;
    static constexpr bool PERM = true;
    const bf16_t* Y; bf16_t* PB;
    DI void operator()(f32x4 (&acc)[2][2][4][2], const pg8::Unit& u, int wr, int wc, int fr, int fq) const {
        const int row0 = u.pm * 256 + wr * 64 + fr, col0 = u.pn * 256 + wc * 32 + 8 * fq;
        bf16_t* P = PB + (size_t)u.seg * MT * DM;
#pragma unroll
        for (int ai = 0; ai < 2; ++ai) {
            u32x4 gb[4][2];
#pragma unroll
            for (int m = 0; m < 4; ++m)
#pragma unroll
                for (int bj = 0; bj < 2; ++bj) gb[m][bj] = *(const u32x4*)(Y + ((size_t)(YC_BR / 256 + u.seg * 8 + u.pn) * MT + row0 + ai * 128 + m * 16) * YLD + wc * 32 + 8 * fq + bj * 128);
#pragma unroll
            for (int m = 0; m < 4; ++m) {
                const size_t row = (size_t)(row0 + ai * 128 + m * 16);
#pragma unroll
                for (int bj = 0; bj < 2; ++bj) {
                    const u32x4 g = gb[m][bj]; const f32x4 v0 = acc[ai][bj][m][0], v1 = acc[ai][bj][m][1];
                    u32x4 w;
                    w.x = pk2(fast_sigmoid(bflo(g.x)) * v0[0], fast_sigmoid(bfhi(g.x)) * v0[1]); w.y = pk2(fast_sigmoid(bflo(g.y)) * v0[2], fast_sigmoid(bfhi(g.y)) * v0[3]);
                    w.z = pk2(fast_sigmoid(bflo(g.z)) * v1[0], fast_sigmoid(bfhi(g.z)) * v1[1]); w.w = pk2(fast_sigmoid(bflo(g.w)) * v1[2], fast_sigmoid(bfhi(g.w)) * v1[3]);
                    *(u32x4*)(P + ((size_t)u.pn * MT + row) * YLD + wc * 32 + 8 * fq + bj * 128) = w;
                }
            }
        }
    }
};

#define XB_TMO      128
#define XB_XCNT(j)  (256  + 64 * (j))
#define XB_XSUB(j)  (1280 + 64 * (j))
#define XB_XGEN(j)  (2304 + 64 * (j))
#define XB_TOP      3328
#define XB_TOPGEN   3392
#define XCD_BAR_WORDS 3456
#define XB_SPIN_CAP (1u << 18)
DI unsigned xb_ld(GAS unsigned* p)              { return __hip_atomic_load(p, __ATOMIC_RELAXED, __HIP_MEMORY_SCOPE_AGENT); }
DI unsigned xb_add(GAS unsigned* p, unsigned v) { return __hip_atomic_fetch_add(p, v, __ATOMIC_RELAXED, __HIP_MEMORY_SCOPE_AGENT); }
DI unsigned xb_xcc_id() { return (unsigned)__builtin_amdgcn_s_getreg((3 << 11) | 20) & 0xFu; }
#define XB_SPIN(cond, bar) do { unsigned _sp = 0; while (cond) { __builtin_amdgcn_s_sleep(1); \
    if ((++_sp & 255u) == 0u) { if (xb_ld(&(bar)[XB_TMO])) break; if (_sp > XB_SPIN_CAP) { xb_add(&(bar)[XB_TMO], 1u); break; } } } } while (0)
struct XcdBarrier { unsigned* bar; unsigned x; volatile LAS unsigned* st; };
DI XcdBarrier xcd_barrier_post(unsigned* bar, volatile LAS unsigned* st) {
    XcdBarrier b; b.bar = bar; b.x = xb_xcc_id(); b.st = st;
    if (threadIdx.x == 0) (void)xb_add(&((GAS unsigned*)bar)[XB_XCNT(b.x)], 1u);
    return b;
}
DI void xcd_barrier_complete(GAS unsigned* bar, unsigned x, unsigned& nloc, unsigned& nx) {
    const unsigned G = gridDim.x * gridDim.y * gridDim.z;
    unsigned sum, cnt, mine, sp = 0u;
    for (;;) {
        sum = 0u; cnt = 0u; mine = 0u;
#pragma unroll
        for (unsigned j = 0; j < 16; ++j) { const unsigned c = xb_ld(&bar[XB_XCNT(j)]); sum += c; cnt += (c > 0u) ? 1u : 0u; mine = (j == x) ? c : mine; }
        if (sum == G) break;
        __builtin_amdgcn_s_sleep(1);
        if ((++sp & 255u) == 0u) { if (xb_ld(&bar[XB_TMO])) break; if (sp > XB_SPIN_CAP) { xb_add(&bar[XB_TMO], 1u); break; } }
    }
    nloc = mine > 0u ? mine : 1u; nx = cnt > 0u ? cnt : 1u;
}
DI void xcd_barrier(const XcdBarrier& b) {
    asm volatile("s_waitcnt vmcnt(0)" ::: "memory");
    __syncthreads();
    if (threadIdx.x == 0) {
        GAS unsigned* bar = (GAS unsigned*)b.bar; asm volatile("" : "+s"(bar));
        __builtin_amdgcn_s_waitcnt(0);
        unsigned nloc = b.st[0], nx = b.st[1];
        if (nloc == 0u) { xcd_barrier_complete(bar, b.x, nloc, nx); b.st[0] = nloc; b.st[1] = nx; }
        const unsigned old = xb_add(&bar[XB_XSUB(b.x)], 1u);
        const unsigned gen = old / nloc;
        if (old + 1u == (gen + 1u) * nloc) {
            __builtin_amdgcn_fence(__ATOMIC_RELEASE, "agent");
            asm volatile("s_waitcnt vmcnt(0)" ::: "memory");
            const unsigned og = xb_add(&bar[XB_TOP], 1u);
            const unsigned tg = og / nx;
            if (og + 1u == (tg + 1u) * nx) xb_add(&bar[XB_TOPGEN], 1u);
            else XB_SPIN(xb_ld(&bar[XB_TOPGEN]) == tg, bar);
            __builtin_amdgcn_fence(__ATOMIC_ACQUIRE, "agent");
            xb_add(&bar[XB_XGEN(b.x)], 1u);
            asm volatile("s_waitcnt vmcnt(0)" ::: "memory");
        } else {
            XB_SPIN(xb_ld(&bar[XB_XGEN(b.x)]) == gen, bar);
            __builtin_amdgcn_fence(__ATOMIC_ACQUIRE, "agent");
            asm volatile("s_waitcnt vmcnt(0)" ::: "memory");
        }
    }
    __syncthreads();
}

namespace att {
constexpr int D = 128, NW = 8, QBLK = 32, KVBLK = 64;
constexpr float SCALE = 0.088388347648318440f;
constexpr float THR = 8.f;
constexpr size_t SHM_V = KVBLK * D * 2, SHM_K = KVBLK * D * 2;
#define KSWZ(row, colB) ((row) * 256 + ((colB) ^ (((row) & 7) << 4)))
#define SBAR() __builtin_amdgcn_sched_barrier(0)
DI unsigned cvtpk(float lo, float hi) { return pk2(lo, hi); }
struct Tile { const bf16_t* k; const bf16_t* v; int ldk, ldv, dpos, masked; };

DI void partialSM(f32x16& p0, f32x16& p1, float& m_reg, float& mn, float& alpha) {
  constexpr float C = SCALE * 1.4426950408889634f;
  float pmax = p0[0];
#pragma unroll
  for (int r = 1; r < 16; ++r) pmax = fmaxf(pmax, p0[r]);
#pragma unroll
  for (int r = 0; r < 16; ++r) pmax = fmaxf(pmax, p1[r]);
  { auto rr = __builtin_amdgcn_permlane32_swap(__float_as_uint(pmax), __float_as_uint(pmax), false, false);
    pmax = fmaxf(__uint_as_float(rr[0]), __uint_as_float(rr[1])); }
  if (__builtin_expect(__all(pmax - m_reg <= THR / SCALE), 1)) { mn = m_reg; alpha = 1.f; }
  else { mn = fmaxf(m_reg, pmax); alpha = __builtin_amdgcn_exp2f((m_reg - mn) * C); m_reg = mn; }
  float mnC = -mn * C;
#pragma unroll
  for (int r = 0; r < 16; ++r) p0[r] = fmaf(p0[r], C, mnC);
#pragma unroll
  for (int r = 0; r < 16; ++r) p1[r] = fmaf(p1[r], C, mnC);
#pragma unroll
  for (int r = 0; r < 16; ++r) p0[r] = __builtin_amdgcn_exp2f(p0[r]);
}
DI void finishSM(f32x16& p0, f32x16& p1, float alpha, float& l_reg, bf16x8& pa0, bf16x8& pa1, bf16x8& pa2, bf16x8& pa3) {
#pragma unroll
  for (int r = 0; r < 16; ++r) p1[r] = __builtin_amdgcn_exp2f(p1[r]);
  float ps = 0;
#pragma unroll
  for (int r = 0; r < 16; ++r) ps += p0[r];
#pragma unroll
  for (int r = 0; r < 16; ++r) ps += p1[r];
  { auto rr = __builtin_amdgcn_permlane32_swap(__float_as_uint(ps), __float_as_uint(ps), false, false);
    ps = __uint_as_float(rr[0]) + __uint_as_float(rr[1]); }
  l_reg = l_reg * alpha + ps;
#define PK4(P, BASE, OUT) do { unsigned a0 = cvtpk(P[BASE + 0], P[BASE + 1]), a1 = cvtpk(P[BASE + 2], P[BASE + 3]);   \
    unsigned b0 = cvtpk(P[BASE + 4], P[BASE + 5]), b1 = cvtpk(P[BASE + 6], P[BASE + 7]);                              \
    auto r0 = __builtin_amdgcn_permlane32_swap(a0, b0, false, false); auto r1 = __builtin_amdgcn_permlane32_swap(a1, b1, false, false); \
    u32x4 w = {r0[0], r1[0], r0[1], r1[1]}; OUT = __builtin_bit_cast(bf16x8, w); } while (0)
  PK4(p0, 0, pa0); PK4(p0, 8, pa1); PK4(p1, 0, pa2); PK4(p1, 8, pa3);
#undef PK4
}
DI void qkt(f32x16& p0, f32x16& p1, const char* Ks, const bf16x8* qr, int r32, int hi) {
#pragma unroll
  for (int i = 0; i < 16; ++i) { p0[i] = 0.f; p1[i] = 0.f; }
#pragma unroll
  for (int d0 = 0; d0 < 8; ++d0) { int cb = (d0 * 16 + hi * 8) * 2;
    bf16x8 b0 = *reinterpret_cast<const bf16x8*>(Ks + KSWZ(r32, cb));
    bf16x8 b1 = *reinterpret_cast<const bf16x8*>(Ks + KSWZ(32 + r32, cb));
    p0 = __builtin_amdgcn_mfma_f32_32x32x16_bf16(b0, qr[d0], p0, 0, 0, 0);
    p1 = __builtin_amdgcn_mfma_f32_32x32x16_bf16(b1, qr[d0], p1, 0, 0, 0); }
}
DI void amask(f32x16& p0, f32x16& p1, int dl, int hi) {
#pragma unroll
  for (int r = 0; r < 16; ++r) { const int kk = crow(r, hi);
    if ((unsigned)(dl + kk + 128) > 256u) p0[r] = -1e30f;
    if ((unsigned)(dl + kk + 32 + 128) > 256u) p1[r] = -1e30f; }
}
DI int v_st(int k, int c) { const int kk = (k & ~0xC) | ((k & 4) << 1) | ((k & 8) >> 1); return ((kk >> 3) * 4 + (c >> 5)) * 512 + ((kk & 7) * 32 + (c & 31)) * 2; }
DI int v_rd_base(int lane) { return ((lane & 3) << 3) | (((lane >> 2) & 3) << 6) | (((lane >> 4) & 1) << 5) | (((lane >> 5) & 1) << 8); }
constexpr int v_rd_off(int d0, int ks, int half) { return d0 * 512 + ks * 4096 + half * 2048; }
template <int OFF> DI s16x4 tr_read(int vb) {
  s16x4 r; asm volatile("ds_read_b64_tr_b16 %0, %1 offset:%2" : "=&v"(r) : "v"(vb), "i"(OFF) : "memory"); return r;
}
template <int D0> DI void pv_one(f32x16& od, int vb, bf16x8 pa0, bf16x8 pa1, bf16x8 pa2, bf16x8 pa3) {
  const s16x4 l0 = tr_read<v_rd_off(D0, 0, 0)>(vb), h0 = tr_read<v_rd_off(D0, 0, 1)>(vb), l1 = tr_read<v_rd_off(D0, 1, 0)>(vb), h1 = tr_read<v_rd_off(D0, 1, 1)>(vb);
  const s16x4 l2 = tr_read<v_rd_off(D0, 2, 0)>(vb), h2 = tr_read<v_rd_off(D0, 2, 1)>(vb), l3 = tr_read<v_rd_off(D0, 3, 0)>(vb), h3 = tr_read<v_rd_off(D0, 3, 1)>(vb);
  asm volatile("s_waitcnt lgkmcnt(0)" ::: "memory"); SBAR();
#define PK(L, H) (bf16x8){L[0], L[1], L[2], L[3], H[0], H[1], H[2], H[3]}
  od = __builtin_amdgcn_mfma_f32_32x32x16_bf16(pa0, PK(l0, h0), od, 0, 0, 0);
  od = __builtin_amdgcn_mfma_f32_32x32x16_bf16(pa1, PK(l1, h1), od, 0, 0, 0);
  od = __builtin_amdgcn_mfma_f32_32x32x16_bf16(pa2, PK(l2, h2), od, 0, 0, 0);
  od = __builtin_amdgcn_mfma_f32_32x32x16_bf16(pa3, PK(l3, h3), od, 0, 0, 0);
#undef PK
}
DI void pv_d0(f32x16* o, int vb, bf16x8 pa0, bf16x8 pa1, bf16x8 pa2, bf16x8 pa3) {
  pv_one<0>(o[0], vb, pa0, pa1, pa2, pa3); pv_one<1>(o[1], vb, pa0, pa1, pa2, pa3); pv_one<2>(o[2], vb, pa0, pa1, pa2, pa3); pv_one<3>(o[3], vb, pa0, pa1, pa2, pa3);
}
DI bf16x8 ld8(const bf16_t* p) { return *reinterpret_cast<const bf16x8*>(p); }

template <class TS>
DI void attn_unit(const bf16_t* __restrict__ Qb, int ldq, const TS& ts, int NT, float sink, bf16_t* __restrict__ Ob, int ldo, char* lds) {
  int tid_ = threadIdx.x; asm volatile("" : "+v"(tid_));
  const int tid = tid_, wid = tid >> 6, lane = tid & 63, r32 = lane & 31, hi = lane >> 5;
  char* V_lds = lds; char* K_lds = lds + 2 * SHM_V;
  float* ws = (float*)(lds + 2 * SHM_V + 2 * SHM_K) + wid * 64; float* li_l = ws; float* al_l = ws + 32;
  float m_reg = sink * (1.0f / SCALE), l_reg = 1.0f; f32x16 o[4]; bf16x8 qr[8];
#pragma unroll
  for (int d = 0; d < 4; ++d)
#pragma unroll
    for (int r = 0; r < 16; ++r) o[d][r] = 0.f;
  const bf16_t* Qw = Qb + (long)(wid * QBLK + r32) * ldq + hi * 8;
#pragma unroll
  for (int d0 = 0; d0 < 8; ++d0) qr[d0] = ld8(Qw + d0 * 16);
  const int sr = tid >> 4, sc = (tid & 15) * 8, vst0 = v_st(sr, sc), vst1 = v_st(32 + sr, sc);
  const int vb0 = (int)(uintptr_t)V_lds + v_rd_base(lane);
  const int dlane = -(wid * QBLK + r32);
  struct { bf16x8 vs0, vs1, ks0, ks1; } sr_[2];
#define SLOAD(i, J) do { const Tile T_ = ts(J); sr_[i].vs0 = ld8(T_.v + (long)sr * T_.ldv + sc); sr_[i].vs1 = ld8(T_.v + (long)(32 + sr) * T_.ldv + sc); \
    sr_[i].ks0 = ld8(T_.k + (long)sr * T_.ldk + sc); sr_[i].ks1 = ld8(T_.k + (long)(32 + sr) * T_.ldk + sc); } while (0)
#define SWRITE(b, i) do { *(bf16x8*)(V_lds + (b) * SHM_V + vst0) = sr_[i].vs0;          \
    *(bf16x8*)(V_lds + (b) * SHM_V + vst1) = sr_[i].vs1; int kc = sc * 2;               \
    *(bf16x8*)(K_lds + (b) * SHM_K + KSWZ(sr, kc)) = sr_[i].ks0;                       \
    *(bf16x8*)(K_lds + (b) * SHM_K + KSWZ(32 + sr, kc)) = sr_[i].ks1; } while (0)
#define SWAIT() asm volatile("s_waitcnt vmcnt(4)" ::: "memory")
#define RESC(a) do { if (__any((a) < 1.f)) { if (hi == 0) al_l[r32] = (a); asm volatile("s_waitcnt lgkmcnt(0)" ::: "memory"); \
    _Pragma("unroll") for (int d = 0; d < 4; ++d) _Pragma("unroll") for (int r = 0; r < 16; ++r) o[d][r] *= al_l[crow(r, hi)]; } } while (0)
#define MASK(P0, P1, J) do { const Tile T_ = ts(J); if (T_.masked) amask(P0, P1, T_.dpos + dlane, hi); } while (0)
  f32x16 pA0, pA1, pB0, pB1; float mnA, mnB, alA, alB; bf16x8 pa0, pa1, pa2, pa3;
  constexpr int SE = 0, SO = 1;
  SLOAD(SE, 0); asm volatile("s_waitcnt vmcnt(0)" ::: "memory"); SWRITE(0, SE); __syncthreads();
  qkt(pA0, pA1, K_lds, qr, r32, hi); MASK(pA0, pA1, 0); partialSM(pA0, pA1, m_reg, mnA, alA);
  SLOAD(SO, 1); if (2 < NT) SLOAD(SE, 2);
  SWAIT(); SWRITE(1, SO); __syncthreads();
  for (int j = 1; j + 1 < NT; j += 2) {
    SBAR(); qkt(pB0, pB1, K_lds + SHM_K, qr, r32, hi); MASK(pB0, pB1, j);
    finishSM(pA0, pA1, alA, l_reg, pa0, pa1, pa2, pa3); SBAR();
    SLOAD(SO, j + 2); SBAR();
    pv_d0(o, vb0, pa0, pa1, pa2, pa3); partialSM(pB0, pB1, m_reg, mnB, alB);
    __syncthreads(); SWAIT(); SWRITE(0, SE);
    RESC(alB); __syncthreads();
    SBAR(); qkt(pA0, pA1, K_lds, qr, r32, hi); MASK(pA0, pA1, j + 1);
    finishSM(pB0, pB1, alB, l_reg, pa0, pa1, pa2, pa3); SBAR();
    if (j + 3 < NT) SLOAD(SE, j + 3); SBAR();
    pv_d0(o, vb0 + (int)SHM_V, pa0, pa1, pa2, pa3); partialSM(pA0, pA1, m_reg, mnA, alA);
    __syncthreads(); SWAIT(); SWRITE(1, SO);
    RESC(alA); __syncthreads();
  }
  SBAR(); qkt(pB0, pB1, K_lds + SHM_K, qr, r32, hi); MASK(pB0, pB1, NT - 1);
  finishSM(pA0, pA1, alA, l_reg, pa0, pa1, pa2, pa3); SBAR();
  pv_d0(o, vb0, pa0, pa1, pa2, pa3); partialSM(pB0, pB1, m_reg, mnB, alB);
  __syncthreads(); RESC(alB);
  finishSM(pB0, pB1, alB, l_reg, pa0, pa1, pa2, pa3); SBAR();
  pv_d0(o, vb0 + (int)SHM_V, pa0, pa1, pa2, pa3);
  if (hi == 0) li_l[r32] = l_reg; asm volatile("s_waitcnt lgkmcnt(0)" ::: "memory");
  float rli[16];
#pragma unroll
  for (int r = 0; r < 16; ++r) rli[r] = __builtin_amdgcn_rcpf(li_l[crow(r, hi)]);
  bf16_t* Ow = Ob + (long)(wid * QBLK) * ldo;
#pragma unroll
  for (int r = 0; r < 16; ++r) { int orow = crow(r, hi);
#pragma unroll
    for (int d0 = 0; d0 < 4; ++d0) Ow[(long)orow * ldo + (long)(d0 >> 1) * ((long)MT * 64) + (d0 & 1) * 32 + r32] = f2bf(o[d0][r] * rli[r]); }
  __syncthreads();
#undef SLOAD
#undef SWRITE
#undef SWAIT
#undef RESC
#undef MASK
}
}

struct Frame {
    unsigned char* ws; float* out; const float* const* in;
    int G, bid;
};
#define MFMA32(a, b, c) __builtin_amdgcn_mfma_f32_32x32x16_bf16((a), (b), (c), 0, 0, 0)
DI bf16x8 pack_step(const f32x16& x, int s) {
    u32x4 p; p.x = pk2(x[8 * s + 0], x[8 * s + 1]); p.y = pk2(x[8 * s + 2], x[8 * s + 3]); p.z = pk2(x[8 * s + 4], x[8 * s + 5]); p.w = pk2(x[8 * s + 6], x[8 * s + 7]);
    return __builtin_bit_cast(bf16x8, p);
}
DI bf16x8 cat4(s16x4 lo, s16x4 hi) { return (bf16x8){lo[0], lo[1], lo[2], lo[3], hi[0], hi[1], hi[2], hi[3]}; }

constexpr int GL_QS = 0, GL_KS = 17408, GL_KT = 34816, GL_VT = 53248, GL_AS = 90112, GL_DS = 99328, GL_PART = 99840;
DI void gla_chain(const Frame& F, LAS unsigned char* lds, int item, int layer) {
    unsigned char* const ws_ = F.ws;
    int tid_ = threadIdx.x; asm volatile("" : "+v"(tid_));
    const int tid = tid_, lane = tid & 63, w = __builtin_amdgcn_readfirstlane(tid >> 6), r = lane & 31, hh = lane >> 5;
    const int dir = item & 1, h = (item >> 1) & 3, sq = item >> 3;
    const bool lat = sq < 2; const int b = lat ? sq : sq - 2;
    const int L = lat ? 1024 : 256, row0 = lat ? M_CTX + b * 1024 : b * 256, NC = L / 64;
    const bf16_t* Y = (const bf16_t*)(ws_ + WS_BIG); const bf16_t* LA = (const bf16_t*)(ws_ + WS_LA);
    bf16_t* OD = (bf16_t*)(ws_ + WS_ODG) + (size_t)dir * MT * 1024;
    LAS bf16_t* Qs = (LAS bf16_t*)(lds + GL_QS); LAS bf16_t* Ks = (LAS bf16_t*)(lds + GL_KS); LAS bf16_t* KT = (LAS bf16_t*)(lds + GL_KT);
    LAS bf16_t* VT = (LAS bf16_t*)(lds + GL_VT); LAS bf16_t* As = (LAS bf16_t*)(lds + GL_AS); LAS float* dS = (LAS float*)(lds + GL_DS); LAS float* partS = (LAS float*)(lds + GL_PART);
    f32x16 S[4];
    if (lat) { const float* st = F.in[5] + ((((size_t)b * 2 + layer) * 2 + dir) * 4 + h) * 128 * 256;
#pragma unroll
        for (int kt = 0; kt < 4; ++kt)
#pragma unroll
            for (int i = 0; i < 16; ++i) S[kt][i] = st[(size_t)(32 * kt + crow(i, hh)) * 256 + 32 * w + r];
    } else {
#pragma unroll
        for (int kt = 0; kt < 4; ++kt)
#pragma unroll
            for (int i = 0; i < 16; ++i) S[kt][i] = 0.f;
    }
    const int kp = tid & 63, sg = tid >> 6, vcc = tid >> 4, vsb = tid & 15;
#define WG_BAR() do { asm volatile("s_waitcnt lgkmcnt(0)" ::: "memory"); __builtin_amdgcn_s_barrier(); asm volatile("" ::: "memory"); } while (0)
#define GLA_LOAD(PROW, LAr, QVr, KVr, VVr) do { \
        _Pragma("unroll") for (int i = 0; i < 8; ++i) LAr[i] = *(const unsigned*)(LA + ((size_t)(dir * 4 + h) * MT + (PROW) + 8 * sg + i) * 128 + 2 * kp); \
        _Pragma("unroll") for (int i = 0; i < 4; ++i) VVr[i] = *(const bf16x8*)(Y + yaddr((PROW) + 4 * vsb + i, YC_GV + h * 256 + 8 * vcc)); \
        _Pragma("unroll") for (int i = 0; i < 8; ++i) { const size_t ro = yaddr((PROW) + 8 * sg + i, h * 128 + 2 * kp); QVr[i] = *(const unsigned*)(Y + ro + yaddr(0, YC_GQ)); KVr[i] = *(const unsigned*)(Y + ro + yaddr(0, YC_GK)); } } while (0)
    unsigned la[8], qv[8], kv[8]; bf16x8 vv[4];
    GLA_LOAD(row0 + 64 * (dir ? NC - 1 : 0), la, qv, kv, vv);
    for (int c = 0; c < NC; ++c) {
        const int pb = dir ? NC - 1 - c : c, prow = row0 + 64 * pb;
        { f32x2 part = {0.f, 0.f};
#pragma unroll
          for (int i = 0; i < 8; ++i) part += (f32x2){bflo(la[i]), bfhi(la[i])};
          *(LAS f32x2*)(partS + sg * 128 + 2 * kp) = part; }
        WG_BAR();
        f32x2 run = {0.f, 0.f}, total = {0.f, 0.f};
#pragma unroll
        for (int j = 0; j < 8; ++j) { const f32x2 p = *(const LAS f32x2*)(partS + j * 128 + 2 * kp); total += p; if (dir == 0 ? (j < sg) : (j > sg)) run += p; }
        const float eta = __expf(total[0]), etb = __expf(total[1]);
        float kha[8], khb[8];
#pragma unroll
        for (int ii = 0; ii < 8; ++ii) { const int i = dir == 0 ? ii : 7 - ii; run += (f32x2){bflo(la[i]), bfhi(la[i])}; const int t = 8 * sg + i;
            const float xa = run[0] * 1.4426950408889634f, xb = run[1] * 1.4426950408889634f;
            const float ka = bflo(kv[i]) * __builtin_amdgcn_exp2f(-xa), kb = bfhi(kv[i]) * __builtin_amdgcn_exp2f(-xb);
            *(LAS unsigned*)(Qs + t * 136 + 2 * kp) = pk2(bflo(qv[i]) * 0.088388347648318440f * __builtin_amdgcn_exp2f(xa), bfhi(qv[i]) * 0.088388347648318440f * __builtin_amdgcn_exp2f(xb));
            *(LAS unsigned*)(Ks + t * 136 + 2 * kp) = pk2(ka, kb); kha[i] = ka * eta; khb[i] = kb * etb; }
        { u32x4 w0, w1; w0.x = pk2(kha[0], kha[1]); w0.y = pk2(kha[2], kha[3]); w0.z = pk2(kha[4], kha[5]); w0.w = pk2(kha[6], kha[7]);
          w1.x = pk2(khb[0], khb[1]); w1.y = pk2(khb[2], khb[3]); w1.z = pk2(khb[4], khb[5]); w1.w = pk2(khb[6], khb[7]);
          *(LAS u32x4*)(KT + (2 * kp) * 72 + 8 * sg) = w0; *(LAS u32x4*)(KT + (2 * kp + 1) * 72 + 8 * sg) = w1; }
        if (sg == 0) *(LAS f32x2*)(dS + 2 * kp) = (f32x2){eta, etb};
#pragma unroll
        for (int e = 0; e < 8; ++e) { s16x4 q4 = {vv[0][e], vv[1][e], vv[2][e], vv[3][e]}; *(LAS s16x4*)(VT + (8 * vcc + e) * 72 + 4 * vsb) = q4; }
        WG_BAR();
        if (c + 1 < NC) GLA_LOAD(row0 + 64 * (dir ? NC - 2 - c : c + 1), la, qv, kv, vv);
        if (w < 4) {
            const int ti = w >> 1, si = w & 1;
            const bool need = dir == 0 ? (si <= ti) : (si >= ti);
            f32x16 a;
#pragma unroll
            for (int i = 0; i < 16; ++i) a[i] = 0.f;
            if (need) {
#pragma unroll
                for (int kk = 0; kk < 8; ++kk) { const bf16x8 fa = *(const LAS bf16x8*)(Qs + (32 * ti + r) * 136 + 16 * kk + 8 * hh), fb = *(const LAS bf16x8*)(Ks + (32 * si + r) * 136 + 16 * kk + 8 * hh);
                    a = MFMA32(fa, fb, a); }
            }
            const int s = 32 * si + r;
#pragma unroll
            for (int i = 0; i < 16; ++i) { const int t = 32 * ti + crow(i, hh); const bool ok = dir == 0 ? (s <= t) : (s >= t); As[t * 72 + s] = f2bf(ok ? a[i] : 0.f); }
        }
        WG_BAR();
        bf16x8 bv[4];
#pragma unroll
        for (int kk = 0; kk < 4; ++kk) bv[kk] = *(const LAS bf16x8*)(VT + (32 * w + r) * 72 + 16 * kk + 8 * hh);
#pragma unroll
        for (int ti = 0; ti < 2; ++ti) {
            f32x16 o;
#pragma unroll
            for (int i = 0; i < 16; ++i) o[i] = 0.f;
#pragma unroll
            for (int kk = 0; kk < 4; ++kk) { const bf16x8 fa = *(const LAS bf16x8*)(As + (32 * ti + r) * 72 + 16 * kk + 8 * hh); o = MFMA32(fa, bv[kk], o); }
#pragma unroll
            for (int kt = 0; kt < 4; ++kt)
#pragma unroll
                for (int s2 = 0; s2 < 2; ++s2) { const bf16x8 fb = pack_step(S[kt], s2);
                    const LAS bf16_t* qp = Qs + (32 * ti + r) * 136 + 32 * kt + 16 * s2 + 4 * hh;
                    const bf16x8 fa = cat4(*(const LAS s16x4*)qp, *(const LAS s16x4*)(qp + 8)); o = MFMA32(fa, fb, o); }
#pragma unroll
            for (int i = 0; i < 16; ++i) (OD + ((size_t)h * MT + prow + 32 * ti + (i & 3) + 8 * (i >> 2)) * YLD + 32 * w)[(unsigned)(4 * hh * YLD + r)] = f2bf(o[i]);
        }
#pragma unroll
        for (int kt = 0; kt < 4; ++kt) {
#pragma unroll
            for (int g = 0; g < 4; ++g) { const f32x4 dv = *(const LAS f32x4*)(dS + 32 * kt + 8 * g + 4 * hh);
                S[kt][4 * g + 0] *= dv[0]; S[kt][4 * g + 1] *= dv[1]; S[kt][4 * g + 2] *= dv[2]; S[kt][4 * g + 3] *= dv[3]; }
#pragma unroll
            for (int kk = 0; kk < 4; ++kk) { const bf16x8 fa = *(const LAS bf16x8*)(KT + (32 * kt + r) * 72 + 16 * kk + 8 * hh); S[kt] = MFMA32(fa, bv[kk], S[kt]); }
        }
    }
    if (!lat) { float* so = F.out + OUT_GLA + ((((size_t)b * 2 + layer) * 2 + dir) * 4 + h) * 128 * 256;
#pragma unroll
        for (int kt = 0; kt < 4; ++kt)
#pragma unroll
            for (int i = 0; i < 16; ++i) so[(size_t)(32 * kt + crow(i, hh)) * 256 + 32 * w + r] = S[kt][i];
    }
    WG_BAR();
#undef GLA_LOAD
}

constexpr int SD_BS = 0, SD_CS = 17408, SD_BT = 34816, SD_XT = 53248, SD_GS = 90112, SD_CUM = 107520, SD_DT = 108544, SD_F = 109568, SD_E = 110592, SD_TOT = 111616;
DI void ssd_chain(const Frame& F, LAS unsigned char* lds, int item, int layer, int hp) {
    unsigned char* const ws_ = F.ws;
    int tid_ = threadIdx.x; asm volatile("" : "+v"(tid_));
    const int tid = tid_, lane = tid & 63, w = __builtin_amdgcn_readfirstlane(tid >> 6), r = lane & 31, hh = lane >> 5;
    const int dir = item & 1, g = (item >> 1) & 3, sq = item >> 3;
    const bool lat = sq < 2; const int b = lat ? sq : sq - 2;
    const int L = lat ? 1024 : 256, row0 = lat ? M_CTX + b * 1024 : b * 256, NC = L / 64;
    const int hg = hp < 0 ? (w >> 1) : (2 * hp + (w >> 2)), ph = hp < 0 ? (w & 1) : ((w >> 1) & 1), head = g * 4 + hg;
    const int ti0 = hp < 0 ? 0 : (w & 1), ti1 = hp < 0 ? 2 : ti0 + 1;
    const bf16_t* XBC = (const bf16_t*)(ws_ + WS_XBC); const float* DT = (const float*)(ws_ + WS_DT); const float* DTA = (const float*)(ws_ + WS_DTA);
    bf16_t* YD = (bf16_t*)(ws_ + WS_ODS) + (size_t)dir * MT * 1024;
    LAS bf16_t* Bs = (LAS bf16_t*)(lds + SD_BS); LAS bf16_t* Cs = (LAS bf16_t*)(lds + SD_CS); LAS bf16_t* BT = (LAS bf16_t*)(lds + SD_BT); LAS bf16_t* XT = (LAS bf16_t*)(lds + SD_XT);
    LAS float* Gs = (LAS float*)(lds + SD_GS); LAS float* cumS = (LAS float*)(lds + SD_CUM); LAS float* dtS = (LAS float*)(lds + SD_DT); LAS float* fS = (LAS float*)(lds + SD_F);
    LAS float* eS = (LAS float*)(lds + SD_E); LAS float* totS = (LAS float*)(lds + SD_TOT);
    f32x16 ST[4];
    if (lat) { const float* st = F.in[6] + ((((size_t)b * 2 + layer) * 2 + dir) * 16 + head) * 64 * 128 + (size_t)(32 * ph + r) * 128;
#pragma unroll
        for (int nt = 0; nt < 4; ++nt)
#pragma unroll
            for (int q = 0; q < 4; ++q) { const f32x4 v = *(const f32x4*)(st + 32 * nt + 8 * q + 4 * hh); ST[nt][4 * q] = v[0]; ST[nt][4 * q + 1] = v[1]; ST[nt][4 * q + 2] = v[2]; ST[nt][4 * q + 3] = v[3]; }
    } else {
#pragma unroll
        for (int nt = 0; nt < 4; ++nt)
#pragma unroll
            for (int i = 0; i < 16; ++i) ST[nt][i] = 0.f;
    }
    const int ssb = tid & 15, sch = (tid >> 4) & 15, xch = tid >> 4; const bool isC = tid >= 256;
#define SSD_LOAD(PROW, BCr, XVr, DTr, DAr) do { \
        _Pragma("unroll") for (int i = 0; i < 4; ++i) BCr[i] = *(const bf16x8*)(XBC + yaddr((PROW) + 4 * ssb + i, (isC ? 1536 : 1024) + g * 128 + 8 * sch)); \
        _Pragma("unroll") for (int i = 0; i < 4; ++i) XVr[i] = *(const bf16x8*)(XBC + yaddr((PROW) + 4 * ssb + i, g * 256 + 8 * xch)); \
        { const size_t di = (size_t)((PROW) + lane) * 32 + dir * 16 + g * 4 + (w & 3); DTr = DT[di]; DAr = DTA[di]; } } while (0)
    bf16x8 bc[4], xv[4], bcn[4], xvn[4]; float dtv = 0.f, dta = 0.f, dtvn = 0.f, dtan = 0.f;
    SSD_LOAD(row0 + 64 * (dir ? NC - 1 : 0), bc, xv, dtv, dta);
    for (int c = 0; c < NC; ++c) {
        const int pb = dir ? NC - 1 - c : c, prow = row0 + 64 * pb;
        { const int cn = c + 1 < NC ? c + 1 : c;
          SSD_LOAD(row0 + 64 * (dir ? NC - 1 - cn : cn), bcn, xvn, dtvn, dtan); }
        { LAS bf16_t* dstR = isC ? Cs : Bs;
#pragma unroll
          for (int i = 0; i < 4; ++i) *(LAS bf16x8*)(dstR + (4 * ssb + i) * 136 + 8 * sch) = bc[i];
          if (!isC) {
#pragma unroll
              for (int e = 0; e < 8; ++e) { s16x4 q4 = {bc[0][e], bc[1][e], bc[2][e], bc[3][e]}; *(LAS s16x4*)(BT + (8 * sch + e) * 72 + 4 * ssb) = q4; } }
#pragma unroll
          for (int e = 0; e < 8; ++e) { s16x4 q4 = {xv[0][e], xv[1][e], xv[2][e], xv[3][e]}; *(LAS s16x4*)(XT + (8 * xch + e) * 72 + 4 * ssb) = q4; }
        }
        if (w < 4) {
            float cs = dta;
#pragma unroll
            for (int o = 1; o < 64; o <<= 1) { const float t = __shfl_up(cs, o); if (lane >= o) cs += t; }
            const float total = __shfl(cs, 63);
            const float cum = dir == 0 ? cs : total - cs + dta;
            cumS[w * 64 + lane] = cum; dtS[w * 64 + lane] = dtv; fS[w * 64 + lane] = dtv * __expf(total - cum); eS[w * 64 + lane] = __expf(cum);
            if (lane == 0) totS[w] = __expf(total);
        }
        WG_BAR();
        if (w < 4) {
            const int ti = w >> 1, si = w & 1;
            const bool need = dir == 0 ? (si <= ti) : (si >= ti);
            f32x16 a;
#pragma unroll
            for (int i = 0; i < 16; ++i) a[i] = 0.f;
            if (need) {
#pragma unroll
                for (int kk = 0; kk < 8; ++kk) { const bf16x8 fa = *(const LAS bf16x8*)(Cs + (32 * ti + r) * 136 + 16 * kk + 8 * hh), fb = *(const LAS bf16x8*)(Bs + (32 * si + r) * 136 + 16 * kk + 8 * hh);
                    a = MFMA32(fa, fb, a); }
            }
#pragma unroll
            for (int i = 0; i < 16; ++i) Gs[(32 * ti + crow(i, hh)) * 68 + 32 * si + r] = a[i];
        }
        WG_BAR();
        const LAS bf16_t* xrow = XT + (hg * 64 + 32 * ph + r) * 72 + 8 * hh;
#pragma unroll 1
        for (int ti = ti0; ti < ti1; ++ti) {
            f32x16 y;
#pragma unroll
            for (int i = 0; i < 16; ++i) y[i] = 0.f;
            const int t = 32 * ti + r; const float ct = cumS[hg * 64 + t];
#pragma unroll
            for (int nt = 0; nt < 4; ++nt)
#pragma unroll
                for (int s2 = 0; s2 < 2; ++s2) { const bf16x8 fb = pack_step(ST[nt], s2);
                    const LAS bf16_t* cp = Cs + t * 136 + 32 * nt + 16 * s2 + 4 * hh;
                    const bf16x8 fa = cat4(*(const LAS s16x4*)cp, *(const LAS s16x4*)(cp + 8)); y = MFMA32(fa, fb, y); }
#pragma unroll
            for (int q = 0; q < 4; ++q) { const f32x4 ev = *(const LAS f32x4*)(eS + hg * 64 + 32 * ti + 8 * q + 4 * hh);
                y[4 * q] *= ev[0]; y[4 * q + 1] *= ev[1]; y[4 * q + 2] *= ev[2]; y[4 * q + 3] *= ev[3]; }
#pragma unroll
            for (int kk = 0; kk < 4; ++kk) {
                const bool blk = dir == 0 ? (16 * kk <= 32 * ti + 31) : (16 * kk + 15 >= 32 * ti);
                if (blk) {
                    const int s0 = 16 * kk + 8 * hh;
                    const f32x4 g0 = *(const LAS f32x4*)(Gs + t * 68 + s0), g1 = *(const LAS f32x4*)(Gs + t * 68 + s0 + 4);
                    const f32x4 c0 = *(const LAS f32x4*)(cumS + hg * 64 + s0), c1 = *(const LAS f32x4*)(cumS + hg * 64 + s0 + 4);
                    const f32x4 d0 = *(const LAS f32x4*)(dtS + hg * 64 + s0), d1 = *(const LAS f32x4*)(dtS + hg * 64 + s0 + 4);
                    float wv[8];
#pragma unroll
                    for (int j = 0; j < 4; ++j) { const int s = s0 + j; const bool ok = dir == 0 ? (s <= t) : (s >= t);
                        wv[j] = ok ? g0[j] * __expf(fminf(ct - c0[j], 0.f)) * d0[j] : 0.f; }
#pragma unroll
                    for (int j = 0; j < 4; ++j) { const int s = s0 + 4 + j; const bool ok = dir == 0 ? (s <= t) : (s >= t);
                        wv[4 + j] = ok ? g1[j] * __expf(fminf(ct - c1[j], 0.f)) * d1[j] : 0.f; }
                    u32x4 p; p.x = pk2(wv[0], wv[1]); p.y = pk2(wv[2], wv[3]); p.z = pk2(wv[4], wv[5]); p.w = pk2(wv[6], wv[7]);
                    y = MFMA32(__builtin_bit_cast(bf16x8, p), *(const LAS bf16x8*)(xrow + 16 * kk), y);
                }
            }
#pragma unroll
            for (int i = 0; i < 16; ++i) (YD + ((size_t)(head >> 2) * MT + prow + 32 * ti + (i & 3) + 8 * (i >> 2)) * YLD + (head & 3) * 64 + 32 * ph)[(unsigned)(4 * hh * YLD + r)] = f2bf(y[i]);
        }
        const float dec = totS[hg];
#pragma unroll
        for (int nt = 0; nt < 4; ++nt)
#pragma unroll
            for (int i = 0; i < 16; ++i) ST[nt][i] *= dec;
#pragma unroll
        for (int kk = 0; kk < 4; ++kk) { const int s0 = 16 * kk + 8 * hh;
            const f32x4 f0 = *(const LAS f32x4*)(fS + hg * 64 + s0), f1 = *(const LAS f32x4*)(fS + hg * 64 + s0 + 4);
            const bf16x8 xk = *(const LAS bf16x8*)(xrow + 16 * kk);
            u32x4 p; p.x = pk2(bf2f_s(xk[0]) * f0[0], bf2f_s(xk[1]) * f0[1]); p.y = pk2(bf2f_s(xk[2]) * f0[2], bf2f_s(xk[3]) * f0[3]);
            p.z = pk2(bf2f_s(xk[4]) * f1[0], bf2f_s(xk[5]) * f1[1]); p.w = pk2(bf2f_s(xk[6]) * f1[2], bf2f_s(xk[7]) * f1[3]);
            const bf16x8 xh = __builtin_bit_cast(bf16x8, p);
#pragma unroll
            for (int nt = 0; nt < 4; ++nt) { const bf16x8 fa = *(const LAS bf16x8*)(BT + (32 * nt + r) * 72 + 16 * kk + 8 * hh); ST[nt] = MFMA32(fa, xh, ST[nt]); }
        }
        WG_BAR();
#pragma unroll
        for (int i = 0; i < 4; ++i) { bc[i] = bcn[i]; xv[i] = xvn[i]; }
        dtv = dtvn; dta = dtan;
    }
    if (!lat) { float* so = F.out + OUT_SSM + ((((size_t)b * 2 + layer) * 2 + dir) * 16 + head) * 64 * 128 + (size_t)(32 * ph + r) * 128;
#pragma unroll
        for (int nt = 0; nt < 4; ++nt)
#pragma unroll
            for (int q = 0; q < 4; ++q) { f32x4 v = {ST[nt][4 * q], ST[nt][4 * q + 1], ST[nt][4 * q + 2], ST[nt][4 * q + 3]}; *(f32x4*)(so + 32 * nt + 8 * q + 4 * hh) = v; }
    }
}

DI void norm_phase(const Frame& F, const float* Xa, const float* Xb, const float* nw, const float* mod  , bf16_t* XN) {
    int tid_ = threadIdx.x; asm volatile("" : "+v"(tid_));
    const int lane = tid_ & 63, gw = F.bid * NWAVES + __builtin_amdgcn_readfirstlane(tid_ >> 6), NGW = F.G * NWAVES;
    f32x4 wf[8], sf[8]; int cur_mi = -1;
    for (int row = gw; row < MT; row += NGW) {
        const f32x4* xr = (const f32x4*)((row < M_CTX ? Xa : Xb) + (size_t)row * DM) + lane;
        f32x4 v[8]; float s = 0.f;
#pragma unroll
        for (int j = 0; j < 8; ++j) { v[j] = xr[64 * j]; s += (v[j][0] * v[j][0] + v[j][1] * v[j][1]) + (v[j][2] * v[j][2] + v[j][3] * v[j][3]); }
        const int mi = row < M_CTX ? 0 : 1 + ((row - M_CTX) >> 10);
        if (mi != cur_mi) { cur_mi = mi;
            const f32x4* sh = (const f32x4*)(mod + (size_t)mi * NMOD) + lane; const f32x4* sc = (const f32x4*)(mod + (size_t)mi * NMOD + DM) + lane; const f32x4* wv = (const f32x4*)nw + lane;
#pragma unroll
            for (int j = 0; j < 8; ++j) { wf[j] = wv[64 * j] * (sc[64 * j] + 1.0f); sf[j] = sh[64 * j]; } }
        const float rstd = 1.0f / sqrtf(wave_sum(s) * (1.0f / DM) + RMS_EPS);
#pragma unroll
        for (int j = 0; j < 8; ++j) { const f32x4 a = v[j] * rstd * wf[j] + sf[j]; u32x2 w; w.x = pk2(a[0], a[1]); w.y = pk2(a[2], a[3]); *(u32x2*)(XN + kb64(MT, row, 256 * j + 4 * lane)) = w; }
    }
}
DI void norm_phase_b(const Frame& F, const bf16_t* XB, const float* nw, const float* mod, bf16_t* XN) {
    int tid_ = threadIdx.x; asm volatile("" : "+v"(tid_));
    const int lane = tid_ & 63, gw = F.bid * NWAVES + __builtin_amdgcn_readfirstlane(tid_ >> 6), NGW = F.G * NWAVES;
    f32x4 wf[8], sf[8]; int cur_mi = -1;
    for (int row = gw; row < MT; row += NGW) {
        const bf16_t* xr = XB + ((size_t)(lane >> 5) * MT + row) * YLD + 8 * (lane & 31);
        u32x4 t[4];
#pragma unroll
        for (int j = 0; j < 4; ++j) t[j] = *(const u32x4*)(xr + (size_t)(2 * j) * MT * YLD);
        f32x4 v[8]; float s = 0.f;
#pragma unroll
        for (int j = 0; j < 4; ++j) { v[2 * j] = (f32x4){bflo(t[j].x), bfhi(t[j].x), bflo(t[j].y), bfhi(t[j].y)}; v[2 * j + 1] = (f32x4){bflo(t[j].z), bfhi(t[j].z), bflo(t[j].w), bfhi(t[j].w)}; }
#pragma unroll
        for (int j = 0; j < 8; ++j) s += (v[j][0] * v[j][0] + v[j][1] * v[j][1]) + (v[j][2] * v[j][2] + v[j][3] * v[j][3]);
        const int mi = row < M_CTX ? 0 : 1 + ((row - M_CTX) >> 10);
        if (mi != cur_mi) { cur_mi = mi;
            const f32x4* sh = (const f32x4*)(mod + (size_t)mi * NMOD) + 2 * lane; const f32x4* sc = (const f32x4*)(mod + (size_t)mi * NMOD + DM) + 2 * lane; const f32x4* wv = (const f32x4*)nw + 2 * lane;
#pragma unroll
            for (int j = 0; j < 8; ++j) { const int o = 128 * (j >> 1) + (j & 1); wf[j] = wv[o] * (sc[o] + 1.0f); sf[j] = sh[o]; } }
        const float rstd = 1.0f / sqrtf(wave_sum(s) * (1.0f / DM) + RMS_EPS);
#pragma unroll
        for (int j = 0; j < 4; ++j) { const f32x4 a = v[2 * j] * rstd * wf[2 * j] + sf[2 * j], b = v[2 * j + 1] * rstd * wf[2 * j + 1] + sf[2 * j + 1];
            u32x4 w; w.x = pk2(a[0], a[1]); w.y = pk2(a[2], a[3]); w.z = pk2(b[0], b[1]); w.w = pk2(b[2], b[3]); *(u32x4*)(XN + kb64(MT, row, 512 * j + 8 * lane)) = w; }
    }
}
DI void final_norm_phase(const Frame& F, const bf16_t* XB, float* Xo, const float* nw) {
    int tid_ = threadIdx.x; asm volatile("" : "+v"(tid_));
    const int lane = tid_ & 63, gw = F.bid * NWAVES + __builtin_amdgcn_readfirstlane(tid_ >> 6), NGW = F.G * NWAVES;
    for (int row = gw; row < MT; row += NGW) {
        const bf16_t* xr = XB + ((size_t)(lane >> 5) * MT + row) * YLD + 8 * (lane & 31);
        u32x4 t[4];
#pragma unroll
        for (int j = 0; j < 4; ++j) t[j] = *(const u32x4*)(xr + (size_t)(2 * j) * MT * YLD);
        f32x4 v[8]; float s = 0.f;
#pragma unroll
        for (int j = 0; j < 4; ++j) { v[2 * j] = (f32x4){bflo(t[j].x), bfhi(t[j].x), bflo(t[j].y), bfhi(t[j].y)}; v[2 * j + 1] = (f32x4){bflo(t[j].z), bfhi(t[j].z), bflo(t[j].w), bfhi(t[j].w)}; }
#pragma unroll
        for (int j = 0; j < 8; ++j) s += (v[j][0] * v[j][0] + v[j][1] * v[j][1]) + (v[j][2] * v[j][2] + v[j][3] * v[j][3]);
        const float rstd = 1.0f / sqrtf(wave_sum(s) * (1.0f / DM) + RMS_EPS);
        const f32x4* wv = (const f32x4*)nw + 2 * lane; f32x4* yo = (f32x4*)(Xo + (size_t)row * DM) + 2 * lane;
#pragma unroll
        for (int j = 0; j < 8; ++j) { const int o = 128 * (j >> 1) + (j & 1); yo[o] = v[j] * rstd * wv[o]; }
    }
}
DI void seq_of_row(int row, int& t, int& L) { if (row < M_CTX) { t = row & 255; L = 256; } else { t = (row - M_CTX) & 1023; L = 1024; } }
DI void prep_phase(const Frame& F, int layer) {
    unsigned char* const ws_ = F.ws;
    const bf16_t* Y = (const bf16_t*)(ws_ + WS_BIG); const float* YS = (const float*)(ws_ + WS_YS);
    bf16_t* XBC = (bf16_t*)(ws_ + WS_XBC); float* DT = (float*)(ws_ + WS_DT); float* DTA = (float*)(ws_ + WS_DTA); bf16_t* LA = (bf16_t*)(ws_ + WS_LA); bf16_t* KR = (bf16_t*)(ws_ + WS_KR);
    int tid_ = threadIdx.x; asm volatile("" : "+v"(tid_));
    const int gt = F.bid * 512 + tid_, NT = F.G * 512;
    const float* cw = F.in[19] + (size_t)layer * 5 * 2048; const float* cb = F.in[20] + (size_t)layer * 2048;
    for (int it = gt; it < (MT / 8) * 256; it += NT) {
        const int r0 = (it >> 8) * 8, ch = (it & 255) * 8; int t0, L; seq_of_row(r0, t0, L);
        u32x4 xr[12];
#pragma unroll
        for (int j = 0; j < 12; ++j) { const int tt = t0 + j - 2; xr[j] = (u32x4){0u, 0u, 0u, 0u}; if (tt >= 0 && tt < L) xr[j] = *(const u32x4*)(Y + yaddr(r0 + j - 2, YC_XBC + ch)); }
        f32x4 w0[5], w1[5];
#pragma unroll
        for (int j = 0; j < 5; ++j) { w0[j] = *(const f32x4*)(cw + j * 2048 + ch); w1[j] = *(const f32x4*)(cw + j * 2048 + ch + 4); }
        const f32x4 b0 = *(const f32x4*)(cb + ch), b1 = *(const f32x4*)(cb + ch + 4);
#pragma unroll
        for (int i = 0; i < 8; ++i) {
            f32x4 a0 = b0, a1 = b1;
#pragma unroll
            for (int j = 0; j < 5; ++j) { const u32x4 xv = xr[i + j];
                a0 = a0 + w0[j] * (f32x4){bflo(xv.x), bfhi(xv.x), bflo(xv.y), bfhi(xv.y)}; a1 = a1 + w1[j] * (f32x4){bflo(xv.z), bfhi(xv.z), bflo(xv.w), bfhi(xv.w)}; }
            u32x4 o; o.x = pk2(fast_silu(a0[0]), fast_silu(a0[1])); o.y = pk2(fast_silu(a0[2]), fast_silu(a0[3])); o.z = pk2(fast_silu(a1[0]), fast_silu(a1[1])); o.w = pk2(fast_silu(a1[2]), fast_silu(a1[3]));
            *(u32x4*)(XBC + yaddr(r0 + i, ch)) = o;
        }
    }
    const float* dtb = F.in[21] + layer * 32; const float* alog = F.in[22] + layer * 32;
    for (int it = gt; it < MT * 32; it += NT) { const int i = it & 31; const float d = softplusf(YS[(size_t)(it >> 5) * 64 + 32 + i] + dtb[i]); DT[it] = d; DTA[it] = -__expf(alog[i]) * d; }
    const float* wup = F.in[16] + (size_t)layer * 2 * 16 * 512; const float* bup = F.in[17] + (size_t)layer * 2 * 512;
    for (int it = gt; it < (MT / 8) * 256; it += NT) {
        const int r0 = (it >> 8) * 8, dir = (it >> 7) & 1, j4 = (it & 127) * 4;
        f32x4 wu[16];
#pragma unroll
        for (int rr = 0; rr < 16; ++rr) wu[rr] = *(const f32x4*)(wup + (size_t)(dir * 16 + rr) * 512 + j4);
        const f32x4 bz = *(const f32x4*)(bup + dir * 512 + j4);
#pragma unroll
        for (int i = 0; i < 8; ++i) {
            const float* gd = YS + (size_t)(r0 + i) * 64 + dir * 16;
            const f32x4 g0 = *(const f32x4*)gd, g1 = *(const f32x4*)(gd + 4), g2 = *(const f32x4*)(gd + 8), g3 = *(const f32x4*)(gd + 12);
            f32x4 z = bz;
            z = z + g0[0] * wu[0] + g0[1] * wu[1] + g0[2] * wu[2] + g0[3] * wu[3]; z = z + g1[0] * wu[4] + g1[1] * wu[5] + g1[2] * wu[6] + g1[3] * wu[7];
            z = z + g2[0] * wu[8] + g2[1] * wu[9] + g2[2] * wu[10] + g2[3] * wu[11]; z = z + g3[0] * wu[12] + g3[1] * wu[13] + g3[2] * wu[14] + g3[3] * wu[15];
            u32x2 ow; ow.x = pk2(-softplusf(-z[0]) * (1.0f / 16.0f), -softplusf(-z[1]) * (1.0f / 16.0f)); ow.y = pk2(-softplusf(-z[2]) * (1.0f / 16.0f), -softplusf(-z[3]) * (1.0f / 16.0f));
            *(u32x2*)(LA + ((size_t)(dir * 4 + (j4 >> 7)) * MT + r0 + i) * 128 + (j4 & 127)) = ow;
        }
    }
    bf16_t* QR = (bf16_t*)(ws_ + WS_QR);
    for (int it = gt; it < M_LAT * 80; it += NT) {
        const int tl = it / 80, rem = it - tl * 80, hd = rem >> 3, half = (rem >> 2) & 1, i0 = (rem & 3) * 8;
        const int t = tl & 1023; const float pos = (float)(half ? (t & 63) : (t >> 6));
        const size_t src = yaddr(M_CTX + tl, (hd < 2 ? YC_AK + hd * 128 : YC_AQ + (hd - 2) * 128) + half * 64 + i0);
        const u32x4 xa = *(const u32x4*)(Y + src), xb = *(const u32x4*)(Y + src + 32);
        const unsigned a4[4] = {xa.x, xa.y, xa.z, xa.w}, b4[4] = {xb.x, xb.y, xb.z, xb.w}; unsigned oa[4], ob[4];
#pragma unroll
        for (int q = 0; q < 4; ++q) { float y1[2], y2[2];
#pragma unroll
            for (int e = 0; e < 2; ++e) { const int i = i0 + 2 * q + e; const float ang = pos * __builtin_amdgcn_exp2f(-(float)i * 0.41524101186092029f), cs = __cosf(ang), sn = __sinf(ang);
                const float x1 = e ? bfhi(a4[q]) : bflo(a4[q]), x2 = e ? bfhi(b4[q]) : bflo(b4[q]); y1[e] = x1 * cs - x2 * sn; y2[e] = x2 * cs + x1 * sn; }
            oa[q] = pk2(y1[0], y1[1]); ob[q] = pk2(y2[0], y2[1]); }
        bf16_t* dst = (hd < 2 ? KR + (size_t)tl * 256 + hd * 128 : QR + (size_t)tl * 1024 + (hd - 2) * 128) + half * 64 + i0;
        *(u32x4*)dst = (u32x4){oa[0], oa[1], oa[2], oa[3]}; *(u32x4*)(dst + 32) = (u32x4){ob[0], ob[1], ob[2], ob[3]};
    }
    for (int it = gt; it < M_CTX * 64; it += NT) { const int row = it >> 6, c8 = (it & 63) * 8, b = row >> 8, t = row & 255;
        const u32x4 xv = *(const u32x4*)(Y + yaddr(row, YC_AK + c8));
        float* o = F.out + (c8 < 256 ? OUT_CK : OUT_CV) + ((size_t)(b * 2 + layer) * 256 + t) * 256 + (c8 & 255);
        *(f32x4*)o = (f32x4){bflo(xv.x), bfhi(xv.x), bflo(xv.y), bfhi(xv.y)}; *(f32x4*)(o + 4) = (f32x4){bflo(xv.z), bfhi(xv.z), bflo(xv.w), bfhi(xv.w)}; }
}
DI void combine_phase(const Frame& F, int layer) {
    unsigned char* const ws_ = F.ws;
    const bf16_t* Y = (const bf16_t*)(ws_ + WS_BIG); const bf16_t* XBC = (const bf16_t*)(ws_ + WS_XBC);
    const bf16_t* OG = (const bf16_t*)(ws_ + WS_ODG); const bf16_t* OS = (const bf16_t*)(ws_ + WS_ODS); bf16_t* OC = (bf16_t*)(ws_ + WS_OCAT);
    const float* gnw = F.in[18] + layer * 256; const float* snw = F.in[24] + layer * 1024; const float* dsk = F.in[23] + layer * 16;
    int tid_ = threadIdx.x; asm volatile("" : "+v"(tid_));
    const int lane = tid_ & 63, gw = F.bid * NWAVES + __builtin_amdgcn_readfirstlane(tid_ >> 6), NGW = F.G * NWAVES, c0 = lane * 16;
    for (int row = gw; row < MT; row += NGW) {
        float o[16]; float ss = 0.f;
        { const u32x4 a0 = *(const u32x4*)(OG + yaddr(row, c0)), a1 = *(const u32x4*)(OG + yaddr(row, c0 + 8)), b0 = *(const u32x4*)(OG + (size_t)MT * 1024 + yaddr(row, c0)), b1 = *(const u32x4*)(OG + (size_t)MT * 1024 + yaddr(row, c0 + 8));
          const unsigned aa[8] = {a0.x, a0.y, a0.z, a0.w, a1.x, a1.y, a1.z, a1.w}, bb[8] = {b0.x, b0.y, b0.z, b0.w, b1.x, b1.y, b1.z, b1.w};
#pragma unroll
          for (int q = 0; q < 8; ++q) { o[2 * q] = bflo(aa[q]) + bflo(bb[q]); o[2 * q + 1] = bfhi(aa[q]) + bfhi(bb[q]); ss += o[2 * q] * o[2 * q] + o[2 * q + 1] * o[2 * q + 1]; } }
        ss += __shfl_xor(ss, 1); ss += __shfl_xor(ss, 2); ss += __shfl_xor(ss, 4); ss += __shfl_xor(ss, 8);
        float rstd = 1.0f / sqrtf(ss * (1.0f / 256.0f) + RMS_EPS);
        { const u32x4 g0 = *(const u32x4*)(Y + yaddr(row, YC_GR + c0)), g1 = *(const u32x4*)(Y + yaddr(row, YC_GR + c0 + 8));
          const unsigned gg[8] = {g0.x, g0.y, g0.z, g0.w, g1.x, g1.y, g1.z, g1.w}; unsigned ow[8];
          const f32x4* gw4 = (const f32x4*)(gnw + (c0 & 255)); const f32x4 n0 = gw4[0], n1 = gw4[1], n2 = gw4[2], n3 = gw4[3]; const float gn[16] = {n0[0], n0[1], n0[2], n0[3], n1[0], n1[1], n1[2], n1[3], n2[0], n2[1], n2[2], n2[3], n3[0], n3[1], n3[2], n3[3]};
#pragma unroll
          for (int q = 0; q < 8; ++q) ow[q] = pk2(o[2 * q] * rstd * gn[2 * q] * fast_silu(bflo(gg[q])), o[2 * q + 1] * rstd * gn[2 * q + 1] * fast_silu(bfhi(gg[q])));
          *(u32x4*)(OC + kb64(MT, row, c0)) = (u32x4){ow[0], ow[1], ow[2], ow[3]}; *(u32x4*)(OC + kb64(MT, row, c0 + 8)) = (u32x4){ow[4], ow[5], ow[6], ow[7]}; }
        ss = 0.f; const float dk = dsk[lane >> 2];
        { const u32x4 x0 = *(const u32x4*)(XBC + yaddr(row, c0)), x1 = *(const u32x4*)(XBC + yaddr(row, c0 + 8));
          const u32x4 z0 = *(const u32x4*)(Y + yaddr(row, YC_SZ + c0)), z1 = *(const u32x4*)(Y + yaddr(row, YC_SZ + c0 + 8));
          const unsigned xx[8] = {x0.x, x0.y, x0.z, x0.w, x1.x, x1.y, x1.z, x1.w}, zz[8] = {z0.x, z0.y, z0.z, z0.w, z1.x, z1.y, z1.z, z1.w};
          const u32x4 a0 = *(const u32x4*)(OS + yaddr(row, c0)), a1 = *(const u32x4*)(OS + yaddr(row, c0 + 8)), b0 = *(const u32x4*)(OS + (size_t)MT * 1024 + yaddr(row, c0)), b1 = *(const u32x4*)(OS + (size_t)MT * 1024 + yaddr(row, c0 + 8));
          const unsigned aa[8] = {a0.x, a0.y, a0.z, a0.w, a1.x, a1.y, a1.z, a1.w}, bb[8] = {b0.x, b0.y, b0.z, b0.w, b1.x, b1.y, b1.z, b1.w};
#pragma unroll
          for (int e = 0; e < 16; ++e) { const unsigned xw = xx[e >> 1], zw = zz[e >> 1], aw = aa[e >> 1], bw = bb[e >> 1];
              const float xf = (e & 1) ? bfhi(xw) : bflo(xw), zf = (e & 1) ? bfhi(zw) : bflo(zw), af = (e & 1) ? bfhi(aw) : bflo(aw), bf = (e & 1) ? bfhi(bw) : bflo(bw);
              const float y = (af + bf + dk * xf) * fast_silu(zf); o[e] = y; ss += y * y; } }
        rstd = 1.0f / sqrtf(wave_sum(ss) * (1.0f / 1024.0f) + RMS_EPS);
        { unsigned ow[8];
          const f32x4* sw4 = (const f32x4*)(snw + c0); const f32x4 n0 = sw4[0], n1 = sw4[1], n2 = sw4[2], n3 = sw4[3]; const float sn[16] = {n0[0], n0[1], n0[2], n0[3], n1[0], n1[1], n1[2], n1[3], n2[0], n2[1], n2[2], n2[3], n3[0], n3[1], n3[2], n3[3]};
#pragma unroll
          for (int q = 0; q < 8; ++q) ow[q] = pk2(o[2 * q] * rstd * sn[2 * q], o[2 * q + 1] * rstd * sn[2 * q + 1]);
          *(u32x4*)(OC + kb64(MT, row, 1024 + c0)) = (u32x4){ow[0], ow[1], ow[2], ow[3]}; *(u32x4*)(OC + kb64(MT, row, 1024 + c0 + 8)) = (u32x4){ow[4], ow[5], ow[6], ow[7]}; }
    }
}

DI void msum_phase(const Frame& F) {
    unsigned char* const ws_ = F.ws;
    int tid_ = threadIdx.x; asm volatile("" : "+v"(tid_));
    const bf16_t* PB = (const bf16_t*)(ws_ + WS_ODG); bf16_t* Mb = (bf16_t*)(ws_ + WS_XBC);
    const int gt = F.bid * 512 + tid_, NT = F.G * 512;
    for (int it0 = gt; it0 < MT * DM / 8; it0 += 4 * NT) {
        u32x4 a[4], b[4], c[4];
#pragma unroll
        for (int q = 0; q < 4; ++q) { const int it = it0 + q * NT; if (it < MT * DM / 8) { a[q] = *(const u32x4*)(PB + (size_t)it * 8); b[q] = *(const u32x4*)(PB + (size_t)MT * DM + (size_t)it * 8); c[q] = *(const u32x4*)(PB + (size_t)2 * MT * DM + (size_t)it * 8); } }
#pragma unroll
        for (int q = 0; q < 4; ++q) { const int it = it0 + q * NT; if (it < MT * DM / 8) {
            u32x4 o;
            o.x = pk2(bflo(a[q].x) + bflo(b[q].x) + bflo(c[q].x), bfhi(a[q].x) + bfhi(b[q].x) + bfhi(c[q].x)); o.y = pk2(bflo(a[q].y) + bflo(b[q].y) + bflo(c[q].y), bfhi(a[q].y) + bfhi(b[q].y) + bfhi(c[q].y));
            o.z = pk2(bflo(a[q].z) + bflo(b[q].z) + bflo(c[q].z), bfhi(a[q].z) + bfhi(b[q].z) + bfhi(c[q].z)); o.w = pk2(bflo(a[q].w) + bflo(b[q].w) + bflo(c[q].w), bfhi(a[q].w) + bfhi(b[q].w) + bfhi(c[q].w));
            *(u32x4*)(Mb + kb64(MT, (it >> 5) % MT, (it / (32 * MT)) * 256 + (it & 31) * 8)) = o; } }
    }
}

DI void transpose_item(const float* W, int K, int N, bf16_t* WT, int NR, int k0, int n0, int dst0, LAS float* scr, int lane) {
#pragma unroll 8
    for (int i = 0; i < 32; ++i) { const int kk = 2 * i + (lane >> 5); scr[kk * 33 + (lane & 31)] = W[(size_t)(k0 + kk) * N + n0 + (lane & 31)]; }
    LDS_WAIT(); asm volatile("" ::: "memory");
    const int c = lane & 7;
#pragma unroll
    for (int j = 0; j < 4; ++j) { const int n = (lane >> 3) + 8 * j; const LAS float* s = scr + (8 * c) * 33 + n;
        u32x4 o; o.x = pk2(s[0 * 33], s[1 * 33]); o.y = pk2(s[2 * 33], s[3 * 33]); o.z = pk2(s[4 * 33], s[5 * 33]); o.w = pk2(s[6 * 33], s[7 * 33]);
        *(u32x4*)(WT + ((size_t)(k0 >> 6) * NR + dst0 + n) * 64 + 8 * c) = o; }
    LDS_WAIT(); asm volatile("" ::: "memory");
}
DI int win_dst(int n) { return n < 3072 ? n : (n < 3104 ? YC_GD + (n - 3072) : (n < 6176 ? n - 32 : (n < 6208 ? YC_DT + (n - 6176) : n - 64))); }
DI void prologue_phase(const Frame& F, LAS unsigned char* lds) {
    unsigned char* const ws_ = F.ws;
    int tid_ = threadIdx.x; asm volatile("" : "+v"(tid_));
    const int tid = tid_, lane = tid & 63, wave = __builtin_amdgcn_readfirstlane(tid >> 6);
    {
        LAS float* sv = (LAS float*)lds;
        LAS float* red = (LAS float*)(lds + 24576);
        for (int i = tid; i < 3 * 2048; i += 512) { const int mi = i >> 11, k = i & 2047; const float x = mi == 0 ? F.in[7][k] : F.in[2][(mi - 1) * 2048 + k]; sv[i] = x / (1.0f + __expf(-x)); }
        __syncthreads();
        float* MOD = (float*)(ws_ + WS_MOD);
        const int tx = tid & 15, ty = tid >> 4;
        for (int it = F.bid; it < 2 * 288; it += F.G) {
            const int l = it / 288, cb = it % 288;
            const float* wp = F.in[8] + ((size_t)l * 2048 + 64 * ty) * NMOD + 64 * cb + 4 * tx;
            f32x4 a0 = {0.f, 0.f, 0.f, 0.f}, a1 = a0, a2 = a0;
#pragma unroll 8
            for (int k = 0; k < 64; ++k) { const f32x4 wv = *(const f32x4*)(wp + (size_t)k * NMOD); const int kk = 64 * ty + k;
                a0 = a0 + sv[kk] * wv; a1 = a1 + sv[2048 + kk] * wv; a2 = a2 + sv[4096 + kk] * wv; }
            *(LAS f32x4*)(red + (ty * 3 + 0) * 64 + 4 * tx) = a0; *(LAS f32x4*)(red + (ty * 3 + 1) * 64 + 4 * tx) = a1; *(LAS f32x4*)(red + (ty * 3 + 2) * 64 + 4 * tx) = a2;
            __syncthreads();
            if (tid < 192) { const int mi = tid >> 6, col = tid & 63; float s = 0.f;
#pragma unroll 8
                for (int y = 0; y < 32; ++y) s += red[(y * 3 + mi) * 64 + col];
                MOD[((size_t)l * 3 + mi) * NMOD + 64 * cb + col] = s + F.in[9][(size_t)l * NMOD + 64 * cb + col]; }
            __syncthreads();
        }
    }
    {
        LAS float* scr = (LAS float*)(lds + wave * 8448);
        const int gw = F.bid * NWAVES + wave, NGW = F.G * NWAVES;
        constexpr int PER_L = 52800;
        for (int it = gw; it < 2 * PER_L; it += NGW) {
            const int l = it / PER_L; int r = it - l * PER_L;
            if (r < 33792) { const int mi = r / 5632, rr = r - mi * 5632;
                if (mi < 4) { const int f = mi >> 1, up = mi & 1; const float* W = F.in[f ? (up ? 32 : 31) : (up ? 12 : 11)] + (size_t)l * DM * FF;
                    const int kb = rr / 176, nb = rr - kb * 176, n0 = 32 * nb;
                    transpose_item(W, DM, FF, (bf16_t*)(ws_ + WS_WGU + (size_t)(l * 2 + f) * SZ_WGU), NGU, 64 * kb, n0, 256 * (n0 >> 7) + 128 * up + (n0 & 127), scr, lane); }
                else { const int f = mi - 4; const float* W = F.in[f ? 33 : 13] + (size_t)l * FF * DM; const int kb = rr >> 6, nb = rr & 63;
                    transpose_item(W, FF, DM, (bf16_t*)(ws_ + WS_WD + (size_t)(l * 2 + f) * SZ_WD), DM, 64 * kb, 32 * nb, 32 * nb, scr, lane); }
                continue; }
            r -= 33792;
            if (r < 13888) { const int kb = r / 434, nb = r - kb * 434; transpose_item(F.in[15] + (size_t)l * DM * D_IN, DM, D_IN, (bf16_t*)(ws_ + WS_WIN + (size_t)l * SZ_WIN), NY, 64 * kb, 32 * nb, win_dst(32 * nb), scr, lane); continue; }
            r -= 13888;
            if (r < 3072) { const int i = r >> 10, rr = r & 1023, kb = rr >> 6, nb = rr & 63;
                transpose_item(F.in[26 + i] + (size_t)l * 1024 * DM, 1024, DM, (bf16_t*)(ws_ + WS_WBR + (size_t)(l * 3 + i) * SZ_WBR), DM, 64 * kb, 32 * nb, 32 * nb, scr, lane); continue; }
            r -= 3072;
            { const int kb = r >> 6, nb = r & 63; transpose_item(F.in[29] + (size_t)l * DM * DM, DM, DM, (bf16_t*)(ws_ + WS_WOUT + (size_t)l * SZ_WOUT), DM, 64 * kb, 32 * nb, 32 * nb, scr, lane); }
        }
    }
    const int gt = F.bid * 512 + tid, NTT = F.G * 512;
    for (int it = gt; it < 2 * 192 * 256; it += NTT) { const int l = it / (192 * 256), r = it - l * (192 * 256);
        *(u32x4*)(ws_ + WS_WIN + (size_t)l * SZ_WIN + kb64(NY, D_IN + (r >> 8), (r & 255) * 8) * 2) = (u32x4){0u, 0u, 0u, 0u}; }
    for (int it = gt; it < 2 * 65536; it += NTT) { const int which = it >> 16, r = it & 65535, l = r >> 15, b = (r >> 14) & 1, e = (r & 16383) * 8;
        const float* src = F.in[3 + which] + ((size_t)(b * 2 + l) * 512 * 256) + e;
        const f32x4 v0 = *(const f32x4*)src, v1 = *(const f32x4*)(src + 4);
        u32x4 o; o.x = pk2(v0[0], v0[1]); o.y = pk2(v0[2], v0[3]); o.z = pk2(v1[0], v1[1]); o.w = pk2(v1[2], v1[3]);
        *(u32x4*)(ws_ + (which ? WS_CVB : WS_CKB) + ((size_t)(l * 2 + b) * 512 * 256 + e) * 2) = o; }
}

struct UTiles { const bf16_t* k1; const bf16_t* v1; int ld1, n1; const bf16_t* k2; const bf16_t* v2; int dpos2;
    DI att::Tile operator()(int j) const { att::Tile t;
        if (j < n1) { t.k = k1 + (size_t)j * 64 * ld1; t.v = v1 + (size_t)j * 64 * ld1; t.ldk = ld1; t.ldv = ld1; t.dpos = 0; t.masked = 0; }
        else { const int s = 64 * (j - n1); t.k = k2 + (size_t)s * 256; t.v = v2 + (size_t)s * YLD; t.ldk = 256; t.ldv = YLD; t.dpos = dpos2 + s; t.masked = 1; }
        return t; } };
DI int q_next(unsigned* ctr, volatile LAS int* slot) {
    __syncthreads();
    if (threadIdx.x == 0) *slot = (int)__hip_atomic_fetch_add(ctr, 1u, RLX_AGENT);
    __syncthreads();
    return *slot;
}
DI void mixer_phase(const Frame& F, unsigned char* lds_g, int layer_q) {
    unsigned char* const ws_ = F.ws;
    const int layer = layer_q & 1;
    LAS unsigned char* lds = (LAS unsigned char*)lds_g;
    volatile LAS int* slot = (volatile LAS int*)(lds + MISC_OFF + 64);
    unsigned* qc = (unsigned*)(ws_ + WS_CTL) + CW_Q + layer_q * 3 * 64;
    const bf16_t* Y = (const bf16_t*)(ws_ + WS_BIG); bf16_t* OC = (bf16_t*)(ws_ + WS_OCAT);
    const float* sinkp = F.in[25] + layer * 8;
    for (;;) {
        const int qi = q_next(qc, slot); if (qi >= 880) break;
        if (qi < 16 || (qi >= 112 && qi < 368)) gla_chain(F, lds, qi < 16 ? qi : qi - 112 + 16, layer);
        else if (qi < 48) ssd_chain(F, lds, (qi - 16) >> 1, layer, (qi - 16) & 1);
        else if (qi >= 368 && qi < 624) ssd_chain(F, lds, qi - 368 + 16, layer, -1);
        else {
            const int it = qi < 112 ? qi - 48 : qi - 624 + 64;
            UTiles ts; int row0, hq, NT, ldq; const bf16_t* Qp;
            if (it < 64) { const int b = it >> 5, qb = it & 3; hq = (it >> 2) & 7; const int kvh = hq >> 2;
                row0 = M_CTX + b * 1024 + qb * 256; const int s0 = qb == 0 ? 0 : 256 * qb - 128, s1 = qb == 3 ? 1024 : 256 * qb + 384;
                ts.k1 = (const bf16_t*)(ws_ + WS_CKB) + (size_t)(layer * 2 + b) * 512 * 256 + kvh * 128; ts.v1 = (const bf16_t*)(ws_ + WS_CVB) + (size_t)(layer * 2 + b) * 512 * 256 + kvh * 128; ts.ld1 = 256; ts.n1 = 8;
                ts.k2 = (const bf16_t*)(ws_ + WS_KR) + (size_t)(b * 1024 + s0) * 256 + kvh * 128; ts.v2 = Y + yaddr(M_CTX + b * 1024 + s0, YC_AV + kvh * 128); ts.dpos2 = s0 - qb * 256;
                NT = 8 + (s1 - s0) / 64; Qp = (const bf16_t*)(ws_ + WS_QR) + (size_t)(b * 1024 + qb * 256) * 1024 + hq * 128; ldq = 1024;
            } else { const int u = it - 64, b = u >> 3; hq = u & 7; const int kvh = hq >> 2; row0 = b * 256;
                ts.k1 = Y + yaddr(row0, YC_AK + kvh * 128); ts.v1 = Y + yaddr(row0, YC_AV + kvh * 128); ts.ld1 = YLD; ts.n1 = 4; ts.k2 = ts.k1; ts.v2 = ts.v1; ts.dpos2 = 0;
                NT = 4; Qp = Y + yaddr(row0, YC_AQ + hq * 128); ldq = YLD; }
            att::attn_unit(Qp, ldq, ts, NT, sinkp[hq], OC + kb64(MT, row0, 2048 + hq * 128), 64, (char*)lds_g);
        }
    }

}

#ifndef SITE_MASK
#define SITE_MASK 1023
#endif

constexpr int N_PH = 56;
struct Args { const float* in[35]; float* out; unsigned char* ws; int ph_lo, ph_hi; };
static_assert(sizeof(Args) == 37 * 8 + 8, "Args has no padding");
__global__ void __launch_bounds__(NWAVES * 64, 2) trunk_fwd(Args args) {
    extern __shared__ __attribute__((aligned(16))) unsigned char lds[];
    LAS unsigned char* L = (LAS unsigned char*)lds;
    Frame F; F.ws = args.ws; F.out = args.out; F.in = args.in;
    F.G = gridDim.x; F.bid = blockIdx.x;
    const int lo = args.ph_lo, hi = args.ph_hi;
    for (int u = threadIdx.x; u < (LDS_BYTES - RING_BYTES) / 4; u += NWAVES * 64) ((LAS unsigned*)(L + RING_BYTES))[u] = 0u;
    __syncthreads();
    XcdBarrier bar; bar.bar = (unsigned*)(F.ws + WS_CTL) + CW_BAR; bar.x = 0; bar.st = nullptr;
    if (hi - lo > 1) bar = xcd_barrier_post((unsigned*)(F.ws + WS_CTL) + CW_BAR, (volatile LAS unsigned*)(L + MISC_OFF) + 8);
#define RUN(p) (lo <= (p) && (p) < hi)
#define SEAM(p) do { if ((p) + 1 < hi) xcd_barrier(bar); } while (0)
    bf16_t* X = (bf16_t*)(F.ws + WS_XB);
    float* MOD = (float*)(F.ws + WS_MOD);
    bf16_t* XN = (bf16_t*)(F.ws + WS_XN); bf16_t* Y = (bf16_t*)(F.ws + WS_BIG); bf16_t* H = (bf16_t*)(F.ws + WS_BIG);
    bf16_t* Mb = (bf16_t*)(F.ws + WS_XBC); bf16_t* OC = (bf16_t*)(F.ws + WS_OCAT);

    #if SITE_MASK & 1
    if (RUN(0)) { for (int rep = 0; rep < NREP(1); ++rep) { prologue_phase(F, L); SEAM(0); } }
#endif
    for (int step = 0; step < 6; ++step) {
        const int l = step / 3, sb = step - 3 * l, pid = 1 + 9 * step;
        const bool ffn = sb != 1; const int f = sb >> 1;
        const float* modl = MOD + (size_t)l * 3 * NMOD + (size_t)sb * 3 * DM;
#if SITE_MASK & 2
        if (RUN(pid + 0)) { const float* nw = F.in[sb == 0 ? 10 : (sb == 1 ? 14 : 30)] + (size_t)l * DM; for (int rep = 0; rep < NREP(2); ++rep) { if (step == 0) norm_phase(F, F.in[0], F.in[1] - (size_t)M_CTX * DM, nw, modl, XN); else norm_phase_b(F, X, nw, modl, XN); SEAM(pid + 0); } }
#endif
        if (ffn) {
#if SITE_MASK & 4
            if (RUN(pid + 1)) {
                pg8::Prob P; P.A = (const char*)XN; P.Bt = (const char*)(F.ws + WS_WGU + (size_t)(l * 2 + f) * SZ_WGU); P.lda = 64; P.ldb = 64; P.kstepA = (size_t)MT * 128; P.kstepB = (size_t)NGU * 128; P.nM = MT / 256; P.nN = NGU / 256; P.ntk = DM / 64; P.nseg = 1; P.a_seg = 0; P.b_seg = 0; P.G = F.G; { const int b_ = opaque_s(F.bid); P.c = XCD_CONTIG ? ((b_ & 31) * 8 + (b_ >> 5)) : b_; }
                EpiSwiGLU E{H}; for (int rep = 0; rep < NREP(4); ++rep) { pg8::gemm_phase(L, P, E); SEAM(pid + 1); } }
#endif
        } else {
#if SITE_MASK & 8
            if (RUN(pid + 2)) {
                pg8::Prob P; P.A = (const char*)XN; P.Bt = (const char*)(F.ws + WS_WIN + (size_t)l * SZ_WIN); P.lda = 64; P.ldb = 64; P.kstepA = (size_t)MT * 128; P.kstepB = (size_t)NY * 128; P.nM = MT / 256; P.nN = NY / 256; P.ntk = DM / 64; P.nseg = 1; P.a_seg = 0; P.b_seg = 0; P.G = F.G; { const int b_ = opaque_s(F.bid); P.c = XCD_CONTIG ? ((b_ & 31) * 8 + (b_ >> 5)) : b_; }
                EpiY E{Y, (float*)(F.ws + WS_YS)}; for (int rep = 0; rep < NREP(8); ++rep) { pg8::gemm_phase(L, P, E); SEAM(pid + 2); } }
#endif
#if SITE_MASK & 16
            if (RUN(pid + 3)) { for (int rep = 0; rep < NREP(16); ++rep) { prep_phase(F, l); SEAM(pid + 3); } }
#endif
#if SITE_MASK & 32
            if (RUN(pid + 4)) { for (int rep = 0; rep < NREP(32); ++rep) { mixer_phase(F, lds, l + 2 * rep); SEAM(pid + 4); } }
#endif
#if SITE_MASK & 64
            if (RUN(pid + 5)) { for (int rep = 0; rep < NREP(64); ++rep) { combine_phase(F, l); SEAM(pid + 5); } }
#endif
#if SITE_MASK & 128
            if (RUN(pid + 6)) {
                pg8::Prob P; P.A = (const char*)OC; P.Bt = (const char*)(F.ws + WS_WBR + (size_t)l * 3 * SZ_WBR); P.lda = 64; P.ldb = 64; P.kstepA = (size_t)MT * 128; P.kstepB = (size_t)DM * 128; P.nM = MT / 256; P.nN = DM / 256; P.ntk = 1024 / 64; P.nseg = 3; P.a_seg = (size_t)16 * MT * 128; P.b_seg = SZ_WBR; P.G = F.G; { const int b_ = opaque_s(F.bid); P.c = XCD_CONTIG ? ((b_ & 31) * 8 + (b_ >> 5)) : b_; }
                EpiBranch E{Y, (bf16_t*)(F.ws + WS_ODG)}; for (int rep = 0; rep < NREP(128); ++rep) { pg8::gemm_phase(L, P, E); SEAM(pid + 6); } }
            if (RUN(pid + 7)) { msum_phase(F); SEAM(pid + 7); }
#endif
        }
#if SITE_MASK & 256
        if (RUN(pid + 8)) {
            pg8::ProbSK P; P.G = F.G; { const int b_ = opaque_s(F.bid); P.vc = (F.G & 7) ? b_ : (b_ & 7) * (F.G >> 3) + (b_ >> 3); }
            if (ffn) { P.A = (const char*)H; P.Bt = (const char*)(F.ws + WS_WD + (size_t)(l * 2 + f) * SZ_WD); P.q4 = FF / 64 / 4; }
            else { P.A = (const char*)Mb; P.Bt = (const char*)(F.ws + WS_WOUT + (size_t)l * SZ_WOUT); P.q4 = DM / 64 / 4; }
            P.lda = 64; P.ldb = 64; P.kstepA = (size_t)MT * 128; P.kstepB = (size_t)DM * 128;
            P.slab = (const float*)(F.ws + WS_SLAB);
            for (int rep = 0; rep < NREP(256); ++rep) {
                P.flags = (unsigned*)(F.ws + WS_CTL) + CW_SK + (step + 6 * rep) * 256 * 64;
                if (step == 0 && rep == 0) { EpiSK<EpiResid<true>> E{EpiResid<true>{X, modl + 2 * DM, 0.5f, F.in[0], F.in[1] - (size_t)M_CTX * DM}, (float*)(F.ws + WS_SLAB), P.flags}; pg8::gemm_phase(L, P, E); }
                else { EpiSK<EpiResid<false>> E{EpiResid<false>{X, modl + 2 * DM, rep ? 0.0f : (ffn ? 0.5f : 1.0f), nullptr, nullptr}, (float*)(F.ws + WS_SLAB), P.flags}; pg8::gemm_phase(L, P, E); }
                SEAM(pid + 8); } }
#endif
    }
#if SITE_MASK & 512
    if (RUN(55)) final_norm_phase(F, X, F.out, F.in[34]);
#endif
#undef RUN
#undef SEAM
}

#ifndef MK_PER_PHASE
#define MK_PER_PHASE 0
#endif
extern "C" void kernel_launch(void* const* d_in, const int* in_sizes, int n_in, void* d_out, int out_size, void* d_ws, size_t ws_size, hipStream_t stream) {
    static int grid = 0;
    if (grid == 0) {
        if (n_in != 35 || out_size != (int)OUT_TOTAL || ws_size < WS_END) { fprintf(stderr, "kernel_launch: unexpected shapes: n_in %d out %d ws %zu (need %zu)\n", n_in, out_size, ws_size, (size_t)WS_END); grid = -1; return; }
        int dev = 0, cus = 0, per_cu = 0;
        if (hipGetDevice(&dev) != hipSuccess || hipDeviceGetAttribute(&cus, hipDeviceAttributeMultiprocessorCount, dev) != hipSuccess) { grid = -1; return; }
        if (hipFuncSetAttribute((const void*)trunk_fwd, hipFuncAttributeMaxDynamicSharedMemorySize, LDS_BYTES) != hipSuccess) { fprintf(stderr, "kernel_launch: hipFuncSetAttribute failed\n"); grid = -1; return; }
        if (hipOccupancyMaxActiveBlocksPerMultiprocessor(&per_cu, (const void*)trunk_fwd, NWAVES * 64, LDS_BYTES) != hipSuccess || per_cu < 1) { fprintf(stderr, "kernel_launch: occupancy query says %d blocks per CU\n", per_cu); }
        (void)hipGetLastError();
        grid = cus;
    }
    if (grid < 0) return;
    (void)hipMemsetAsync((char*)d_ws + WS_CTL, 0, CTL_ZERO_BYTES, stream);
    Args a{};
    for (int i = 0; i < 35; ++i) a.in[i] = (const float*)d_in[i];
    a.out = (float*)d_out; a.ws = (unsigned char*)d_ws;
#if MK_PER_PHASE
    for (int p = 0; p < N_PH; ++p) {
        if (p >= 1 && p <= 54) { const int step = (p - 1) / 9, site = (p - 1) % 9; const bool ffn = (step % 3) != 1;
            if (site == 1 && !ffn) continue; if (site >= 2 && site <= 7 && ffn) continue; }
        a.ph_lo = p; a.ph_hi = p + 1;
        hipLaunchKernelGGL(trunk_fwd, dim3(grid), dim3(NWAVES * 64), LDS_BYTES, stream, a);
    }
#else
    a.ph_lo = 0; a.ph_hi = N_PH;
    hipLaunchKernelGGL(trunk_fwd, dim3(grid), dim3(NWAVES * 64), LDS_BYTES, stream, a);
#endif
    const hipError_t le = hipPeekAtLastError();
    if (le != hipSuccess) fprintf(stderr, "kernel_launch: launch failed: %s\n", hipGetErrorName(le));
}
```
